# Optimizing an MI355X kernel written in HIP

```python
import jax, jax.numpy as jnp
from jax import lax
import numpy as np

D_MODEL = 1024
BATCH = 1
SEQ = 16384
DEPTH = 4

GRID_W = 64
CTX_LEN = 256
A_HEADS = 4
A_DQK = 128
A_DV = 256
A_QK_WIDTH = A_HEADS * A_DQK
A_WIDTH = A_HEADS * A_DV
MLSTM_CHUNK = 128
SHORT_CONV_W = 5
B_GROUPS = 4
B_WIDTH = 1024
B_CHUNK = 128
ROWS_PER_CHUNK = B_CHUNK // GRID_W
D_FF = -(-(8 * D_MODEL) // (3 * 256)) * 256
N_MOD = 6
EPS = 1e-6
IN_SIZES = (A_QK_WIDTH, A_QK_WIDTH, A_WIDTH, A_WIDTH, 4 * A_HEADS, B_WIDTH, B_WIDTH, D_MODEL, D_MODEL)
IN_WIDTH = sum(IN_SIZES)
IN_SPLITS = tuple(int(s) for s in np.cumsum(IN_SIZES)[:-1])

kernel_name = 'hybrid_mlstm_gmlp_diffusion_block'


def _rmsnorm(x, g):
    xf = x.astype(jnp.float32)
    y = xf * lax.rsqrt(jnp.mean(xf * xf, axis=-1, keepdims=True) + EPS)
    return (y * g.astype(jnp.float32)).astype(x.dtype)


def _modulate(h, shift, scale):
    return h * (1 + scale[:, None, :]) + shift[:, None, :]


def _short_conv(x, w, b):
    pad = SHORT_CONV_W // 2
    y = lax.conv_general_dilated(x, w[:, None, :].astype(x.dtype), window_strides=(1,), padding=[(pad, pad)], dimension_numbers=('NWC', 'WIO', 'NWC'), feature_group_count=x.shape[-1])
    return y + b


def _heads(t, d):
    B, N, _ = t.shape
    return t.reshape(B, N, -1, d).transpose(0, 2, 1, 3)


def _mlstm_chunkwise(q, k, v, log_i, log_f, state):
    q, k, v = (t.astype(jnp.float32) for t in (q, k, v))
    B, H, N, _ = q.shape
    L = MLSTM_CHUNK
    nc = N // L

    def to_chunks(t):
        return jnp.moveaxis(t.reshape(B, H, nc, L, *t.shape[3:]), 2, 0)

    xs = tuple(to_chunks(t) for t in (q, k, v, log_i, log_f))
    lower = jnp.tril(jnp.ones((L, L), dtype=bool))

    def step(carry, inp):
        C, n, m = carry
        qc, kc, vc, ic, fc = inp
        b = jnp.cumsum(fc, axis=-1)
        log_d = b[..., :, None] - b[..., None, :] + ic[..., None, :]
        log_d = jnp.where(lower, log_d, -jnp.inf)
        log_prev = b + m[..., None]
        m_t = jnp.maximum(log_prev, jnp.max(log_d, axis=-1))
        w_prev = jnp.exp(log_prev - m_t)
        s = jnp.einsum('bhtd,bhsd->bhts', qc, kc) * jnp.exp(log_d - m_t[..., None])
        num = jnp.einsum('bhts,bhsv->bhtv', s, vc) + w_prev[..., None] * jnp.einsum('bhtd,bhdv->bhtv', qc, C)
        den = jnp.sum(s, axis=-1) + w_prev * jnp.einsum('bhtd,bhd->bht', qc, n)
        h = num / jnp.maximum(jnp.abs(den), jnp.exp(-m_t))[..., None]
        b_end = b[..., -1]
        log_src = b_end[..., None] - b + ic
        m_new = jnp.maximum(b_end + m, jnp.max(log_src, axis=-1))
        w_src = jnp.exp(log_src - m_new[..., None])
        w_c = jnp.exp(b_end + m - m_new)
        kw = kc * w_src[..., None]
        C_new = w_c[..., None, None] * C + jnp.einsum('bhsd,bhsv->bhdv', kw, vc)
        n_new = w_c[..., None] * n + jnp.sum(kw, axis=2)
        return (C_new, n_new, m_new), h

    state, hs = lax.scan(step, state, xs)
    h = jnp.moveaxis(hs, 0, 2).reshape(B, H, N, v.shape[-1])
    return h, state


def _mlstm_direction(ctx_in, lat_in, reverse):
    if reverse:
        ctx_in = tuple(jnp.flip(t, axis=2) for t in ctx_in)
        lat_in = tuple(jnp.flip(t, axis=2) for t in lat_in)
    B = ctx_in[0].shape[0]
    state0 = (jnp.zeros((B, A_HEADS, A_DQK, A_DV), jnp.float32), jnp.zeros((B, A_HEADS, A_DQK), jnp.float32), jnp.zeros((B, A_HEADS), jnp.float32))
    h_c, state = _mlstm_chunkwise(*ctx_in, state0)
    h_x, _ = _mlstm_chunkwise(*lat_in, state)
    if reverse:
        h_c = jnp.flip(h_c, axis=2)
        h_x = jnp.flip(h_x, axis=2)
    return h_c, h_x


def _mix_inputs(h, w_in, conv_w, conv_b, gate_b):
    B, N, _ = h.shape
    z = jnp.einsum('bnd,de->bne', h, w_in)
    q_raw, k_raw, v_raw, o_raw, g_raw, u_raw, vb_raw, ga_raw, gb_raw = jnp.split(z, IN_SPLITS, axis=-1)
    qk = jax.nn.silu(_short_conv(jnp.concatenate([q_raw, k_raw], axis=-1), conv_w, conv_b))
    q, k = jnp.split(qk, 2, axis=-1)
    q = _heads(q, A_DQK) * (A_DQK ** -0.5)
    k = _heads(k, A_DQK)
    v = _heads(v_raw, A_DV)
    g = (g_raw + gate_b).astype(jnp.float32).reshape(B, N, 4, A_HEADS).transpose(2, 0, 3, 1)
    fwd = (q, k, v, g[0], jax.nn.log_sigmoid(g[1]))
    bwd = (q, k, v, g[2], jax.nn.log_sigmoid(g[3]))
    rest = (o_raw, u_raw, vb_raw, ga_raw, gb_raw)
    return fwd, bwd, rest


def _mix_outputs(h_a, rest, n_chunks, head_g, vnorm_g, w_sp, b_sp, w_pa, w_pb, w_out):
    o_raw, u_raw, vb_raw, ga_raw, gb_raw = rest
    B, N, _ = o_raw.shape
    y_a = _rmsnorm(h_a.astype(o_raw.dtype), head_g[:, None, :]).transpose(0, 2, 1, 3).reshape(B, N, A_WIDTH)
    y_a = y_a * jax.nn.sigmoid(o_raw)
    u = jax.nn.gelu(u_raw)
    vb = _rmsnorm(jax.nn.gelu(vb_raw), vnorm_g).reshape(B, n_chunks, B_CHUNK, B_GROUPS, B_WIDTH // B_GROUPS)
    sv = jnp.einsum('gts,bcsgd->bctgd', w_sp, vb) + b_sp.T[:, :, None]
    y_b = u * sv.reshape(B, N, B_WIDTH)
    merged = jax.nn.sigmoid(ga_raw) * jnp.einsum('bne,ed->bnd', y_a, w_pa) + jax.nn.sigmoid(gb_raw) * jnp.einsum('bne,ed->bnd', y_b, w_pb)
    return jnp.einsum('bnd,de->bne', merged, w_out)


def _swiglu(h, w1, w3, w2):
    a = jnp.einsum('bnd,df->bnf', h, w1)
    g = jnp.einsum('bnd,df->bnf', h, w3)
    return jnp.einsum('bnf,fd->bnd', jax.nn.silu(a) * g, w2)


def setup_inputs(seed: int = 0) -> dict:
    key = jax.random.key(seed)
    ks = jax.random.split(key, 24)
    L, D = DEPTH, D_MODEL

    def nrm(k, shape, scale):
        return jax.random.normal(k, shape, jnp.float32) * scale

    gate_i = nrm(ks[11], (L, 2, A_HEADS), 0.1)
    gate_f = jnp.linspace(3.0, 6.0, A_HEADS, dtype=jnp.float32) + nrm(ks[12], (L, 2, A_HEADS), 0.1)
    gate_b = jnp.stack([gate_i, gate_f], axis=2).reshape(L, 4 * A_HEADS)
    return {
        'x': nrm(ks[0], (BATCH, SEQ, D), 1.0),
        'c': nrm(ks[1], (BATCH, D), 1.0),
        'ctx': nrm(ks[2], (BATCH, CTX_LEN, D), 1.0),
        'c_ctx': nrm(ks[3], (D,), 1.0),
        'w_ada': nrm(ks[4], (L, D, N_MOD * D), 0.5 * D ** -0.5),
        'b_ada': nrm(ks[5], (L, N_MOD * D), 0.02),
        'norm1_g': 1.0 + nrm(ks[6], (L, D), 0.1),
        'norm2_g': 1.0 + nrm(ks[7], (L, D), 0.1),
        'w_in': nrm(ks[8], (L, D, IN_WIDTH), D ** -0.5),
        'conv_w': nrm(ks[9], (L, SHORT_CONV_W, 2 * A_QK_WIDTH), SHORT_CONV_W ** -0.5),
        'conv_b': nrm(ks[10], (L, 2 * A_QK_WIDTH), 0.02),
        'gate_b': gate_b,
        'head_g': 1.0 + nrm(ks[13], (L, A_HEADS, A_DV), 0.1),
        'vnorm_g': 1.0 + nrm(ks[14], (L, B_WIDTH), 0.1),
        'w_spatial': nrm(ks[15], (L, B_GROUPS, B_CHUNK, B_CHUNK), 0.5 * B_CHUNK ** -0.5),
        'b_spatial': 1.0 + nrm(ks[16], (L, B_GROUPS, B_CHUNK), 0.1),
        'w_pa': nrm(ks[17], (L, A_WIDTH, D), A_WIDTH ** -0.5),
        'w_pb': nrm(ks[18], (L, B_WIDTH, D), B_WIDTH ** -0.5),
        'w_out': nrm(ks[19], (L, D, D), D ** -0.5),
        'w_ff1': nrm(ks[20], (L, D, D_FF), D ** -0.5),
        'w_ff3': nrm(ks[21], (L, D, D_FF), D ** -0.5),
        'w_ff2': nrm(ks[22], (L, D_FF, D), D_FF ** -0.5),
        'final_g': 1.0 + nrm(ks[23], (D,), 0.1),
    }


def reference(x, c, ctx, c_ctx, w_ada, b_ada, norm1_g, norm2_g, w_in, conv_w, conv_b, gate_b, head_g, vnorm_g, w_spatial, b_spatial, w_pa, w_pb, w_out, w_ff1, w_ff3, w_ff2, final_g):
    rows = x.shape[1] // GRID_W
    lat_chunks = rows // ROWS_PER_CHUNK
    ctx_chunks = ctx.shape[1] // B_CHUNK
    mod_x = jnp.einsum('bd,lde->lbe', jax.nn.silu(c), w_ada) + b_ada[:, None, :]
    mod_c = jnp.einsum('d,lde->le', jax.nn.silu(c_ctx), w_ada)[:, None, :] + b_ada[:, None, :]
    xs, cs = x, ctx
    for l in range(DEPTH):
        last = l == DEPTH - 1
        sh1x, sc1x, g1x, sh2x, sc2x, g2x = jnp.split(mod_x[l], N_MOD, axis=-1)
        sh1c, sc1c, g1c, sh2c, sc2c, g2c = jnp.split(mod_c[l], N_MOD, axis=-1)
        hx = _modulate(_rmsnorm(xs, norm1_g[l]), sh1x, sc1x)
        hc = _modulate(_rmsnorm(cs, norm1_g[l]), sh1c, sc1c)
        fwd_x, bwd_x, rest_x = _mix_inputs(hx, w_in[l], conv_w[l], conv_b[l], gate_b[l])
        fwd_c, bwd_c, rest_c = _mix_inputs(hc, w_in[l], conv_w[l], conv_b[l], gate_b[l])
        hc_f, hx_f = _mlstm_direction(fwd_c, fwd_x, reverse=False)
        hc_b, hx_b = _mlstm_direction(bwd_c, bwd_x, reverse=True)
        out_x = _mix_outputs(hx_f + hx_b, rest_x, lat_chunks, head_g[l], vnorm_g[l], w_spatial[l], b_spatial[l], w_pa[l], w_pb[l], w_out[l])
        xs = xs + g1x[:, None, :] * out_x
        xs = xs + g2x[:, None, :] * _swiglu(_modulate(_rmsnorm(xs, norm2_g[l]), sh2x, sc2x), w_ff1[l], w_ff3[l], w_ff2[l])
        if not last:
            out_c = _mix_outputs(hc_f + hc_b, rest_c, ctx_chunks, head_g[l], vnorm_g[l], w_spatial[l], b_spatial[l], w_pa[l], w_pb[l], w_out[l])
            cs = cs + g1c[:, None, :] * out_c
            cs = cs + g2c[:, None, :] * _swiglu(_modulate(_rmsnorm(cs, norm2_g[l]), sh2c, sc2c), w_ff1[l], w_ff3[l], w_ff2[l])
    return _rmsnorm(xs, final_g)
```

```cpp
#include <hip/hip_runtime.h>
#include <hip/hip_cooperative_groups.h>
#include <cstdio>
namespace cg = cooperative_groups;

#define LAS __attribute__((address_space(3)))
typedef unsigned short bf16_t;
typedef short bf16x8 __attribute__((ext_vector_type(8)));
typedef float f32x4 __attribute__((ext_vector_type(4)));
typedef float f32x2 __attribute__((ext_vector_type(2)));
typedef unsigned u32x4 __attribute__((ext_vector_type(4)));
typedef unsigned u32x2 __attribute__((ext_vector_type(2)));

constexpr int T = 16640, NCTX = 256, D = 1024, NCH = 130, DFF = 2816, INW = 7184, ZW = 7168, DEPTH = 4;
constexpr size_t PLANE = (size_t)T * 1024;
constexpr float EPS = 1e-6f;
constexpr int NTHREADS = 512, NWAVES = 8;
constexpr int LDS_BYTES = 147456;
#ifndef PH_MASK
#define PH_MASK 0xFFFFF
#endif
#define PH(k) ((PH_MASK >> (k)) & 1)

constexpr size_t MiB = 1u << 20;
constexpr size_t OFF_MOD = 0;
constexpr size_t OFF_SC = 256 * 1024;
constexpr size_t OFF_MP = 256 * 1024 + 16 * 1024;
constexpr size_t OFF_NS = 320 * 1024;
constexpr size_t OFF_G = 1 * MiB;
constexpr size_t OFF_CS = 3 * MiB;
constexpr size_t OFF_WB = 4 * MiB;
constexpr size_t WB_WIN = 0, WB_WPAB = (size_t)ZW * 1024 * 2, WB_WOUT = WB_WPAB + (size_t)2048 * 1024 * 2, WB_W13 = WB_WOUT + (size_t)1024 * 1024 * 2,
                 WB_W2 = WB_W13 + (size_t)5632 * 1024 * 2, WB_END = WB_W2 + (size_t)1024 * 2816 * 2;
static_assert(WB_END <= 37 * MiB, "wb");
constexpr size_t OFF_H = 41 * MiB;
constexpr size_t OFF_QK = 74 * MiB;
constexpr size_t OFF_ST = 107 * MiB;
constexpr size_t OFF_Z = 172 * MiB;
constexpr size_t WS_END = OFF_Z + 7 * PLANE * 2;
static_assert(OFF_H + PLANE * 2 <= OFF_QK && OFF_QK + PLANE * 2 <= OFF_ST && OFF_ST + (size_t)NCH * 8 * 32768 * 2 <= OFF_Z, "ws map");

struct Params {
    const float *x, *c, *ctx, *c_ctx, *w_ada, *b_ada, *norm1_g, *norm2_g, *w_in, *conv_w, *conv_b, *gate_b, *head_g, *vnorm_g, *w_sp, *b_sp, *w_pa, *w_pb, *w_out, *w_ff1, *w_ff3, *w_ff2, *final_g;
    float* out; unsigned char* ws;
};

__device__ __forceinline__ float bf_lo(unsigned w) { return __uint_as_float(w << 16); }
__device__ __forceinline__ float bf_hi(unsigned w) { return __uint_as_float(w & 0xffff0000u); }
typedef __bf16 bf16v2_t __attribute__((ext_vector_type(2)));
__device__ __forceinline__ unsigned cvt_pk_bf16(float lo, float hi) { const f32x2 v = {lo, hi}; const bf16v2_t b = __builtin_convertvector(v, bf16v2_t); return __builtin_bit_cast(unsigned, b); }
__device__ __forceinline__ float wave_sum(float v) {
#pragma unroll
    for (int o = 1; o < 64; o <<= 1) v += __shfl_xor(v, o);
    return v;
}
__device__ __forceinline__ float wave_max(float v) {
#pragma unroll
    for (int o = 1; o < 64; o <<= 1) v = fmaxf(v, __shfl_xor(v, o));
    return v;
}
__device__ __forceinline__ float sigmoidf_(float x) { return 1.0f / (1.0f + __expf(-x)); }
__device__ __forceinline__ float siluf_(float x) { return x / (1.0f + __expf(-x)); }
__device__ __forceinline__ float geluf_(float x) {
    const float y = 0.7978845608028654f * (x + 0.044715f * x * x * x);
    const float th = 1.0f - 2.0f / (1.0f + __expf(2.0f * y));
    return 0.5f * x * (1.0f + th);
}
__device__ __forceinline__ float logsigf_(float x) { return fminf(x, 0.0f) - log1pf(__expf(-fabsf(x))); }
#define LDS_WAIT() asm volatile("s_waitcnt lgkmcnt(0)" ::: "memory")

namespace pg8 {
constexpr int BM = 256, BK = 64, HALF = 128, HTB = HALF * BK * 2, STAGE_BYTES = 8 * HTB, NXCD = 8, WGM = 8;
__host__ __device__ __forceinline__ int lds_byte(int r, int c) { const int st = (r >> 4) * 2 + (c >> 5), rr = r & 15, cc = c & 31, ob = rr * 64 + cc * 2; return st * 1024 + (ob ^ (((ob >> 9) & 1) << 5)); }
__host__ __device__ __forceinline__ void stage_rc(int b, int& R, int& C) { const int st = b / 1024, sb = b % 1024, swz = sb ^ (((sb >> 9) & 1) << 5); R = (st >> 1) * 16 + swz / 64; C = (st & 1) * 32 + (swz % 64) / 2; }
__host__ __device__ __forceinline__ int perm32(int rho) { const int n = rho >> 4, i = rho & 15; return 8 * (i >> 2) + 4 * n + (i & 3); }

struct Unit { int pm, pn, seg; };
struct Gemm { const bf16_t* A0; const bf16_t* A1; const bf16_t* Bt; int K; int seg_pn_off; };
struct Sched {
    int nM, nN, nwg, G, c, nseg, pm0;
    __device__ void init(int nM_, int nN_, int G_, int c_, int nseg_, int pm0_) { nM = nM_; nN = nN_; nwg = nM * nN; G = G_; c = c_; nseg = nseg_; pm0 = pm0_; }
    __device__ bool next(int i, Unit& u) const {
        const int ii = i / nseg; u.seg = i - ii * nseg;
        const long L = (long)ii * G + c; if (L >= nwg) return false;
        int wgid = (int)L; { const int q = nwg / NXCD, r = nwg % NXCD, xcd = wgid % NXCD, off = wgid / NXCD; wgid = (xcd < r ? xcd * (q + 1) : r * (q + 1) + (xcd - r) * q) + off; }
        const int nig = WGM * nN, gid = wgid / nig, fm = gid * WGM, gsz = (nM - fm) < WGM ? (nM - fm) : WGM;
        u.pm = pm0 + fm + ((wgid % nig) % gsz); u.pn = (wgid % nig) / gsz; return true;
    }
};

template <class Epi>
__device__ __forceinline__ void gemm_phase(LAS unsigned char* lds, const Gemm g, const Sched& S, const Epi& E, const int tid) {
    const int wid = __builtin_amdgcn_readfirstlane(tid >> 6), lane = tid & 63, wr = wid >> 2, wc = wid & 3, fr = lane & 15, fq = lane >> 4;
    const int K = g.K, nt = K / BK;
    unsigned voffA[2], voffB[2];
#pragma unroll
    for (int i = 0; i < 2; ++i) { int R, C; stage_rc(tid * 16 + i * 8192, R, C); const int Rb = Epi::PERM ? ((R & ~31) + perm32(R & 31)) : R;
        voffA[i] = (unsigned)(R * K + C) * 2u; voffB[i] = (unsigned)(Rb * K + C) * 2u; }
    const size_t kstep = (size_t)(BK * 2);
    const size_t hstep = (size_t)HALF * K * 2;
    const size_t tstep = 2 * hstep;
    const unsigned ldsw = (unsigned)wid * 1024u;
    const int aoff = lds_byte(wr * 64 + fr, fq * 8), boff = lds_byte(wc * 32 + fr, fq * 8);
#define PG8_SA(b, h) (((b) * 2 + (h)) * HTB)
#define PG8_SB(b, h) ((4 + (b) * 2 + (h)) * HTB)
#define PG8_STAGE(bufoff, gbase, voff) do { _Pragma("unroll") for (int _i = 0; _i < 2; ++_i) \
        __builtin_amdgcn_global_load_lds((const unsigned*)((const char*)(gbase) + (voff)[_i]), (LAS unsigned*)(lds + (bufoff) + ldsw + _i * 8192), 16, 0, 0); } while (0)
#define PG8_LDA(dst, b, h) do { _Pragma("unroll") for (int m = 0; m < 4; ++m) _Pragma("unroll") for (int k = 0; k < 2; ++k) dst[m][k] = *(const LAS bf16x8*)(lds + PG8_SA(b, h) + aoff + m * 2048 + k * 1024); } while (0)
#define PG8_LDB(dst, b, h) do { _Pragma("unroll") for (int n = 0; n < 2; ++n) _Pragma("unroll") for (int k = 0; k < 2; ++k) dst[n][k] = *(const LAS bf16x8*)(lds + PG8_SB(b, h) + boff + n * 2048 + k * 1024); } while (0)
#define PG8_MMA(ai, bj, At, Bt) do { __builtin_amdgcn_s_setprio(1); _Pragma("unroll") for (int m = 0; m < 4; ++m) _Pragma("unroll") for (int n = 0; n < 2; ++n) _Pragma("unroll") for (int k = 0; k < 2; ++k) \
        acc[ai][bj][m][n] = __builtin_amdgcn_mfma_f32_16x16x32_bf16(Bt[n][k], At[m][k], acc[ai][bj][m][n], 0, 0, 0); __builtin_amdgcn_s_setprio(0); } while (0)
#define PG8_WAIT_V(n) asm volatile("s_waitcnt vmcnt(" #n ")" ::: "memory")
#define PG8_WAIT_L(n) asm volatile("s_waitcnt lgkmcnt(" #n ")" ::: "memory")
#define PG8_BAR __builtin_amdgcn_s_barrier()
#define PG8_SCHED __builtin_amdgcn_sched_barrier(0)
    Unit cur, nxt; int ui = 0;
    if (!S.next(0, cur)) return;
    f32x4 acc[2][2][4][2];
#pragma unroll
    for (int a = 0; a < 2; ++a)
#pragma unroll
        for (int b = 0; b < 2; ++b)
#pragma unroll
            for (int m = 0; m < 4; ++m)
#pragma unroll
                for (int n = 0; n < 2; ++n) acc[a][b][m][n] = (f32x4){0.f, 0.f, 0.f, 0.f};
    bf16x8 At[4][2], B0[2][2], B1[2][2];
    const char* cA = (const char*)(cur.seg ? g.A1 : g.A0) + (size_t)cur.pm * tstep; const char* cB = (const char*)g.Bt + (size_t)(cur.pn + cur.seg * g.seg_pn_off) * tstep;
    PG8_STAGE(PG8_SB(0, 0), cB, voffB); PG8_STAGE(PG8_SA(0, 0), cA, voffA); PG8_STAGE(PG8_SB(0, 1), cB + hstep, voffB); PG8_STAGE(PG8_SA(0, 1), cA + hstep, voffA);
    if (wr == 1) PG8_BAR;
    PG8_WAIT_V(4); PG8_BAR;
    PG8_STAGE(PG8_SB(1, 0), cB + kstep, voffB); PG8_STAGE(PG8_SA(1, 0), cA + kstep, voffA); PG8_STAGE(PG8_SB(1, 1), cB + hstep + kstep, voffB);
    PG8_WAIT_V(6); PG8_BAR;
    for (;;) {
        const bool has_next = S.next(ui + 1, nxt);
        const char* nA = has_next ? (const char*)(nxt.seg ? g.A1 : g.A0) + (size_t)nxt.pm * tstep : cA;
        const char* nB = has_next ? (const char*)g.Bt + (size_t)(nxt.pn + nxt.seg * g.seg_pn_off) * tstep : cB;
        for (int t = 0; t < nt; t += 2) {
            const bool last = (t == nt - 2);
            const char* a1 = cA + (size_t)(t + 1) * kstep;
            const char* a2 = last ? nA : cA + (size_t)(t + 2) * kstep; const char* b2 = last ? nB : cB + (size_t)(t + 2) * kstep;
            const char* a3 = a2 + kstep; const char* b3 = b2 + kstep;
            PG8_LDB(B0, 0, 0); PG8_SCHED; PG8_LDA(At, 0, 0); PG8_STAGE(PG8_SA(1, 1), a1 + hstep, voffA);
            PG8_WAIT_L(8); PG8_BAR; PG8_WAIT_L(0); PG8_MMA(0, 0, At, B0); PG8_BAR; PG8_SCHED;
            PG8_LDB(B1, 0, 1); PG8_STAGE(PG8_SB(0, 0), b2, voffB);
            PG8_BAR; PG8_WAIT_L(0); PG8_MMA(0, 1, At, B1); PG8_BAR;
            PG8_LDA(At, 0, 1); PG8_STAGE(PG8_SA(0, 0), a2, voffA);
            PG8_BAR; PG8_WAIT_L(0); PG8_MMA(1, 0, At, B0); PG8_BAR; PG8_SCHED;
            PG8_STAGE(PG8_SB(0, 1), b2 + hstep, voffB);
            PG8_WAIT_V(6); PG8_BAR; PG8_MMA(1, 1, At, B1); PG8_BAR;
            PG8_LDB(B0, 1, 0); PG8_SCHED; PG8_LDA(At, 1, 0); PG8_STAGE(PG8_SA(0, 1), a2 + hstep, voffA);
            PG8_WAIT_L(8); PG8_BAR; PG8_WAIT_L(0); PG8_MMA(0, 0, At, B0); PG8_BAR; PG8_SCHED;
            PG8_LDB(B1, 1, 1); PG8_STAGE(PG8_SB(1, 0), b3, voffB);
            PG8_BAR; PG8_WAIT_L(0); PG8_MMA(0, 1, At, B1); PG8_BAR;
            PG8_LDA(At, 1, 1); PG8_STAGE(PG8_SA(1, 0), a3, voffA);
            PG8_BAR; PG8_WAIT_L(0); PG8_MMA(1, 0, At, B0); PG8_BAR; PG8_SCHED;
            PG8_STAGE(PG8_SB(1, 1), b3 + hstep, voffB);
            PG8_WAIT_V(6); PG8_BAR; PG8_MMA(1, 1, At, B1); PG8_BAR;
        }
        const bool zero = E(acc, cur, wr, wc, fr, fq);
        if (!has_next) break;
        if (zero) {
#pragma unroll
            for (int a = 0; a < 2; ++a)
#pragma unroll
                for (int b = 0; b < 2; ++b)
#pragma unroll
                    for (int m = 0; m < 4; ++m)
#pragma unroll
                        for (int n = 0; n < 2; ++n) acc[a][b][m][n] = (f32x4){0.f, 0.f, 0.f, 0.f};
        }
        cur = nxt; cA = nA; cB = nB; ++ui;
    }
    PG8_WAIT_V(0);
    if (wr == 0) PG8_BAR;
    PG8_BAR;
#undef PG8_SA
#undef PG8_SB
#undef PG8_STAGE
#undef PG8_LDA
#undef PG8_LDB
#undef PG8_MMA
#undef PG8_WAIT_V
#undef PG8_WAIT_L
#undef PG8_BAR
#undef PG8_SCHED
}
}

typedef f32x4 AccT[2][2][4][2];
struct EpiZ {
    static constexpr bool PERM = true;
    bf16_t* Z;
    __device__ __forceinline__ bool operator()(AccT& acc, const pg8::Unit& u, int wr, int wc, int fr, int fq) const {
        const int row0 = u.pm * 256 + wr * 64 + fr; const int colt = u.pn * 256; const int plane = colt >> 10;
        bf16_t* base = Z + (size_t)plane * PLANE + (colt & 1023) + wc * 32 + 8 * fq;
#pragma unroll
        for (int ai = 0; ai < 2; ++ai)
#pragma unroll
            for (int m = 0; m < 4; ++m) { bf16_t* rowp = base + (size_t)(row0 + ai * 128 + m * 16) * 1024;
#pragma unroll
                for (int bj = 0; bj < 2; ++bj) { const f32x4 v0 = acc[ai][bj][m][0], v1 = acc[ai][bj][m][1];
                    u32x4 w; w.x = cvt_pk_bf16(v0[0], v0[1]); w.y = cvt_pk_bf16(v0[2], v0[3]); w.z = cvt_pk_bf16(v1[0], v1[1]); w.w = cvt_pk_bf16(v1[2], v1[3]);
                    *(u32x4*)(rowp + bj * 128) = w; } }
        return true;
    }
};
struct EpiMerge {
    static constexpr bool PERM = true;
    const bf16_t* GA; const bf16_t* GB; bf16_t* O;
    __device__ __forceinline__ bool operator()(AccT& acc, const pg8::Unit& u, int wr, int wc, int fr, int fq) const {
        const int row0 = u.pm * 256 + wr * 64 + fr; const int col0 = u.pn * 256 + wc * 32 + 8 * fq;
#pragma unroll
        for (int ai = 0; ai < 2; ++ai)
#pragma unroll
            for (int m = 0; m < 4; ++m) { const size_t ro = (size_t)(row0 + ai * 128 + m * 16) * 1024 + col0;
#pragma unroll
                for (int bj = 0; bj < 2; ++bj) {
                    const u32x4 gb = *(const u32x4*)(GB + ro + bj * 128);
                    float b[8] = {bf_lo(gb.x), bf_hi(gb.x), bf_lo(gb.y), bf_hi(gb.y), bf_lo(gb.z), bf_hi(gb.z), bf_lo(gb.w), bf_hi(gb.w)};
                    if (u.seg == 0) {
                        const u32x4 ga = *(const u32x4*)(GA + ro + bj * 128);
                        float a[8] = {bf_lo(ga.x), bf_hi(ga.x), bf_lo(ga.y), bf_hi(ga.y), bf_lo(ga.z), bf_hi(ga.z), bf_lo(ga.w), bf_hi(ga.w)};
#pragma unroll
                        for (int j = 0; j < 8; ++j) { const float r = sigmoidf_(a[j]) * (1.0f + __expf(-b[j])); acc[ai][bj][m][j >> 2][j & 3] *= r; }
                    } else {
                        float v[8];
#pragma unroll
                        for (int j = 0; j < 8; ++j) v[j] = acc[ai][bj][m][j >> 2][j & 3] * sigmoidf_(b[j]);
                        u32x4 w; w.x = cvt_pk_bf16(v[0], v[1]); w.y = cvt_pk_bf16(v[2], v[3]); w.z = cvt_pk_bf16(v[4], v[5]); w.w = cvt_pk_bf16(v[6], v[7]);
                        *(u32x4*)(O + ro + bj * 128) = w;
                    }
                } }
        return u.seg != 0;
    }
};
struct EpiRes {
    static constexpr bool PERM = false;
    float* out; float* cs; const float* gx; const float* gc;
    __device__ __forceinline__ bool operator()(AccT& acc, const pg8::Unit& u, int wr, int wc, int fr, int fq) const {
        const bool isc = (u.pm == 0);
        float* base = isc ? cs : out - (size_t)NCTX * 1024; const float* gv = isc ? gc : gx;
        const int row0 = u.pm * 256 + wr * 64 + fr, col0 = u.pn * 256 + wc * 32 + 4 * fq;
        f32x4 g4[2][2];
#pragma unroll
        for (int bj = 0; bj < 2; ++bj)
#pragma unroll
            for (int n = 0; n < 2; ++n) g4[bj][n] = *(const f32x4*)(gv + col0 + bj * 128 + n * 16);
#pragma unroll
        for (int ai = 0; ai < 2; ++ai)
#pragma unroll
            for (int m = 0; m < 4; ++m) { float* rowp = base + (size_t)(row0 + ai * 128 + m * 16) * 1024 + col0;
#pragma unroll
                for (int bj = 0; bj < 2; ++bj)
#pragma unroll
                    for (int n = 0; n < 2; ++n) { f32x4* p = (f32x4*)(rowp + bj * 128 + n * 16); *p = *p + g4[bj][n] * acc[ai][bj][m][n]; } }
        return true;
    }
};
struct EpiSwiglu {
    static constexpr bool PERM = true;
    bf16_t* FM;
    __device__ __forceinline__ bool operator()(AccT& acc, const pg8::Unit& u, int wr, int wc, int fr, int fq) const {
        const int row0 = u.pm * 256 + wr * 64 + fr, col0 = u.pn * 128 + wc * 32 + 8 * fq;
#pragma unroll
        for (int ai = 0; ai < 2; ++ai)
#pragma unroll
            for (int m = 0; m < 4; ++m) {
                float v[8];
#pragma unroll
                for (int j = 0; j < 8; ++j) v[j] = siluf_(acc[ai][0][m][j >> 2][j & 3]) * acc[ai][1][m][j >> 2][j & 3];
                u32x4 w; w.x = cvt_pk_bf16(v[0], v[1]); w.y = cvt_pk_bf16(v[2], v[3]); w.z = cvt_pk_bf16(v[4], v[5]); w.w = cvt_pk_bf16(v[6], v[7]);
                *(u32x4*)(FM + (size_t)(row0 + ai * 128 + m * 16) * DFF + col0) = w; }
        return true;
    }
};

__device__ __forceinline__ void transpose_item(const float* W, int ldw, int src_col0, int k0, bf16_t* WT, int K, int dst_row0, LAS float* scr, int lane) {
#pragma unroll 8
    for (int i = 0; i < 32; ++i) { const int kk = 2 * i + (lane >> 5); scr[kk * 33 + (lane & 31)] = W[(size_t)(k0 + kk) * ldw + src_col0 + (lane & 31)]; }
    LDS_WAIT();
    const int c = lane & 7;
#pragma unroll
    for (int j = 0; j < 4; ++j) { const int n = (lane >> 3) + 8 * j; const LAS float* s = scr + (8 * c) * 33 + n;
        u32x4 o; o.x = cvt_pk_bf16(s[0 * 33], s[1 * 33]); o.y = cvt_pk_bf16(s[2 * 33], s[3 * 33]); o.z = cvt_pk_bf16(s[4 * 33], s[5 * 33]); o.w = cvt_pk_bf16(s[6 * 33], s[7 * 33]);
        *(u32x4*)(WT + (size_t)(dst_row0 + n) * K + k0 + 8 * c) = o; }
    LDS_WAIT();
}
__device__ __forceinline__ void convert_weights(const Params& p, int l, LAS unsigned char* lds_scr, int gw, int NGW, int wave, int lane) {
    LAS float* scr = (LAS float*)(lds_scr + wave * 8448);
    bf16_t* wb = (bf16_t*)(p.ws + OFF_WB);
    constexpr int I_IN = 16 * 224, I_SQ = 16 * 32, I_F = 16 * 88, I_2 = 44 * 32;
    constexpr int NIT = I_IN + 3 * I_SQ + 2 * I_F + I_2;
    for (int it = gw; it < NIT; it += NGW) {
        int r = it;
        if (r < I_IN) { const int kb = r / 224, nb = r % 224; const int dc = nb * 32; const int sc = dc + (dc >= 3072 ? 16 : 0);
            transpose_item(p.w_in + (size_t)l * 1024 * INW, INW, sc, kb * 64, wb + WB_WIN / 2, 1024, dc, scr, lane); continue; } r -= I_IN;
        if (r < I_SQ) { const int kb = r / 32, nb = r % 32; transpose_item(p.w_pa + (size_t)l * 1024 * 1024, 1024, nb * 32, kb * 64, wb + WB_WPAB / 2, 1024, nb * 32, scr, lane); continue; } r -= I_SQ;
        if (r < I_SQ) { const int kb = r / 32, nb = r % 32; transpose_item(p.w_pb + (size_t)l * 1024 * 1024, 1024, nb * 32, kb * 64, wb + WB_WPAB / 2, 1024, 1024 + nb * 32, scr, lane); continue; } r -= I_SQ;
        if (r < I_SQ) { const int kb = r / 32, nb = r % 32; transpose_item(p.w_out + (size_t)l * 1024 * 1024, 1024, nb * 32, kb * 64, wb + WB_WOUT / 2, 1024, nb * 32, scr, lane); continue; } r -= I_SQ;
        if (r < I_F) { const int kb = r / 88, nb = r % 88; const int j0 = nb * 32; transpose_item(p.w_ff1 + (size_t)l * 1024 * DFF, DFF, j0, kb * 64, wb + WB_W13 / 2, 1024, 256 * (j0 >> 7) + (j0 & 127), scr, lane); continue; } r -= I_F;
        if (r < I_F) { const int kb = r / 88, nb = r % 88; const int j0 = nb * 32; transpose_item(p.w_ff3 + (size_t)l * 1024 * DFF, DFF, j0, kb * 64, wb + WB_W13 / 2, 1024, 256 * (j0 >> 7) + 128 + (j0 & 127), scr, lane); continue; } r -= I_F;
        { const int kb = r / 32, nb = r % 32; transpose_item(p.w_ff2 + (size_t)l * DFF * 1024, 1024, nb * 32, kb * 64, wb + WB_W2 / 2, DFF, nb * 32, scr, lane); }
    }
}

__device__ __forceinline__ void mods_phase(const Params& p, LAS unsigned char* lds, int tid, int wave, int lane) {
    LAS float* sc = (LAS float*)lds; LAS float* scc = sc + 1024; LAS float* red = scc + 1024;
    float* MOD = (float*)(p.ws + OFF_MOD);
    for (int i = tid; i < 1024; i += NTHREADS) { sc[i] = siluf_(p.c[i]); scc[i] = siluf_(p.c_ctx[i]); }
    __syncthreads();
    for (int item = blockIdx.x; item < 4 * 96; item += gridDim.x) {
        const int l = item / 96, col = (item % 96) * 64 + lane;
        const float* w = p.w_ada + (size_t)l * 1024 * 6144 + col;
        float ax = 0.f, ac = 0.f;
#pragma unroll 8
        for (int d = wave * 128; d < wave * 128 + 128; ++d) { const float wv = w[(size_t)d * 6144]; ax += sc[d] * wv; ac += scc[d] * wv; }
        red[(wave * 64 + lane) * 2] = ax; red[(wave * 64 + lane) * 2 + 1] = ac;
        __syncthreads();
        if (wave == 0) { float sx = 0.f, s2 = 0.f;
#pragma unroll
            for (int w8 = 0; w8 < 8; ++w8) { sx += red[(w8 * 64 + lane) * 2]; s2 += red[(w8 * 64 + lane) * 2 + 1]; }
            const float b = p.b_ada[l * 6144 + col];
            MOD[(size_t)(l * 2 + 0) * 6144 + col] = sx + b; MOD[(size_t)(l * 2 + 1) * 6144 + col] = s2 + b; }
        __syncthreads();
    }
}

template <bool GATES>
__device__ __forceinline__ void norm_phase(const Params& p, int l, LAS unsigned char* lds, int gw, int NGW, int tid, int lane) {
    const float* MOD = (const float*)(p.ws + OFF_MOD);
    float* CS = (float*)(p.ws + OFF_CS); bf16_t* H = (bf16_t*)(p.ws + OFF_H); float* G = (float*)(p.ws + OFF_G);
    const float* ng = (GATES ? p.norm1_g : p.norm2_g) + l * 1024;
    LAS float* wg = (LAS float*)lds;
    if (GATES) {
        const float* wsrc = p.w_in + (size_t)l * 1024 * INW + 3072;
        for (int i = tid; i < 16384; i += NTHREADS) { const int k = i >> 4, j = i & 15; wg[j * 1024 + k] = wsrc[(size_t)k * INW + j]; }
        __syncthreads();
    }
    const bool first = GATES && (l == 0);
    for (int grp = gw; grp < T / 4; grp += NGW) {
        const int row0 = grp * 4; const bool isc = row0 < NCTX;
        const float* modp = MOD + (size_t)(l * 2 + (isc ? 1 : 0)) * 6144 + (GATES ? 0 : 3072);
        f32x4 gm[4], sh[4];
#pragma unroll
        for (int j = 0; j < 4; ++j) { const int col = 4 * lane + 256 * j; const f32x4 g4 = *(const f32x4*)(ng + col); const f32x4 s4 = *(const f32x4*)(modp + 1024 + col);
            sh[j] = *(const f32x4*)(modp + col); gm[j] = g4 * (s4 + 1.0f); }
        f32x4 xv[4][4];
#pragma unroll
        for (int r = 0; r < 4; ++r) {
            const int row = row0 + r;
            const float* src = first ? (isc ? p.ctx + (size_t)row * 1024 : p.x + (size_t)(row - NCTX) * 1024) : (isc ? CS + (size_t)row * 1024 : p.out + (size_t)(row - NCTX) * 1024);
#pragma unroll
            for (int j = 0; j < 4; ++j) xv[r][j] = *(const f32x4*)(src + 4 * lane + 256 * j);
        }
        if (first) {
#pragma unroll
            for (int r = 0; r < 4; ++r) { const int row = row0 + r; float* dst = isc ? CS + (size_t)row * 1024 : p.out + (size_t)(row - NCTX) * 1024;
#pragma unroll
                for (int j = 0; j < 4; ++j) *(f32x4*)(dst + 4 * lane + 256 * j) = xv[r][j]; }
        }
#pragma unroll
        for (int r = 0; r < 4; ++r) {
            float s = 0.f;
#pragma unroll
            for (int j = 0; j < 4; ++j) s += (xv[r][j][0] * xv[r][j][0] + xv[r][j][1] * xv[r][j][1]) + (xv[r][j][2] * xv[r][j][2] + xv[r][j][3] * xv[r][j][3]);
            const float rstd = rsqrtf(wave_sum(s) * (1.0f / 1024.0f) + EPS);
            bf16_t* hrow = H + (size_t)(row0 + r) * 1024;
#pragma unroll
            for (int j = 0; j < 4; ++j) { xv[r][j] = xv[r][j] * rstd * gm[j] + sh[j];
                u32x2 w; w.x = cvt_pk_bf16(xv[r][j][0], xv[r][j][1]); w.y = cvt_pk_bf16(xv[r][j][2], xv[r][j][3]);
                *(u32x2*)(hrow + 4 * lane + 256 * j) = w; }
        }
        if (GATES) {
            float v[64];
#pragma unroll
            for (int i = 0; i < 64; ++i) v[i] = 0.f;
#pragma unroll
            for (int gi = 0; gi < 16; ++gi)
#pragma unroll
                for (int j = 0; j < 4; ++j) { const f32x4 w4 = *(const LAS f32x4*)(wg + gi * 1024 + 4 * lane + 256 * j);
#pragma unroll
                    for (int r = 0; r < 4; ++r) v[r * 16 + gi] += (xv[r][j][0] * w4[0] + xv[r][j][1] * w4[1]) + (xv[r][j][2] * w4[2] + xv[r][j][3] * w4[3]); }
#pragma unroll
            for (int i = 0; i < 32; ++i) { const bool hi = (lane & 32) != 0; const float keep = hi ? v[i + 32] : v[i]; const float send = hi ? v[i] : v[i + 32]; v[i] = keep + __shfl_xor(send, 32); }
#pragma unroll
            for (int i = 0; i < 16; ++i) { const bool hi = (lane & 16) != 0; const float keep = hi ? v[i + 16] : v[i]; const float send = hi ? v[i] : v[i + 16]; v[i] = keep + __shfl_xor(send, 16); }
#pragma unroll
            for (int i = 0; i < 8; ++i) { const bool hi = (lane & 8) != 0; const float keep = hi ? v[i + 8] : v[i]; const float send = hi ? v[i] : v[i + 8]; v[i] = keep + __shfl_xor(send, 8); }
#pragma unroll
            for (int i = 0; i < 4; ++i) { const bool hi = (lane & 4) != 0; const float keep = hi ? v[i + 4] : v[i]; const float send = hi ? v[i] : v[i + 4]; v[i] = keep + __shfl_xor(send, 4); }
#pragma unroll
            for (int i = 0; i < 2; ++i) { const bool hi = (lane & 2) != 0; const float keep = hi ? v[i + 2] : v[i]; const float send = hi ? v[i] : v[i + 2]; v[i] = keep + __shfl_xor(send, 2); }
            { const bool hi = (lane & 1) != 0; const float keep = hi ? v[1] : v[0]; const float send = hi ? v[0] : v[1]; v[0] = keep + __shfl_xor(send, 1); }
            const int gate = lane & 15;
            float val = v[0] + p.gate_b[l * 16 + gate];
            if (gate & 4) val = logsigf_(val);
            G[(size_t)row0 * 16 + lane] = val;
        }
    }
}

__device__ __forceinline__ void final_norm(const Params& p, int gw, int NGW, int lane) {
    f32x4 g4[4];
#pragma unroll
    for (int j = 0; j < 4; ++j) g4[j] = *(const f32x4*)(p.final_g + 4 * lane + 256 * j);
    for (int row = gw; row < T - NCTX; row += NGW) {
        float* rp = p.out + (size_t)row * 1024; f32x4 xv[4]; float s = 0.f;
#pragma unroll
        for (int j = 0; j < 4; ++j) { xv[j] = *(const f32x4*)(rp + 4 * lane + 256 * j); s += (xv[j][0] * xv[j][0] + xv[j][1] * xv[j][1]) + (xv[j][2] * xv[j][2] + xv[j][3] * xv[j][3]); }
        const float rstd = rsqrtf(wave_sum(s) * (1.0f / 1024.0f) + EPS);
#pragma unroll
        for (int j = 0; j < 4; ++j) { f32x4 o = xv[j] * rstd * g4[j];
#ifdef DBG_SANITIZE
#pragma unroll
            for (int e = 0; e < 4; ++e) if (!(fabsf(o[e]) < 1e30f)) o[e] = 10000.0f;
#endif
            *(f32x4*)(rp + 4 * lane + 256 * j) = o; }
    }
}

constexpr size_t OFF_FLAG = 300 * 1024;
#define FLAGBAD(cond, code) do { if (cond) atomicMin((unsigned*)(p.ws + OFF_FLAG), (unsigned)(code)); } while (0)
constexpr int LROW = 272;
__device__ __forceinline__ float wave_incl_sum(float v, int lane) {
#pragma unroll
    for (int o = 1; o < 64; o <<= 1) { const float t = __shfl_up(v, o); if (lane >= o) v += t; }
    return v;
}
__device__ __forceinline__ float wave_incl_max(float v, int lane) {
#pragma unroll
    for (int o = 1; o < 64; o <<= 1) { const float t = __shfl_up(v, o); if (lane >= o) v = fmaxf(v, t); }
    return v;
}

__device__ __forceinline__ void mixA_mlstm(const Params& p, int l, int c, int h, LAS unsigned char* lds, int tid, int wave, int lane) {
    const int fr = lane & 15, fq = lane >> 4;
    bf16_t* Z = (bf16_t*)(p.ws + OFF_Z); bf16_t* QK = (bf16_t*)(p.ws + OFF_QK); bf16_t* ST = (bf16_t*)(p.ws + OFF_ST);
    const float* G = (const float*)(p.ws + OFF_G); float* SC = (float*)(p.ws + OFF_SC); float* NS = (float*)(p.ws + OFF_NS);
    LAS unsigned char* KT = lds; LAS unsigned char* VT = lds + 128 * LROW;
    LAS float* wsrc = (LAS float*)(lds + 384 * LROW); LAS float* red = wsrc + 256;
    const int t0 = c * 128; const int seq_lo = (c < 2) ? 0 : NCTX, seq_hi = (c < 2) ? NCTX : T;
    const float* cw = p.conv_w + (size_t)l * 5 * 1024; const float* cb = p.conv_b + (size_t)l * 1024;
#pragma unroll 1
    for (int qk = 0; qk < 2; ++qk) {
        const int ch = qk * 512 + h * 128 + (tid & 15) * 8;
        float wv[5][8], bv[8];
#pragma unroll
        for (int j = 0; j < 5; ++j) { const f32x4 a = *(const f32x4*)(cw + j * 1024 + ch), b = *(const f32x4*)(cw + j * 1024 + ch + 4);
            wv[j][0] = a[0]; wv[j][1] = a[1]; wv[j][2] = a[2]; wv[j][3] = a[3]; wv[j][4] = b[0]; wv[j][5] = b[1]; wv[j][6] = b[2]; wv[j][7] = b[3]; }
        { const f32x4 a = *(const f32x4*)(cb + ch), b = *(const f32x4*)(cb + ch + 4); bv[0] = a[0]; bv[1] = a[1]; bv[2] = a[2]; bv[3] = a[3]; bv[4] = b[0]; bv[5] = b[1]; bv[6] = b[2]; bv[7] = b[3]; }
#pragma unroll 1
        for (int ps = 0; ps < 4; ++ps) {
            const int tok = (tid >> 4) + 32 * ps; const int t = t0 + tok;
            float a[8];
#pragma unroll
            for (int e = 0; e < 8; ++e) a[e] = bv[e];
#pragma unroll
            for (int j = 0; j < 5; ++j) { const int tt = t + j - 2;
                if (tt >= seq_lo && tt < seq_hi) { const u32x4 r = *(const u32x4*)(Z + (size_t)tt * 1024 + ch);
                    a[0] += wv[j][0] * bf_lo(r.x); a[1] += wv[j][1] * bf_hi(r.x); a[2] += wv[j][2] * bf_lo(r.y); a[3] += wv[j][3] * bf_hi(r.y);
                    a[4] += wv[j][4] * bf_lo(r.z); a[5] += wv[j][5] * bf_hi(r.z); a[6] += wv[j][6] * bf_lo(r.w); a[7] += wv[j][7] * bf_hi(r.w); } }
            const float scl = qk ? 1.0f : 0.08838834764831845f;
#pragma unroll
            for (int e = 0; e < 8; ++e) a[e] = siluf_(a[e]) * scl;
            u32x4 w; w.x = cvt_pk_bf16(a[0], a[1]); w.y = cvt_pk_bf16(a[2], a[3]); w.z = cvt_pk_bf16(a[4], a[5]); w.w = cvt_pk_bf16(a[6], a[7]);
            *(u32x4*)(QK + (size_t)t * 1024 + ch) = w;
            if (qk) { const int dk0 = (tid & 15) * 8;
                const unsigned ww[4] = {w.x, w.y, w.z, w.w};
#pragma unroll
                for (int e = 0; e < 8; ++e) *(LAS bf16_t*)(KT + (dk0 + e) * LROW + tok * 2) = (bf16_t)((e & 1) ? (ww[e >> 1] >> 16) : (ww[e >> 1] & 0xffffu)); }
        }
    }
    bf16_t* Zv = Z + PLANE + (size_t)t0 * 1024 + h * 256;
#pragma unroll 1
    for (int ps = 0; ps < 8; ++ps) {
        const int tok = (tid >> 5) + 16 * ps; const int d0 = (tid & 31) * 8;
        const u32x4 r = *(const u32x4*)(Zv + (size_t)tok * 1024 + d0);
        const unsigned ww[4] = {r.x, r.y, r.z, r.w};
#pragma unroll
        for (int e = 0; e < 8; ++e) *(LAS bf16_t*)(VT + (d0 + e) * LROW + tok * 2) = (bf16_t)((e & 1) ? (ww[e >> 1] >> 16) : (ww[e >> 1] & 0xffffu));
    }
    if (wave < 2) {
        const int dir = wave;
        const int r0 = dir ? 127 - 2 * lane : 2 * lane, r1 = dir ? r0 - 1 : r0 + 1;
        const float* gp = G + (size_t)t0 * 16 + dir * 8 + h;
        const float i0 = gp[r0 * 16], f0 = gp[r0 * 16 + 4], i1 = gp[r1 * 16], f1 = gp[r1 * 16 + 4];
        const float s = f0 + f1; const float incl = wave_incl_sum(s, lane); const float b0 = incl - s + f0, b1 = incl;
        const float B0 = i0 - b0, B1 = i1 - b1;
        const float cmB = wave_max(fmaxf(B0, B1)); const float bend = __shfl(b1, 63);
        wsrc[dir * 128 + r0] = __expf(B0 - cmB); wsrc[dir * 128 + r1] = __expf(B1 - cmB);
        if (lane == 0) { SC[((c * 2 + dir) * 4 + h) * 2] = bend; SC[((c * 2 + dir) * 4 + h) * 2 + 1] = bend + cmB; }
    }
    __syncthreads();
#pragma unroll 1
    for (int ps = 0; ps < 8; ++ps) {
        const int dv = (tid >> 4) + 32 * ps, chn = tid & 15;
        const u32x4 r = *(const LAS u32x4*)(VT + dv * LROW + chn * 16);
        *(u32x4*)(Zv + (size_t)(dv >> 1) * 1024 + (dv & 1) * 128 + chn * 8) = r;
    }
#pragma unroll 1
    for (int dir = 0; dir < 2; ++dir) {
        f32x4 acc[2][8];
#pragma unroll
        for (int m = 0; m < 2; ++m)
#pragma unroll
            for (int n = 0; n < 8; ++n) acc[m][n] = (f32x4){0.f, 0.f, 0.f, 0.f};
#pragma unroll
        for (int ks = 0; ks < 4; ++ks) {
            const LAS float* wp = wsrc + dir * 128 + 32 * ks + 8 * fq;
            const f32x4 w0 = *(const LAS f32x4*)wp, w1 = *(const LAS f32x4*)(wp + 4);
#ifdef DBG_CHECK
            if (l == 0) { bool b = false;
                for (int e = 0; e < 4; ++e) { if (!(w0[e] >= 0.f && w0[e] <= 1.0001f)) b = true; if (!(w1[e] >= 0.f && w1[e] <= 1.0001f)) b = true; }
                FLAGBAD(b, 71); }
#endif
            bf16x8 af[2];
#pragma unroll
            for (int m = 0; m < 2; ++m) { const u32x4 r = *(const LAS u32x4*)(VT + (32 * wave + 16 * m + fr) * LROW + 64 * ks + 16 * fq);
                u32x4 o; o.x = cvt_pk_bf16(bf_lo(r.x) * w0[0], bf_hi(r.x) * w0[1]); o.y = cvt_pk_bf16(bf_lo(r.y) * w0[2], bf_hi(r.y) * w0[3]);
                o.z = cvt_pk_bf16(bf_lo(r.z) * w1[0], bf_hi(r.z) * w1[1]); o.w = cvt_pk_bf16(bf_lo(r.w) * w1[2], bf_hi(r.w) * w1[3]);
                af[m] = __builtin_bit_cast(bf16x8, o);
#ifdef DBG_CHECK
                if (l == 0) { bool b = false; const unsigned rr[4] = {r.x, r.y, r.z, r.w};
                    for (int e = 0; e < 4; ++e) { if (!(fabsf(bf_lo(rr[e])) < 1e4f)) b = true; if (!(fabsf(bf_hi(rr[e])) < 1e4f)) b = true; }
                    FLAGBAD(b, 72); }
#endif
            }
#pragma unroll
            for (int n = 0; n < 8; ++n) { const bf16x8 bfv = *(const LAS bf16x8*)(KT + (16 * n + fr) * LROW + 64 * ks + 16 * fq);
#ifdef DBG_CHECK
                if (l == 0) { bool b = false; const u32x4 rk = __builtin_bit_cast(u32x4, bfv); const unsigned rr[4] = {rk.x, rk.y, rk.z, rk.w};
                    for (int e = 0; e < 4; ++e) { if (!(fabsf(bf_lo(rr[e])) < 1e4f)) b = true; if (!(fabsf(bf_hi(rr[e])) < 1e4f)) b = true; }
                    FLAGBAD(b, 73); }
#endif
#pragma unroll
                for (int m = 0; m < 2; ++m) acc[m][n] = __builtin_amdgcn_mfma_f32_16x16x32_bf16(bfv, af[m], acc[m][n], 0, 0, 0); }
        }
#ifdef DBG_CHECK
        if (l == 0) { bool b = false;
            for (int m = 0; m < 2; ++m) for (int n = 0; n < 8; ++n) for (int e = 0; e < 4; ++e) if (!(fabsf(acc[m][n][e]) < 1e6f)) b = true;
            FLAGBAD(b, 74); }
#endif
        bf16_t* st = ST + (size_t)((c * 2 + dir) * 4 + h) * 32768;
#pragma unroll
        for (int m = 0; m < 2; ++m)
#pragma unroll
            for (int n = 0; n < 8; ++n) { u32x2 w; w.x = cvt_pk_bf16(acc[m][n][0], acc[m][n][1]); w.y = cvt_pk_bf16(acc[m][n][2], acc[m][n][3]);
                *(u32x2*)(st + (32 * wave + 16 * m + fr) * 128 + 16 * n + 4 * fq) = w; }
        { const int dk = tid & 127, part = tid >> 7; float s = 0.f;
#pragma unroll 8
          for (int e = 0; e < 32; ++e) { const int sidx = part * 32 + e; s += wsrc[dir * 128 + sidx] * __uint_as_float(((unsigned)*(const LAS bf16_t*)(KT + dk * LROW + sidx * 2)) << 16); }
          red[(dir * 4 + part) * 128 + dk] = s; }
    }
    __syncthreads();
    if (tid < 256) { const int dir = tid >> 7, dk = tid & 127;
        NS[(size_t)((c * 2 + dir) * 4 + h) * 128 + dk] = (red[(dir * 4 + 0) * 128 + dk] + red[(dir * 4 + 1) * 128 + dk]) + (red[(dir * 4 + 2) * 128 + dk] + red[(dir * 4 + 3) * 128 + dk]); }
    __syncthreads();
}

__device__ __forceinline__ void mixA_spatial(const Params& p, int l, int c, int g, LAS unsigned char* lds, int tid, int wave, int lane) {
    const int fr = lane & 15, fq = lane >> 4;
    const bf16_t* Z = (const bf16_t*)(p.ws + OFF_Z); bf16_t* YB = (bf16_t*)(p.ws + OFF_H);
    LAS unsigned char* VBT = lds; LAS unsigned char* WS = lds + 256 * LROW;
    const int t0 = c * 128;
    const bf16_t* Zvb = Z + 4 * PLANE + (size_t)t0 * 1024;
    const int sel = g >> 1; const bool mine = (lane >> 5) == (g & 1);
    float vg[8];
    { const float* vn = p.vnorm_g + (size_t)l * 1024 + 256 * g + (lane & 31) * 8; const f32x4 a = *(const f32x4*)vn, b = *(const f32x4*)(vn + 4);
      vg[0] = a[0]; vg[1] = a[1]; vg[2] = a[2]; vg[3] = a[3]; vg[4] = b[0]; vg[5] = b[1]; vg[6] = b[2]; vg[7] = b[3]; }
#pragma unroll 2
    for (int i = 0; i < 16; ++i) {
        const int tok = wave * 16 + i;
        const u32x4 r0 = *(const u32x4*)(Zvb + (size_t)tok * 1024 + lane * 8), r1 = *(const u32x4*)(Zvb + (size_t)tok * 1024 + 512 + lane * 8);
        float a[8], b[8];
        a[0] = geluf_(bf_lo(r0.x)); a[1] = geluf_(bf_hi(r0.x)); a[2] = geluf_(bf_lo(r0.y)); a[3] = geluf_(bf_hi(r0.y)); a[4] = geluf_(bf_lo(r0.z)); a[5] = geluf_(bf_hi(r0.z)); a[6] = geluf_(bf_lo(r0.w)); a[7] = geluf_(bf_hi(r0.w));
        b[0] = geluf_(bf_lo(r1.x)); b[1] = geluf_(bf_hi(r1.x)); b[2] = geluf_(bf_lo(r1.y)); b[3] = geluf_(bf_hi(r1.y)); b[4] = geluf_(bf_lo(r1.z)); b[5] = geluf_(bf_hi(r1.z)); b[6] = geluf_(bf_lo(r1.w)); b[7] = geluf_(bf_hi(r1.w));
        float s = 0.f;
#pragma unroll
        for (int e = 0; e < 8; ++e) s += a[e] * a[e] + b[e] * b[e];
        const float rstd = rsqrtf(wave_sum(s) * (1.0f / 1024.0f) + EPS);
        if (mine) { const int d0 = (lane & 31) * 8;
#pragma unroll
            for (int e = 0; e < 8; ++e) { const float v = (sel ? b[e] : a[e]) * rstd * vg[e]; *(LAS bf16_t*)(VBT + (d0 + e) * LROW + tok * 2) = (bf16_t)(cvt_pk_bf16(v, 0.f) & 0xffffu); } }
    }
    { const float* wsp = p.w_sp + ((size_t)l * 4 + g) * 16384;
#pragma unroll
      for (int i = 0; i < 8; ++i) { const int idx = tid + 512 * i; const int t = idx >> 5, s4 = idx & 31; const f32x4 w4 = *(const f32x4*)(wsp + (size_t)idx * 4);
          u32x2 o; o.x = cvt_pk_bf16(w4[0], w4[1]); o.y = cvt_pk_bf16(w4[2], w4[3]); *(LAS u32x2*)(WS + t * LROW + s4 * 8) = o; } }
    __syncthreads();
    f32x4 acc[8][2];
#pragma unroll
    for (int m = 0; m < 8; ++m)
#pragma unroll
        for (int n = 0; n < 2; ++n) acc[m][n] = (f32x4){0.f, 0.f, 0.f, 0.f};
#pragma unroll
    for (int ks = 0; ks < 4; ++ks) {
        bf16x8 bfv[2];
#pragma unroll
        for (int n = 0; n < 2; ++n) bfv[n] = *(const LAS bf16x8*)(VBT + (32 * wave + 16 * n + fr) * LROW + 64 * ks + 16 * fq);
#pragma unroll
        for (int m = 0; m < 8; ++m) { const bf16x8 af = *(const LAS bf16x8*)(WS + (16 * m + fr) * LROW + 64 * ks + 16 * fq);
#pragma unroll
            for (int n = 0; n < 2; ++n) acc[m][n] = __builtin_amdgcn_mfma_f32_16x16x32_bf16(bfv[n], af, acc[m][n], 0, 0, 0); }
    }
    const bf16_t* Zu = Z + 3 * PLANE + (size_t)t0 * 1024 + 256 * g;
    const float* bsp = p.b_sp + ((size_t)l * 4 + g) * 128;
#pragma unroll
    for (int m = 0; m < 8; ++m) { const int t = 16 * m + fr; const float bb = bsp[t];
#pragma unroll
        for (int n = 0; n < 2; ++n) { const int d = 32 * wave + 16 * n + 4 * fq;
            const u32x2 ur = *(const u32x2*)(Zu + (size_t)t * 1024 + d);
            const float y0 = geluf_(bf_lo(ur.x)) * (acc[m][n][0] + bb), y1 = geluf_(bf_hi(ur.x)) * (acc[m][n][1] + bb), y2 = geluf_(bf_lo(ur.y)) * (acc[m][n][2] + bb), y3 = geluf_(bf_hi(ur.y)) * (acc[m][n][3] + bb);
            u32x2 o; o.x = cvt_pk_bf16(y0, y1); o.y = cvt_pk_bf16(y2, y3);
            *(u32x2*)(YB + (size_t)(t0 + t) * 1024 + 256 * g + d) = o; } }
    __syncthreads();
}

__device__ __forceinline__ int scan_chunk(int dir, int k) { return dir ? (k < 2 ? 1 - k : 131 - k) : k; }
__device__ __forceinline__ void scan_phase(const Params& p, int tid) {
    bf16_t* ST = (bf16_t*)(p.ws + OFF_ST); const float* SC = (const float*)(p.ws + OFF_SC); float* MP = (float*)(p.ws + OFF_MP); float* NS = (float*)(p.ws + OFF_NS);
    const int gid = blockIdx.x * NTHREADS + tid, gsz = gridDim.x * NTHREADS;
    for (int pr = gid; pr < 8 * 16384; pr += gsz) {
        const int dh = pr >> 14, e = pr & 16383, dir = dh >> 2, h = dh & 3;
        float c0 = 0.f, c1 = 0.f, m = 0.f;
#pragma unroll 1
        for (int k0 = 0; k0 < NCH; k0 += 10) {
            unsigned dv[10]; float be[10], ml[10];
#pragma unroll
            for (int j = 0; j < 10; ++j) { const int c = scan_chunk(dir, k0 + j); const int sl = (c * 2 + dir) * 4 + h;
                dv[j] = *(const unsigned*)(ST + (size_t)sl * 32768 + 2 * e); be[j] = SC[sl * 2]; ml[j] = SC[sl * 2 + 1]; }
#pragma unroll
            for (int j = 0; j < 10; ++j) { const int c = scan_chunk(dir, k0 + j); const int sl = (c * 2 + dir) * 4 + h;
                *(unsigned*)(ST + (size_t)sl * 32768 + 2 * e) = cvt_pk_bf16(c0, c1);
                if (e == 0) MP[sl] = m;
                const float mn = fmaxf(be[j] + m, ml[j]); const float wc = __expf(be[j] + m - mn), wl = __expf(ml[j] - mn);
                c0 = wc * c0 + wl * bf_lo(dv[j]); c1 = wc * c1 + wl * bf_hi(dv[j]); m = mn; }
        }
    }
    if (gid < 1024) {
        const int dh = gid >> 7, dk = gid & 127, dir = dh >> 2, h = dh & 3;
        float n = 0.f, m = 0.f;
#pragma unroll 1
        for (int k = 0; k < NCH; ++k) { const int c = scan_chunk(dir, k); const int sl = (c * 2 + dir) * 4 + h;
            const float d = NS[(size_t)sl * 128 + dk]; const float be = SC[sl * 2], ml = SC[sl * 2 + 1];
            NS[(size_t)sl * 128 + dk] = n;
            const float mn = fmaxf(be + m, ml); n = __expf(be + m - mn) * n + __expf(ml - mn) * d; m = mn; }
    }
}

__device__ __forceinline__ void mixC_item(const Params& p, int l, int c, int h, LAS unsigned char* lds, int tid, int wave, int lane) {
    const int fr = lane & 15, fq = lane >> 4;
    const bf16_t* Z = (const bf16_t*)(p.ws + OFF_Z); const bf16_t* QK = (const bf16_t*)(p.ws + OFF_QK); const bf16_t* ST = (const bf16_t*)(p.ws + OFF_ST);
    bf16_t* YA = (bf16_t*)(p.ws + OFF_Z);
    const float* G = (const float*)(p.ws + OFF_G); const float* MP = (const float*)(p.ws + OFF_MP); const float* NS = (const float*)(p.ws + OFF_NS);
    LAS unsigned char* Qs = lds; LAS unsigned char* Ks = lds + 128 * LROW; LAS unsigned char* QBs = lds + 256 * LROW;
    LAS float* vec = (LAS float*)(lds + 384 * LROW);
    LAS float* Bv = vec;
    LAS float* Mx = vec + 256;
    LAS float* bt = vec + 512;
    LAS float* npv = vec + 768;
    LAS float* qnp = vec + 1024;
    LAS float* cfv = vec + 2048;
    LAS float* ssq = vec + 2304;
    LAS float* mpv = vec + 3328;
    const int t0 = c * 128;
#pragma unroll
    for (int ps = 0; ps < 4; ++ps) { const int tok = (tid >> 4) + 32 * ps, chn = tid & 15;
        const u32x4 q = *(const u32x4*)(QK + (size_t)(t0 + tok) * 1024 + h * 128 + chn * 8), k = *(const u32x4*)(QK + (size_t)(t0 + tok) * 1024 + 512 + h * 128 + chn * 8);
        *(LAS u32x4*)(Qs + tok * LROW + chn * 16) = q; *(LAS u32x4*)(Ks + tok * LROW + chn * 16) = k; }
    if (wave < 2) {
        const int dir = wave; const int sl = (c * 2 + dir) * 4 + h;
        const int r0 = dir ? 127 - 2 * lane : 2 * lane, r1 = dir ? r0 - 1 : r0 + 1;
        const float* gp = G + (size_t)t0 * 16 + dir * 8 + h;
        const float i0 = gp[r0 * 16], f0 = gp[r0 * 16 + 4], i1 = gp[r1 * 16], f1 = gp[r1 * 16 + 4];
        const float s = f0 + f1; const float incl = wave_incl_sum(s, lane); const float b0 = incl - s + f0, b1 = incl;
        const float B0 = i0 - b0, B1 = i1 - b1;
        const float pm = fmaxf(B0, B1); const float cmi = wave_incl_max(pm, lane);
        float cme = __shfl_up(cmi, 1); if (lane == 0) cme = -INFINITY;
        const float mprev = MP[sl];
        const float cm0 = fmaxf(cme, B0), cm1 = cmi;
        Bv[dir * 128 + r0] = B0; Bv[dir * 128 + r1] = B1;
        Mx[dir * 128 + r0] = fmaxf(mprev, cm0); Mx[dir * 128 + r1] = fmaxf(mprev, cm1);
        bt[dir * 128 + r0] = b0; bt[dir * 128 + r1] = b1;
        npv[dir * 128 + lane] = NS[(size_t)sl * 128 + lane]; npv[dir * 128 + 64 + lane] = NS[(size_t)sl * 128 + 64 + lane];
        if (lane == 0) mpv[dir] = mprev;
    }
    __syncthreads();
    f32x4 S[8];
#pragma unroll
    for (int n = 0; n < 8; ++n) S[n] = (f32x4){0.f, 0.f, 0.f, 0.f};
#pragma unroll
    for (int ks = 0; ks < 4; ++ks) { const bf16x8 af = *(const LAS bf16x8*)(Qs + (16 * wave + fr) * LROW + 64 * ks + 16 * fq);
#pragma unroll
        for (int n = 0; n < 8; ++n) { const bf16x8 bfv = *(const LAS bf16x8*)(Ks + (16 * n + fr) * LROW + 64 * ks + 16 * fq);
            S[n] = __builtin_amdgcn_mfma_f32_16x16x32_bf16(bfv, af, S[n], 0, 0, 0); } }
    { const int t = tid & 127, part = tid >> 7; float sf = 0.f, sb = 0.f;
#pragma unroll
      for (int e8 = 0; e8 < 4; ++e8) { const u32x4 r = *(const LAS u32x4*)(Qs + t * LROW + part * 64 + e8 * 16); const int d = part * 32 + e8 * 8;
          const float qv[8] = {bf_lo(r.x), bf_hi(r.x), bf_lo(r.y), bf_hi(r.y), bf_lo(r.z), bf_hi(r.z), bf_lo(r.w), bf_hi(r.w)};
#pragma unroll
          for (int e = 0; e < 8; ++e) { sf += qv[e] * npv[d + e]; sb += qv[e] * npv[128 + d + e]; } }
      qnp[(0 * 4 + part) * 128 + t] = sf; qnp[(1 * 4 + part) * 128 + t] = sb; }
    __syncthreads();
    {
        const int t = 16 * wave + fr;
        const float mxf = Mx[t], mxb = Mx[128 + t];
        float pf[8][4], pb[8][4]; float sumf = 0.f, sumb = 0.f;
#pragma unroll
        for (int n = 0; n < 8; ++n) { const f32x4 bf4 = *(const LAS f32x4*)(Bv + 16 * n + 4 * fq), bb4 = *(const LAS f32x4*)(Bv + 128 + 16 * n + 4 * fq);
#pragma unroll
            for (int j = 0; j < 4; ++j) { const int s = 16 * n + 4 * fq + j;
                const float ef = (s <= t) ? __expf(bf4[j] - mxf) : 0.f; const float eb = (s >= t) ? __expf(bb4[j] - mxb) : 0.f;
                pf[n][j] = S[n][j] * ef; pb[n][j] = S[n][j] * eb; sumf += pf[n][j]; sumb += pb[n][j]; } }
        sumf += __shfl_xor(sumf, 16); sumf += __shfl_xor(sumf, 32); sumb += __shfl_xor(sumb, 16); sumb += __shfl_xor(sumb, 32);
        const float qnf = (qnp[0 * 128 + t] + qnp[1 * 128 + t]) + (qnp[2 * 128 + t] + qnp[3 * 128 + t]);
        const float qnb = (qnp[4 * 128 + t] + qnp[5 * 128 + t]) + (qnp[6 * 128 + t] + qnp[7 * 128 + t]);
        const float wpf = __expf(mpv[0] - mxf), wpb = __expf(mpv[1] - mxb);
        const float denf = sumf + wpf * qnf, denb = sumb + wpb * qnb;
        const float rsf = 1.0f / fmaxf(fabsf(denf), __expf(-(bt[t] + mxf))), rsb = 1.0f / fmaxf(fabsf(denb), __expf(-(bt[128 + t] + mxb)));
        if (fq == 0) { cfv[t] = wpf * rsf; cfv[128 + t] = wpb * rsb; }
#pragma unroll
        for (int n = 0; n < 8; ++n) { u32x2 o; o.x = cvt_pk_bf16(pf[n][0] * rsf + pb[n][0] * rsb, pf[n][1] * rsf + pb[n][1] * rsb); o.y = cvt_pk_bf16(pf[n][2] * rsf + pb[n][2] * rsb, pf[n][3] * rsf + pb[n][3] * rsb);
            *(LAS u32x2*)(Ks + t * LROW + 32 * n + 8 * fq) = o; }
    }
    __syncthreads();
#pragma unroll
    for (int ps = 0; ps < 4; ++ps) { const int tok = (tid >> 4) + 32 * ps, chn = tid & 15;
        const u32x4 r = *(const LAS u32x4*)(Qs + tok * LROW + chn * 16); const float cf = cfv[tok], cb = cfv[128 + tok];
        const float qv[8] = {bf_lo(r.x), bf_hi(r.x), bf_lo(r.y), bf_hi(r.y), bf_lo(r.z), bf_hi(r.z), bf_lo(r.w), bf_hi(r.w)};
        u32x4 a, b; a.x = cvt_pk_bf16(qv[0] * cf, qv[1] * cf); a.y = cvt_pk_bf16(qv[2] * cf, qv[3] * cf); a.z = cvt_pk_bf16(qv[4] * cf, qv[5] * cf); a.w = cvt_pk_bf16(qv[6] * cf, qv[7] * cf);
        b.x = cvt_pk_bf16(qv[0] * cb, qv[1] * cb); b.y = cvt_pk_bf16(qv[2] * cb, qv[3] * cb); b.z = cvt_pk_bf16(qv[4] * cb, qv[5] * cb); b.w = cvt_pk_bf16(qv[6] * cb, qv[7] * cb);
        *(LAS u32x4*)(Qs + tok * LROW + chn * 16) = a; *(LAS u32x4*)(QBs + tok * LROW + chn * 16) = b; }
    __syncthreads();
    f32x4 acc[8][2];
#pragma unroll
    for (int m = 0; m < 8; ++m)
#pragma unroll
        for (int n = 0; n < 2; ++n) acc[m][n] = (f32x4){0.f, 0.f, 0.f, 0.f};
    const bf16_t* Zv = Z + PLANE + (size_t)t0 * 1024 + h * 256;
#pragma unroll
    for (int seg = 0; seg < 3; ++seg) {
        const LAS unsigned char* As = seg == 0 ? Ks : (seg == 1 ? Qs : QBs);
        bf16x8 bfv[2][4];
#pragma unroll
        for (int n = 0; n < 2; ++n) { const int dv = 32 * wave + 16 * n + fr;
            const bf16_t* bp = seg == 0 ? Zv + (size_t)(dv >> 1) * 1024 + (dv & 1) * 128 : ST + (size_t)((c * 2 + (seg - 1)) * 4 + h) * 32768 + dv * 128;
#pragma unroll
            for (int ks = 0; ks < 4; ++ks) bfv[n][ks] = *(const bf16x8*)(bp + 32 * ks + 8 * fq); }
#pragma unroll
        for (int ks = 0; ks < 4; ++ks)
#pragma unroll
            for (int m = 0; m < 8; ++m) { const bf16x8 af = *(const LAS bf16x8*)(As + (16 * m + fr) * LROW + 64 * ks + 16 * fq);
#pragma unroll
                for (int n = 0; n < 2; ++n) acc[m][n] = __builtin_amdgcn_mfma_f32_16x16x32_bf16(bfv[n][ks], af, acc[m][n], 0, 0, 0); }
    }
#pragma unroll
    for (int m = 0; m < 8; ++m) { float s = 0.f;
#pragma unroll
        for (int n = 0; n < 2; ++n) s += (acc[m][n][0] * acc[m][n][0] + acc[m][n][1] * acc[m][n][1]) + (acc[m][n][2] * acc[m][n][2] + acc[m][n][3] * acc[m][n][3]);
        s += __shfl_xor(s, 16); s += __shfl_xor(s, 32);
        if (fq == 0) ssq[wave * 128 + 16 * m + fr] = s; }
    __syncthreads();
    const float* hg = p.head_g + ((size_t)l * 4 + h) * 256;
    const bf16_t* Zo = Z + 2 * PLANE + (size_t)t0 * 1024 + h * 256;
    f32x4 hg4[2];
#pragma unroll
    for (int n = 0; n < 2; ++n) hg4[n] = *(const f32x4*)(hg + 32 * wave + 16 * n + 4 * fq);
#pragma unroll
    for (int m = 0; m < 8; ++m) { const int t = 16 * m + fr; float tot = 0.f;
#pragma unroll
        for (int w8 = 0; w8 < 8; ++w8) tot += ssq[w8 * 128 + t];
        const float rstd = rsqrtf(tot * (1.0f / 256.0f) + EPS);
#pragma unroll
        for (int n = 0; n < 2; ++n) { const int dv = 32 * wave + 16 * n + 4 * fq;
            const u32x2 orw = *(const u32x2*)(Zo + (size_t)t * 1024 + dv);
            const float y0 = acc[m][n][0] * rstd * hg4[n][0] * sigmoidf_(bf_lo(orw.x)), y1 = acc[m][n][1] * rstd * hg4[n][1] * sigmoidf_(bf_hi(orw.x));
            const float y2 = acc[m][n][2] * rstd * hg4[n][2] * sigmoidf_(bf_lo(orw.y)), y3 = acc[m][n][3] * rstd * hg4[n][3] * sigmoidf_(bf_hi(orw.y));
            u32x2 o; o.x = cvt_pk_bf16(y0, y1); o.y = cvt_pk_bf16(y2, y3);
            *(u32x2*)(YA + (size_t)(t0 + t) * 1024 + h * 256 + dv) = o; } }
    __syncthreads();
}

#define GRID_SYNC() do { __builtin_amdgcn_fence(__ATOMIC_RELEASE, "agent"); asm volatile("s_waitcnt vmcnt(0) lgkmcnt(0)" ::: "memory"); grid.sync(); __builtin_amdgcn_fence(__ATOMIC_ACQUIRE, "agent"); } while (0)
typedef const __attribute__((address_space(4))) Params* KP;
typedef const __attribute__((address_space(4))) unsigned long long* KP64;
__device__ __forceinline__ Params load_params(KP q) {
    Params p; unsigned long long* d = (unsigned long long*)&p; KP64 s = (KP64)q;
#pragma unroll
    for (int i = 0; i < (int)(sizeof(Params) / 8); ++i) d[i] = s[i];
    return p;
}
#define LOADP() ({ KP q_ = kp; asm volatile("" : "+s"(q_)); load_params(q_); })
#define TIDS() int t_ = threadIdx.x; asm volatile("" : "+v"(t_)); const int tid = t_, lane = tid & 63, wave = __builtin_amdgcn_readfirstlane(tid >> 6); const int gw = bx * NWAVES + wave; (void)lane; (void)gw;

#ifdef DBG_CHECK
__device__ __forceinline__ void chk_bf16(const Params& p, const bf16_t* b, size_t n, unsigned code, bool on, int tid) {
    if (!on) return; unsigned* flag = (unsigned*)(p.ws + OFF_FLAG); bool bad = false;
    for (size_t i = (size_t)blockIdx.x * NTHREADS + tid; i < n; i += (size_t)gridDim.x * NTHREADS) { const float v = __uint_as_float(((unsigned)b[i]) << 16); if (!(fabsf(v) < 1e6f)) bad = true; }
    if (bad) atomicMin(flag, code);
}
__device__ __forceinline__ void chk_f32(const Params& p, const float* b, size_t n, unsigned code, bool on, int tid) {
    if (!on) return; unsigned* flag = (unsigned*)(p.ws + OFF_FLAG); bool bad = false;
    for (size_t i = (size_t)blockIdx.x * NTHREADS + tid; i < n; i += (size_t)gridDim.x * NTHREADS) { const float v = b[i]; if (!(fabsf(v) < 1e6f)) bad = true; }
    if (bad) atomicMin(flag, code);
}
#define CHK(stmt) do { TIDS(); const Params p = LOADP(); stmt; } while (0)
#else
#define CHK(stmt) do {} while (0)
#endif
__global__ void __launch_bounds__(NTHREADS, 2) fwd_megakernel(Params pk) {
    extern __shared__ __attribute__((aligned(16))) unsigned char lds_raw[];
    LAS unsigned char* lds = (LAS unsigned char*)lds_raw;
    cg::grid_group grid = cg::this_grid();
    KP kp = (KP)__builtin_amdgcn_kernarg_segment_ptr();
    const int G = gridDim.x, bx = blockIdx.x;
    const int NGW = G * NWAVES;

#ifdef DBG_CHECK
    { const Params p = LOADP(); if (blockIdx.x == 0 && threadIdx.x == 0) *(unsigned*)(p.ws + OFF_FLAG) = 9999u; }
#endif
    if (PH(0)) { TIDS(); const Params p = LOADP(); mods_phase(p, lds, tid, wave, lane); }
    __syncthreads();
    if (PH(1)) { TIDS(); const Params p = LOADP(); convert_weights(p, 0, lds, gw, NGW, wave, lane); }
    GRID_SYNC();
        CHK(chk_f32(p, (const float*)(p.ws + OFF_MOD), 4 * 2 * 6144, 1, true, tid); chk_bf16(p, (const bf16_t*)(p.ws + OFF_WB), WB_END / 2, 2, true, tid));

#pragma unroll 1
    for (int l = 0; l < DEPTH; ++l) {
        if (PH(1)) if (l > 0) { TIDS(); const Params p = LOADP(); convert_weights(p, l, lds + 65536, gw, NGW, wave, lane); }
        if (PH(2)) { TIDS(); const Params p = LOADP(); norm_phase<true>(p, l, lds, gw, NGW, tid, lane); }
        GRID_SYNC();
        CHK(chk_bf16(p, (const bf16_t*)(p.ws + OFF_H), PLANE, 3, l == 0, tid); chk_f32(p, (const float*)(p.ws + OFF_G), (size_t)T * 16, 4, l == 0, tid));
        if (PH(3)) { TIDS(); const Params p = LOADP(); bf16_t* WB = (bf16_t*)(p.ws + OFF_WB); bf16_t* H = (bf16_t*)(p.ws + OFF_H); bf16_t* Z = (bf16_t*)(p.ws + OFF_Z);
          pg8::Gemm g{H, H, WB + WB_WIN / 2, 1024, 0}; pg8::Sched S; S.init(65, 28, G, bx, 1, 0); EpiZ E{Z};
          pg8::gemm_phase<EpiZ>(lds, g, S, E, tid); }
        GRID_SYNC();
        CHK(chk_bf16(p, (const bf16_t*)(p.ws + OFF_Z), 7 * PLANE, 5, l == 0, tid));
        for (int it = bx; it < 2 * NCH * 4; it += G) {
            if (it < NCH * 4) { if (PH(4)) { TIDS(); const Params p = LOADP(); mixA_mlstm(p, l, it >> 2, it & 3, lds, tid, wave, lane); } }
            else { const int j = it - NCH * 4; if (PH(5)) { TIDS(); const Params p = LOADP(); mixA_spatial(p, l, j >> 2, j & 3, lds, tid, wave, lane); } }
        }
        GRID_SYNC();
        CHK(chk_bf16(p, (const bf16_t*)(p.ws + OFF_QK), PLANE, 6, l == 0, tid); chk_bf16(p, (const bf16_t*)(p.ws + OFF_ST), (size_t)NCH * 8 * 32768, 79, l == 0, tid); chk_f32(p, (const float*)(p.ws + OFF_NS), (size_t)NCH * 8 * 128, 8, l == 0, tid); chk_f32(p, (const float*)(p.ws + OFF_SC), (size_t)NCH * 16, 9, l == 0, tid); chk_bf16(p, (const bf16_t*)(p.ws + OFF_H), PLANE, 10, l == 0, tid));
        if (PH(6)) { TIDS(); const Params p = LOADP(); scan_phase(p, tid); }
        GRID_SYNC();
        CHK(chk_bf16(p, (const bf16_t*)(p.ws + OFF_ST), (size_t)NCH * 8 * 32768, 11, l == 0, tid); chk_f32(p, (const float*)(p.ws + OFF_NS), (size_t)NCH * 8 * 128, 12, l == 0, tid); chk_f32(p, (const float*)(p.ws + OFF_MP), (size_t)NCH * 8, 13, l == 0, tid));
        if (PH(7)) for (int it = bx; it < NCH * 4; it += G) { TIDS(); const Params p = LOADP(); mixC_item(p, l, it >> 2, it & 3, lds, tid, wave, lane); }
        GRID_SYNC();
        CHK(chk_bf16(p, (const bf16_t*)(p.ws + OFF_Z), PLANE, 14, l == 0, tid));
        if (PH(8)) { TIDS(); const Params p = LOADP(); bf16_t* WB = (bf16_t*)(p.ws + OFF_WB); bf16_t* H = (bf16_t*)(p.ws + OFF_H); bf16_t* Z = (bf16_t*)(p.ws + OFF_Z);
          pg8::Gemm g{Z, H, WB + WB_WPAB / 2, 1024, 4}; pg8::Sched S; S.init(65, 4, G, bx, 2, 0); EpiMerge E{Z + 5 * PLANE, Z + 6 * PLANE, Z + 3 * PLANE};
          pg8::gemm_phase<EpiMerge>(lds, g, S, E, tid); }
        GRID_SYNC();
        CHK(chk_bf16(p, (const bf16_t*)(p.ws + OFF_Z) + 3 * PLANE, PLANE, 15, l == 0, tid));
        if (PH(9)) { TIDS(); const Params p = LOADP(); bf16_t* WB = (bf16_t*)(p.ws + OFF_WB); bf16_t* Z = (bf16_t*)(p.ws + OFF_Z); const float* MOD = (const float*)(p.ws + OFF_MOD); float* CS = (float*)(p.ws + OFF_CS);
          pg8::Gemm g{Z + 3 * PLANE, Z + 3 * PLANE, WB + WB_WOUT / 2, 1024, 0}; pg8::Sched S; S.init(65, 4, G, bx, 1, 0);
          EpiRes E{p.out, CS, MOD + (size_t)(l * 2 + 0) * 6144 + 2048, MOD + (size_t)(l * 2 + 1) * 6144 + 2048};
          pg8::gemm_phase<EpiRes>(lds, g, S, E, tid); }
        GRID_SYNC();
        CHK(chk_f32(p, p.out, (size_t)(T - NCTX) * 1024, 16, l == 0, tid); chk_f32(p, (const float*)(p.ws + OFF_CS), (size_t)NCTX * 1024, 16, l == 0, tid));
        if (PH(10)) { TIDS(); const Params p = LOADP(); norm_phase<false>(p, l, lds, gw, NGW, tid, lane); }
        GRID_SYNC();
        CHK(chk_bf16(p, (const bf16_t*)(p.ws + OFF_H), PLANE, 17, l == 0, tid));
        if (PH(11)) { TIDS(); const Params p = LOADP(); bf16_t* WB = (bf16_t*)(p.ws + OFF_WB); bf16_t* H = (bf16_t*)(p.ws + OFF_H); bf16_t* Z = (bf16_t*)(p.ws + OFF_Z);
          pg8::Gemm g{H, H, WB + WB_W13 / 2, 1024, 0}; pg8::Sched S; S.init(65, 22, G, bx, 1, 0); EpiSwiglu E{Z + PLANE};
          pg8::gemm_phase<EpiSwiglu>(lds, g, S, E, tid); }
        GRID_SYNC();
        CHK(chk_bf16(p, (const bf16_t*)(p.ws + OFF_Z) + PLANE, (size_t)T * DFF, 18, l == 0, tid));
        if (PH(12)) { TIDS(); const Params p = LOADP(); bf16_t* WB = (bf16_t*)(p.ws + OFF_WB); bf16_t* Z = (bf16_t*)(p.ws + OFF_Z); const float* MOD = (const float*)(p.ws + OFF_MOD); float* CS = (float*)(p.ws + OFF_CS);
          pg8::Gemm g{Z + PLANE, Z + PLANE, WB + WB_W2 / 2, DFF, 0}; pg8::Sched S; S.init(65, 4, G, bx, 1, 0);
          EpiRes E{p.out, CS, MOD + (size_t)(l * 2 + 0) * 6144 + 5120, MOD + (size_t)(l * 2 + 1) * 6144 + 5120};
          pg8::gemm_phase<EpiRes>(lds, g, S, E, tid); }
        GRID_SYNC();
        CHK(chk_f32(p, p.out, (size_t)(T - NCTX) * 1024, 19 + l, true, tid));
    }
#ifdef DBG_CHECK
    GRID_SYNC();
    { const Params p = LOADP(); const unsigned f = *(volatile unsigned*)(p.ws + OFF_FLAG);
      if (f != 9999u) { for (size_t i = (size_t)blockIdx.x * NTHREADS + threadIdx.x; i < (size_t)(T - NCTX) * 1024; i += (size_t)gridDim.x * NTHREADS) p.out[i] = 100.0f * (float)f; return; } }
#endif
    if (PH(13)) { TIDS(); const Params p = LOADP(); final_norm(p, gw, NGW, lane); }
}

extern "C" void kernel_launch(void* const* d_in, const int* in_sizes, int n_in, void* d_out, int out_size, void* d_ws, size_t ws_size, hipStream_t stream) {
    static int grid = 0;
    if (grid == 0) {
        if (n_in != 23 || out_size != (T - NCTX) * D || ws_size < WS_END) { fprintf(stderr, "kernel_launch: unexpected shapes (n_in %d, out %d, ws %zu, need %zu)\n", n_in, out_size, ws_size, (size_t)WS_END); grid = -1; return; }
        int dev = 0, cus = 0, per_cu = 0;
        (void)hipGetDevice(&dev); (void)hipDeviceGetAttribute(&cus, hipDeviceAttributeMultiprocessorCount, dev);
        if (hipFuncSetAttribute((const void*)fwd_megakernel, hipFuncAttributeMaxDynamicSharedMemorySize, LDS_BYTES) != hipSuccess) { fprintf(stderr, "kernel_launch: hipFuncSetAttribute failed\n"); grid = -1; return; }
        if (hipOccupancyMaxActiveBlocksPerMultiprocessor(&per_cu, (const void*)fwd_megakernel, NTHREADS, LDS_BYTES) != hipSuccess || per_cu < 1) { fprintf(stderr, "kernel_launch: occupancy query says %d\n", per_cu); per_cu = 1; }
        (void)hipGetLastError();
        grid = cus;
    }
    if (grid < 0) return;
    Params p{};
    p.x = (const float*)d_in[0]; p.c = (const float*)d_in[1]; p.ctx = (const float*)d_in[2]; p.c_ctx = (const float*)d_in[3]; p.w_ada = (const float*)d_in[4]; p.b_ada = (const float*)d_in[5];
    p.norm1_g = (const float*)d_in[6]; p.norm2_g = (const float*)d_in[7]; p.w_in = (const float*)d_in[8]; p.conv_w = (const float*)d_in[9]; p.conv_b = (const float*)d_in[10]; p.gate_b = (const float*)d_in[11];
    p.head_g = (const float*)d_in[12]; p.vnorm_g = (const float*)d_in[13]; p.w_sp = (const float*)d_in[14]; p.b_sp = (const float*)d_in[15]; p.w_pa = (const float*)d_in[16]; p.w_pb = (const float*)d_in[17];
    p.w_out = (const float*)d_in[18]; p.w_ff1 = (const float*)d_in[19]; p.w_ff3 = (const float*)d_in[20]; p.w_ff2 = (const float*)d_in[21]; p.final_g = (const float*)d_in[22];
    p.out = (float*)d_out; p.ws = (unsigned char*)d_ws;
    void* args[] = {&p};
    hipError_t e = hipLaunchCooperativeKernel((const void*)fwd_megakernel, dim3(grid), dim3(NTHREADS), args, LDS_BYTES, stream);
    if (e != hipSuccess) fprintf(stderr, "kernel_launch: cooperative launch failed: %s (grid %d)\n", hipGetErrorString(e), grid);
}
```

```cpp
#include <hip/hip_runtime.h>
#include <hip/hip_cooperative_groups.h>
#include <cstdio>
namespace cg = cooperative_groups;

#define LAS __attribute__((address_space(3)))
typedef unsigned short bf16_t;
typedef short bf16x8 __attribute__((ext_vector_type(8)));
typedef float f32x4 __attribute__((ext_vector_type(4)));
typedef float f32x2 __attribute__((ext_vector_type(2)));
typedef unsigned u32x4 __attribute__((ext_vector_type(4)));
typedef unsigned u32x2 __attribute__((ext_vector_type(2)));

constexpr int T = 16640, NCTX = 256, D = 1024, NCH = 130, DFF = 2816, INW = 7184, ZW = 7168, DEPTH = 4;
constexpr size_t PLANE = (size_t)T * 1024;
constexpr float EPS = 1e-6f;
constexpr int NTHREADS = 512, NWAVES = 8;
constexpr int LDS_BYTES = 147456;
#ifndef PH_MASK
#define PH_MASK 0xFFFFF
#endif
#define PH(k) ((PH_MASK >> (k)) & 1)

constexpr size_t MiB = 1u << 20;
constexpr size_t OFF_MOD = 0;
constexpr size_t OFF_SC = 256 * 1024;
constexpr size_t OFF_MP = 256 * 1024 + 16 * 1024;
constexpr size_t OFF_NS = 320 * 1024;
constexpr size_t OFF_G = 1 * MiB;
constexpr size_t OFF_CS = 3 * MiB;
constexpr size_t OFF_WB = 4 * MiB;
constexpr size_t WB_WIN = 0, WB_WPAB = (size_t)ZW * 1024 * 2, WB_WOUT = WB_WPAB + (size_t)2048 * 1024 * 2, WB_W13 = WB_WOUT + (size_t)1024 * 1024 * 2,
                 WB_W2 = WB_W13 + (size_t)5632 * 1024 * 2, WB_END = WB_W2 + (size_t)1024 * 2816 * 2;
static_assert(WB_END <= 37 * MiB, "wb");
constexpr size_t OFF_H = 41 * MiB;
constexpr size_t OFF_QK = 74 * MiB;
constexpr size_t OFF_ST = 107 * MiB;
constexpr size_t OFF_Z = 172 * MiB;
constexpr size_t OFF_SSQ = 400 * MiB;
constexpr size_t WS_END = OFF_SSQ + 2 * MiB;
static_assert(OFF_Z + 7 * PLANE * 2 <= OFF_SSQ, "ws map 2");
static_assert(OFF_H + PLANE * 2 <= OFF_QK && OFF_QK + PLANE * 2 <= OFF_ST && OFF_ST + (size_t)NCH * 8 * 32768 * 2 <= OFF_Z, "ws map");

struct Params {
    const float *x, *c, *ctx, *c_ctx, *w_ada, *b_ada, *norm1_g, *norm2_g, *w_in, *conv_w, *conv_b, *gate_b, *head_g, *vnorm_g, *w_sp, *b_sp, *w_pa, *w_pb, *w_out, *w_ff1, *w_ff3, *w_ff2, *final_g;
    float* out; unsigned char* ws;
};

__device__ __forceinline__ float bf_lo(unsigned w) { return __uint_as_float(w << 16); }
__device__ __forceinline__ float bf_hi(unsigned w) { return __uint_as_float(w & 0xffff0000u); }
typedef __bf16 bf16v2_t __attribute__((ext_vector_type(2)));
__device__ __forceinline__ unsigned cvt_pk_bf16(float lo, float hi) { const f32x2 v = {lo, hi}; const bf16v2_t b = __builtin_convertvector(v, bf16v2_t); return __builtin_bit_cast(unsigned, b); }
__device__ __forceinline__ float wave_sum(float v) {
#pragma unroll
    for (int o = 1; o < 64; o <<= 1) v += __shfl_xor(v, o);
    return v;
}
__device__ __forceinline__ float wave_max(float v) {
#pragma unroll
    for (int o = 1; o < 64; o <<= 1) v = fmaxf(v, __shfl_xor(v, o));
    return v;
}
__device__ __forceinline__ float sigmoidf_(float x) { return __builtin_amdgcn_rcpf(1.0f + __expf(-x)); }
__device__ __forceinline__ float siluf_(float x) { return x * __builtin_amdgcn_rcpf(1.0f + __expf(-x)); }
__device__ __forceinline__ float geluf_(float x) {
    const float y2 = 1.5957691216057308f * (x + 0.044715f * x * x * x);
    return x * __builtin_amdgcn_rcpf(1.0f + __expf(-y2));
}
__device__ __forceinline__ float logsigf_(float x) { return fminf(x, 0.0f) - log1pf(__expf(-fabsf(x))); }
#define LDS_WAIT() asm volatile("s_waitcnt lgkmcnt(0)" ::: "memory")
#define LDS_BARRIER() do { asm volatile("s_waitcnt lgkmcnt(0)" ::: "memory"); __builtin_amdgcn_s_barrier(); asm volatile("" ::: "memory"); } while (0)

namespace pg8 {
constexpr int BM = 256, BK = 64, HALF = 128, HTB = HALF * BK * 2, STAGE_BYTES = 8 * HTB, NXCD = 8, WGM = 8;
__host__ __device__ __forceinline__ int lds_byte(int r, int c) { const int st = (r >> 4) * 2 + (c >> 5), rr = r & 15, cc = c & 31, ob = rr * 64 + cc * 2; return st * 1024 + (ob ^ (((ob >> 9) & 1) << 5)); }
__host__ __device__ __forceinline__ void stage_rc(int b, int& R, int& C) { const int st = b / 1024, sb = b % 1024, swz = sb ^ (((sb >> 9) & 1) << 5); R = (st >> 1) * 16 + swz / 64; C = (st & 1) * 32 + (swz % 64) / 2; }
__host__ __device__ __forceinline__ int perm32(int rho) { const int n = rho >> 4, i = rho & 15; return 8 * (i >> 2) + 4 * n + (i & 3); }

struct Unit { int pm, pn, seg; };
struct Gemm { const bf16_t* A0; const bf16_t* A1; const bf16_t* Bt; int K; int seg_pn_off; };
struct Sched {
    int nM, nN, nwg, G, c, nseg, pm0;
    __device__ void init(int nM_, int nN_, int G_, int c_, int nseg_, int pm0_) { nM = nM_; nN = nN_; nwg = nM * nN; G = G_; c = c_; nseg = nseg_; pm0 = pm0_; }
    __device__ bool next(int i, Unit& u) const {
        const int ii = i / nseg; u.seg = i - ii * nseg;
        const long L = (long)ii * G + c; if (L >= nwg) return false;
        int wgid = (int)L; { const int q = nwg / NXCD, r = nwg % NXCD, xcd = wgid % NXCD, off = wgid / NXCD; wgid = (xcd < r ? xcd * (q + 1) : r * (q + 1) + (xcd - r) * q) + off; }
        const int nig = WGM * nN, gid = wgid / nig, fm = gid * WGM, gsz = (nM - fm) < WGM ? (nM - fm) : WGM;
        u.pm = pm0 + fm + ((wgid % nig) % gsz); u.pn = (wgid % nig) / gsz; return true;
    }
};

template <class Epi>
__device__ __forceinline__ void gemm_phase(LAS unsigned char* lds, const Gemm g, const Sched& S, const Epi& E, const int tid) {
    const int wid = __builtin_amdgcn_readfirstlane(tid >> 6), lane = tid & 63, wr = wid >> 2, wc = wid & 3, fr = lane & 15, fq = lane >> 4;
    const int K = g.K, nt = K / BK;
    unsigned voffA[2], voffB[2];
#pragma unroll
    for (int i = 0; i < 2; ++i) { int R, C; stage_rc(tid * 16 + i * 8192, R, C); const int Rb = Epi::PERM ? ((R & ~31) + perm32(R & 31)) : R;
        voffA[i] = (unsigned)(R * K + C) * 2u; voffB[i] = (unsigned)(Rb * K + C) * 2u; }
    const size_t kstep = (size_t)(BK * 2);
    const size_t hstep = (size_t)HALF * K * 2;
    const size_t tstep = 2 * hstep;
    const unsigned ldsw = (unsigned)wid * 1024u;
    const int aoff = lds_byte(wr * 64 + fr, fq * 8), boff = lds_byte(wc * 32 + fr, fq * 8);
#define PG8_SA(b, h) (((b) * 2 + (h)) * HTB)
#define PG8_SB(b, h) ((4 + (b) * 2 + (h)) * HTB)
#define PG8_STAGE(bufoff, gbase, voff) do { _Pragma("unroll") for (int _i = 0; _i < 2; ++_i) \
        __builtin_amdgcn_global_load_lds((const unsigned*)((const char*)(gbase) + (voff)[_i]), (LAS unsigned*)(lds + (bufoff) + ldsw + _i * 8192), 16, 0, 0); } while (0)
#define PG8_LDA(dst, b, h) do { _Pragma("unroll") for (int m = 0; m < 4; ++m) _Pragma("unroll") for (int k = 0; k < 2; ++k) dst[m][k] = *(const LAS bf16x8*)(lds + PG8_SA(b, h) + aoff + m * 2048 + k * 1024); } while (0)
#define PG8_LDB(dst, b, h) do { _Pragma("unroll") for (int n = 0; n < 2; ++n) _Pragma("unroll") for (int k = 0; k < 2; ++k) dst[n][k] = *(const LAS bf16x8*)(lds + PG8_SB(b, h) + boff + n * 2048 + k * 1024); } while (0)
#define PG8_MMA(ai, bj, At, Bt) do { __builtin_amdgcn_s_setprio(1); _Pragma("unroll") for (int m = 0; m < 4; ++m) _Pragma("unroll") for (int n = 0; n < 2; ++n) _Pragma("unroll") for (int k = 0; k < 2; ++k) \
        acc[ai][bj][m][n] = __builtin_amdgcn_mfma_f32_16x16x32_bf16(Bt[n][k], At[m][k], acc[ai][bj][m][n], 0, 0, 0); __builtin_amdgcn_s_setprio(0); } while (0)
#define PG8_WAIT_V(n) asm volatile("s_waitcnt vmcnt(" #n ")" ::: "memory")
#define PG8_WAIT_L(n) asm volatile("s_waitcnt lgkmcnt(" #n ")" ::: "memory")
#define PG8_BAR __builtin_amdgcn_s_barrier()
#define PG8_SCHED __builtin_amdgcn_sched_barrier(0)
    Unit cur, nxt; int ui = 0;
    if (!S.next(0, cur)) return;
    f32x4 acc[2][2][4][2];
#pragma unroll
    for (int a = 0; a < 2; ++a)
#pragma unroll
        for (int b = 0; b < 2; ++b)
#pragma unroll
            for (int m = 0; m < 4; ++m)
#pragma unroll
                for (int n = 0; n < 2; ++n) acc[a][b][m][n] = (f32x4){0.f, 0.f, 0.f, 0.f};
    bf16x8 At[4][2], B0[2][2], B1[2][2];
    const char* cA = (const char*)(cur.seg ? g.A1 : g.A0) + (size_t)cur.pm * tstep; const char* cB = (const char*)g.Bt + (size_t)(cur.pn + cur.seg * g.seg_pn_off) * tstep;
    PG8_STAGE(PG8_SB(0, 0), cB, voffB); PG8_STAGE(PG8_SA(0, 0), cA, voffA); PG8_STAGE(PG8_SB(0, 1), cB + hstep, voffB); PG8_STAGE(PG8_SA(0, 1), cA + hstep, voffA);
    if (wr == 1) PG8_BAR;
    PG8_WAIT_V(4); PG8_BAR;
    PG8_STAGE(PG8_SB(1, 0), cB + kstep, voffB); PG8_STAGE(PG8_SA(1, 0), cA + kstep, voffA); PG8_STAGE(PG8_SB(1, 1), cB + hstep + kstep, voffB);
    PG8_WAIT_V(6); PG8_BAR;
    for (;;) {
        const bool has_next = S.next(ui + 1, nxt);
        const char* nA = has_next ? (const char*)(nxt.seg ? g.A1 : g.A0) + (size_t)nxt.pm * tstep : cA;
        const char* nB = has_next ? (const char*)g.Bt + (size_t)(nxt.pn + nxt.seg * g.seg_pn_off) * tstep : cB;
        for (int t = 0; t < nt; t += 2) {
            const bool last = (t == nt - 2);
            const char* a1 = cA + (size_t)(t + 1) * kstep;
            const char* a2 = last ? nA : cA + (size_t)(t + 2) * kstep; const char* b2 = last ? nB : cB + (size_t)(t + 2) * kstep;
            const char* a3 = a2 + kstep; const char* b3 = b2 + kstep;
            PG8_LDB(B0, 0, 0); PG8_SCHED; PG8_LDA(At, 0, 0); PG8_STAGE(PG8_SA(1, 1), a1 + hstep, voffA);
            PG8_WAIT_L(8); PG8_BAR; PG8_WAIT_L(0); PG8_MMA(0, 0, At, B0); PG8_BAR; PG8_SCHED;
            PG8_LDB(B1, 0, 1); PG8_STAGE(PG8_SB(0, 0), b2, voffB);
            PG8_BAR; PG8_WAIT_L(0); PG8_MMA(0, 1, At, B1); PG8_BAR;
            PG8_LDA(At, 0, 1); PG8_STAGE(PG8_SA(0, 0), a2, voffA);
            PG8_BAR; PG8_WAIT_L(0); PG8_MMA(1, 0, At, B0); PG8_BAR; PG8_SCHED;
            PG8_STAGE(PG8_SB(0, 1), b2 + hstep, voffB);
            PG8_WAIT_V(6); PG8_BAR; PG8_MMA(1, 1, At, B1); PG8_BAR;
            PG8_LDB(B0, 1, 0); PG8_SCHED; PG8_LDA(At, 1, 0); PG8_STAGE(PG8_SA(0, 1), a2 + hstep, voffA);
            PG8_WAIT_L(8); PG8_BAR; PG8_WAIT_L(0); PG8_MMA(0, 0, At, B0); PG8_BAR; PG8_SCHED;
            PG8_LDB(B1, 1, 1); PG8_STAGE(PG8_SB(1, 0), b3, voffB);
            PG8_BAR; PG8_WAIT_L(0); PG8_MMA(0, 1, At, B1); PG8_BAR;
            PG8_LDA(At, 1, 1); PG8_STAGE(PG8_SA(1, 0), a3, voffA);
            PG8_BAR; PG8_WAIT_L(0); PG8_MMA(1, 0, At, B0); PG8_BAR; PG8_SCHED;
            PG8_STAGE(PG8_SB(1, 1), b3 + hstep, voffB);
            PG8_WAIT_V(6); PG8_BAR; PG8_MMA(1, 1, At, B1); PG8_BAR;
        }
        const bool zero = E(acc, cur, wr, wc, fr, fq);
        if (!has_next) break;
        if (zero) {
#pragma unroll
            for (int a = 0; a < 2; ++a)
#pragma unroll
                for (int b = 0; b < 2; ++b)
#pragma unroll
                    for (int m = 0; m < 4; ++m)
#pragma unroll
                        for (int n = 0; n < 2; ++n) acc[a][b][m][n] = (f32x4){0.f, 0.f, 0.f, 0.f};
        }
        cur = nxt; cA = nA; cB = nB; ++ui;
    }
    PG8_WAIT_V(0);
    if (wr == 0) PG8_BAR;
    PG8_BAR;
#undef PG8_SA
#undef PG8_SB
#undef PG8_STAGE
#undef PG8_LDA
#undef PG8_LDB
#undef PG8_MMA
#undef PG8_WAIT_V
#undef PG8_WAIT_L
#undef PG8_BAR
#undef PG8_SCHED
}
}

typedef f32x4 AccT[2][2][4][2];
struct EpiZ {
    static constexpr bool PERM = true;
    bf16_t* Z; float* SSQP;
    __device__ __forceinline__ bool operator()(AccT& acc, const pg8::Unit& u, int wr, int wc, int fr, int fq) const {
        const int row0 = u.pm * 256 + wr * 64 + fr; const int colt = u.pn * 256; const int plane = colt >> 10;
        bf16_t* base = Z + (size_t)plane * PLANE + (colt & 1023) + wc * 32 + 8 * fq;
        const bool act = (plane == 3) || (plane == 4);
#pragma unroll
        for (int ai = 0; ai < 2; ++ai)
#pragma unroll
            for (int m = 0; m < 4; ++m) { const int row = row0 + ai * 128 + m * 16; bf16_t* rowp = base + (size_t)row * 1024; float ss = 0.f;
#pragma unroll
                for (int bj = 0; bj < 2; ++bj) { f32x4 v0 = acc[ai][bj][m][0], v1 = acc[ai][bj][m][1];
                    if (act) {
#pragma unroll
                        for (int j = 0; j < 4; ++j) { v0[j] = geluf_(v0[j]); v1[j] = geluf_(v1[j]); ss += v0[j] * v0[j] + v1[j] * v1[j]; } }
                    u32x4 w; w.x = cvt_pk_bf16(v0[0], v0[1]); w.y = cvt_pk_bf16(v0[2], v0[3]); w.z = cvt_pk_bf16(v1[0], v1[1]); w.w = cvt_pk_bf16(v1[2], v1[3]);
                    *(u32x4*)(rowp + bj * 128) = w; }
                if (plane == 4) { ss += __shfl_xor(ss, 16); ss += __shfl_xor(ss, 32); if (fq == 0) SSQP[(size_t)row * 16 + (u.pn & 3) * 4 + wc] = ss; } }
        return true;
    }
};
struct EpiMerge {
    static constexpr bool PERM = true;
    const bf16_t* GA; const bf16_t* GB; bf16_t* O;
    __device__ __forceinline__ bool operator()(AccT& acc, const pg8::Unit& u, int wr, int wc, int fr, int fq) const {
        const int row0 = u.pm * 256 + wr * 64 + fr; const int col0 = u.pn * 256 + wc * 32 + 8 * fq;
#pragma unroll
        for (int ai = 0; ai < 2; ++ai)
#pragma unroll
            for (int m = 0; m < 4; ++m) { const size_t ro = (size_t)(row0 + ai * 128 + m * 16) * 1024 + col0;
#pragma unroll
                for (int bj = 0; bj < 2; ++bj) {
                    const u32x4 gb = *(const u32x4*)(GB + ro + bj * 128);
                    float b[8] = {bf_lo(gb.x), bf_hi(gb.x), bf_lo(gb.y), bf_hi(gb.y), bf_lo(gb.z), bf_hi(gb.z), bf_lo(gb.w), bf_hi(gb.w)};
                    if (u.seg == 0) {
                        const u32x4 ga = *(const u32x4*)(GA + ro + bj * 128);
                        float a[8] = {bf_lo(ga.x), bf_hi(ga.x), bf_lo(ga.y), bf_hi(ga.y), bf_lo(ga.z), bf_hi(ga.z), bf_lo(ga.w), bf_hi(ga.w)};
#pragma unroll
                        for (int j = 0; j < 8; ++j) { const float r = sigmoidf_(a[j]) * (1.0f + __expf(-b[j])); acc[ai][bj][m][j >> 2][j & 3] *= r; }
                    } else {
                        float v[8];
#pragma unroll
                        for (int j = 0; j < 8; ++j) v[j] = acc[ai][bj][m][j >> 2][j & 3] * sigmoidf_(b[j]);
                        u32x4 w; w.x = cvt_pk_bf16(v[0], v[1]); w.y = cvt_pk_bf16(v[2], v[3]); w.z = cvt_pk_bf16(v[4], v[5]); w.w = cvt_pk_bf16(v[6], v[7]);
                        *(u32x4*)(O + ro + bj * 128) = w;
                    }
                } }
        return u.seg != 0;
    }
};
struct EpiRes {
    static constexpr bool PERM = false;
    float* out; float* cs; const float* gx; const float* gc;
    __device__ __forceinline__ bool operator()(AccT& acc, const pg8::Unit& u, int wr, int wc, int fr, int fq) const {
        const bool isc = (u.pm == 0);
        float* base = isc ? cs : out - (size_t)NCTX * 1024; const float* gv = isc ? gc : gx;
        const int row0 = u.pm * 256 + wr * 64 + fr, col0 = u.pn * 256 + wc * 32 + 4 * fq;
        f32x4 g4[2][2];
#pragma unroll
        for (int bj = 0; bj < 2; ++bj)
#pragma unroll
            for (int n = 0; n < 2; ++n) g4[bj][n] = *(const f32x4*)(gv + col0 + bj * 128 + n * 16);
#pragma unroll
        for (int ai = 0; ai < 2; ++ai)
#pragma unroll
            for (int m = 0; m < 4; ++m) { float* rowp = base + (size_t)(row0 + ai * 128 + m * 16) * 1024 + col0;
#pragma unroll
                for (int bj = 0; bj < 2; ++bj)
#pragma unroll
                    for (int n = 0; n < 2; ++n) { f32x4* p = (f32x4*)(rowp + bj * 128 + n * 16); *p = *p + g4[bj][n] * acc[ai][bj][m][n]; } }
        return true;
    }
};
struct EpiSwiglu {
    static constexpr bool PERM = true;
    bf16_t* FM;
    __device__ __forceinline__ bool operator()(AccT& acc, const pg8::Unit& u, int wr, int wc, int fr, int fq) const {
        const int row0 = u.pm * 256 + wr * 64 + fr, col0 = u.pn * 128 + wc * 32 + 8 * fq;
#pragma unroll
        for (int ai = 0; ai < 2; ++ai)
#pragma unroll
            for (int m = 0; m < 4; ++m) {
                float v[8];
#pragma unroll
                for (int j = 0; j < 8; ++j) v[j] = siluf_(acc[ai][0][m][j >> 2][j & 3]) * acc[ai][1][m][j >> 2][j & 3];
                u32x4 w; w.x = cvt_pk_bf16(v[0], v[1]); w.y = cvt_pk_bf16(v[2], v[3]); w.z = cvt_pk_bf16(v[4], v[5]); w.w = cvt_pk_bf16(v[6], v[7]);
                *(u32x4*)(FM + (size_t)(row0 + ai * 128 + m * 16) * DFF + col0) = w; }
        return true;
    }
};

__device__ __forceinline__ void transpose_item(const float* W, int ldw, int src_col0, int k0, bf16_t* WT, int K, int dst_row0, LAS float* scr, int lane) {
    float tv[32];
#pragma unroll
    for (int i = 0; i < 32; ++i) { const int kk = 2 * i + (lane >> 5); tv[i] = W[(size_t)(k0 + kk) * ldw + src_col0 + (lane & 31)]; }
#pragma unroll
    for (int i = 0; i < 32; ++i) { const int kk = 2 * i + (lane >> 5); scr[kk * 33 + (lane & 31)] = tv[i]; }
    LDS_WAIT();
    const int c = lane & 7;
#pragma unroll
    for (int j = 0; j < 4; ++j) { const int n = (lane >> 3) + 8 * j; const LAS float* s = scr + (8 * c) * 33 + n;
        u32x4 o; o.x = cvt_pk_bf16(s[0 * 33], s[1 * 33]); o.y = cvt_pk_bf16(s[2 * 33], s[3 * 33]); o.z = cvt_pk_bf16(s[4 * 33], s[5 * 33]); o.w = cvt_pk_bf16(s[6 * 33], s[7 * 33]);
        *(u32x4*)(WT + (size_t)(dst_row0 + n) * K + k0 + 8 * c) = o; }
    LDS_WAIT();
}
__device__ __forceinline__ void convert_weights(const Params& p, int l, LAS unsigned char* lds_scr, int gw, int NGW, int wave, int lane) {
    LAS float* scr = (LAS float*)(lds_scr + wave * 8448);
    bf16_t* wb = (bf16_t*)(p.ws + OFF_WB);
    constexpr int I_IN = 16 * 224, I_SQ = 16 * 32, I_F = 16 * 88, I_2 = 44 * 32;
    constexpr int NIT = I_IN + 3 * I_SQ + 2 * I_F + I_2;
    for (int it = gw; it < NIT; it += NGW) {
        int r = it;
        if (r < I_IN) { const int kb = r / 224, nb = r % 224; const int dc = nb * 32; const int sc = dc + (dc >= 3072 ? 16 : 0);
            transpose_item(p.w_in + (size_t)l * 1024 * INW, INW, sc, kb * 64, wb + WB_WIN / 2, 1024, dc, scr, lane); continue; } r -= I_IN;
        if (r < I_SQ) { const int kb = r / 32, nb = r % 32; transpose_item(p.w_pa + (size_t)l * 1024 * 1024, 1024, nb * 32, kb * 64, wb + WB_WPAB / 2, 1024, nb * 32, scr, lane); continue; } r -= I_SQ;
        if (r < I_SQ) { const int kb = r / 32, nb = r % 32; transpose_item(p.w_pb + (size_t)l * 1024 * 1024, 1024, nb * 32, kb * 64, wb + WB_WPAB / 2, 1024, 1024 + nb * 32, scr, lane); continue; } r -= I_SQ;
        if (r < I_SQ) { const int kb = r / 32, nb = r % 32; transpose_item(p.w_out + (size_t)l * 1024 * 1024, 1024, nb * 32, kb * 64, wb + WB_WOUT / 2, 1024, nb * 32, scr, lane); continue; } r -= I_SQ;
        if (r < I_F) { const int kb = r / 88, nb = r % 88; const int j0 = nb * 32; transpose_item(p.w_ff1 + (size_t)l * 1024 * DFF, DFF, j0, kb * 64, wb + WB_W13 / 2, 1024, 256 * (j0 >> 7) + (j0 & 127), scr, lane); continue; } r -= I_F;
        if (r < I_F) { const int kb = r / 88, nb = r % 88; const int j0 = nb * 32; transpose_item(p.w_ff3 + (size_t)l * 1024 * DFF, DFF, j0, kb * 64, wb + WB_W13 / 2, 1024, 256 * (j0 >> 7) + 128 + (j0 & 127), scr, lane); continue; } r -= I_F;
        { const int kb = r / 32, nb = r % 32; transpose_item(p.w_ff2 + (size_t)l * DFF * 1024, 1024, nb * 32, kb * 64, wb + WB_W2 / 2, DFF, nb * 32, scr, lane); }
    }
}

__device__ __forceinline__ void mods_phase(const Params& p, LAS unsigned char* lds, int tid, int wave, int lane) {
    LAS float* sc = (LAS float*)lds; LAS float* scc = sc + 1024; LAS float* red = scc + 1024;
    float* MOD = (float*)(p.ws + OFF_MOD);
    for (int i = tid; i < 1024; i += NTHREADS) { sc[i] = siluf_(p.c[i]); scc[i] = siluf_(p.c_ctx[i]); }
    __syncthreads();
    for (int item = blockIdx.x; item < 4 * 96; item += gridDim.x) {
        const int l = item / 96, col = (item % 96) * 64 + lane;
        const float* w = p.w_ada + (size_t)l * 1024 * 6144 + col;
        float ax = 0.f, ac = 0.f;
#pragma unroll 8
        for (int d = wave * 128; d < wave * 128 + 128; ++d) { const float wv = w[(size_t)d * 6144]; ax += sc[d] * wv; ac += scc[d] * wv; }
        red[(wave * 64 + lane) * 2] = ax; red[(wave * 64 + lane) * 2 + 1] = ac;
        __syncthreads();
        if (wave == 0) { float sx = 0.f, s2 = 0.f;
#pragma unroll
            for (int w8 = 0; w8 < 8; ++w8) { sx += red[(w8 * 64 + lane) * 2]; s2 += red[(w8 * 64 + lane) * 2 + 1]; }
            const float b = p.b_ada[l * 6144 + col];
            MOD[(size_t)(l * 2 + 0) * 6144 + col] = sx + b; MOD[(size_t)(l * 2 + 1) * 6144 + col] = s2 + b; }
        __syncthreads();
    }
}

template <bool GATES>
__device__ __forceinline__ void norm_phase(const Params& p, int l, LAS unsigned char* lds, int gw, int NGW, int tid, int lane) {
    const float* MOD = (const float*)(p.ws + OFF_MOD);
    float* CS = (float*)(p.ws + OFF_CS); bf16_t* H = (bf16_t*)(p.ws + OFF_H); float* G = (float*)(p.ws + OFF_G);
    const float* ng = (GATES ? p.norm1_g : p.norm2_g) + l * 1024;
    LAS float* wg = (LAS float*)lds;
    if (GATES) {
        const float* wsrc = p.w_in + (size_t)l * 1024 * INW + 3072;
        for (int i = tid; i < 16384; i += NTHREADS) { const int k = i >> 4, j = i & 15; wg[j * 1024 + k] = wsrc[(size_t)k * INW + j]; }
        __syncthreads();
    }
    const bool first = GATES && (l == 0);
    const bool spread = (NGW >= 64 * 32);
    const int n_lat = (T / 4 - 64 - gw + NGW - 1) / NGW;
    const int has_ctx = spread ? (((gw & 31) == 0 && (gw >> 5) < 64) ? 1 : 0) : 0;
    const int n_it = spread ? n_lat + has_ctx : (T / 4 - gw + NGW - 1) / NGW;
    for (int it = 0; it < n_it; ++it) {
        const int grp = spread ? ((it < n_lat) ? 64 + gw + it * NGW : (gw >> 5)) : gw + it * NGW;
        const int row0 = grp * 4; const bool isc = row0 < NCTX;
        const float* modp = MOD + (size_t)(l * 2 + (isc ? 1 : 0)) * 6144 + (GATES ? 0 : 3072);
        f32x4 gm[4], sh[4];
#pragma unroll
        for (int j = 0; j < 4; ++j) { const int col = 4 * lane + 256 * j; const f32x4 g4 = *(const f32x4*)(ng + col); const f32x4 s4 = *(const f32x4*)(modp + 1024 + col);
            sh[j] = *(const f32x4*)(modp + col); gm[j] = g4 * (s4 + 1.0f); }
        f32x4 xv[4][4];
#pragma unroll
        for (int r = 0; r < 4; ++r) {
            const int row = row0 + r;
            const float* src = first ? (isc ? p.ctx + (size_t)row * 1024 : p.x + (size_t)(row - NCTX) * 1024) : (isc ? CS + (size_t)row * 1024 : p.out + (size_t)(row - NCTX) * 1024);
#pragma unroll
            for (int j = 0; j < 4; ++j) xv[r][j] = *(const f32x4*)(src + 4 * lane + 256 * j);
        }
        if (first) {
#pragma unroll
            for (int r = 0; r < 4; ++r) { const int row = row0 + r; float* dst = isc ? CS + (size_t)row * 1024 : p.out + (size_t)(row - NCTX) * 1024;
#pragma unroll
                for (int j = 0; j < 4; ++j) *(f32x4*)(dst + 4 * lane + 256 * j) = xv[r][j]; }
        }
#pragma unroll
        for (int r = 0; r < 4; ++r) {
            float s = 0.f;
#pragma unroll
            for (int j = 0; j < 4; ++j) s += (xv[r][j][0] * xv[r][j][0] + xv[r][j][1] * xv[r][j][1]) + (xv[r][j][2] * xv[r][j][2] + xv[r][j][3] * xv[r][j][3]);
            const float rstd = rsqrtf(wave_sum(s) * (1.0f / 1024.0f) + EPS);
            bf16_t* hrow = H + (size_t)(row0 + r) * 1024;
#pragma unroll
            for (int j = 0; j < 4; ++j) { xv[r][j] = xv[r][j] * rstd * gm[j] + sh[j];
                u32x2 w; w.x = cvt_pk_bf16(xv[r][j][0], xv[r][j][1]); w.y = cvt_pk_bf16(xv[r][j][2], xv[r][j][3]);
                *(u32x2*)(hrow + 4 * lane + 256 * j) = w; }
        }
        if (GATES) {
            float v[64];
#pragma unroll
            for (int i = 0; i < 64; ++i) v[i] = 0.f;
#pragma unroll
            for (int gi = 0; gi < 16; ++gi) {
                if ((gi & 1) == 0) asm volatile("" ::: "memory");
#pragma unroll
                for (int j = 0; j < 4; ++j) { const f32x4 w4 = *(const LAS f32x4*)(wg + gi * 1024 + 4 * lane + 256 * j);
#pragma unroll
                    for (int r = 0; r < 4; ++r) v[r * 16 + gi] += (xv[r][j][0] * w4[0] + xv[r][j][1] * w4[1]) + (xv[r][j][2] * w4[2] + xv[r][j][3] * w4[3]); } }
#pragma unroll
            for (int i = 0; i < 32; ++i) { const bool hi = (lane & 32) != 0; const float keep = hi ? v[i + 32] : v[i]; const float send = hi ? v[i] : v[i + 32]; v[i] = keep + __shfl_xor(send, 32); }
#pragma unroll
            for (int i = 0; i < 16; ++i) { const bool hi = (lane & 16) != 0; const float keep = hi ? v[i + 16] : v[i]; const float send = hi ? v[i] : v[i + 16]; v[i] = keep + __shfl_xor(send, 16); }
#pragma unroll
            for (int i = 0; i < 8; ++i) { const bool hi = (lane & 8) != 0; const float keep = hi ? v[i + 8] : v[i]; const float send = hi ? v[i] : v[i + 8]; v[i] = keep + __shfl_xor(send, 8); }
#pragma unroll
            for (int i = 0; i < 4; ++i) { const bool hi = (lane & 4) != 0; const float keep = hi ? v[i + 4] : v[i]; const float send = hi ? v[i] : v[i + 4]; v[i] = keep + __shfl_xor(send, 4); }
#pragma unroll
            for (int i = 0; i < 2; ++i) { const bool hi = (lane & 2) != 0; const float keep = hi ? v[i + 2] : v[i]; const float send = hi ? v[i] : v[i + 2]; v[i] = keep + __shfl_xor(send, 2); }
            { const bool hi = (lane & 1) != 0; const float keep = hi ? v[1] : v[0]; const float send = hi ? v[0] : v[1]; v[0] = keep + __shfl_xor(send, 1); }
            const int gate = lane & 15;
            float val = v[0] + p.gate_b[l * 16 + gate];
            if (gate & 4) val = logsigf_(val);
            G[(size_t)row0 * 16 + lane] = val;
        }
    }
}

__device__ __forceinline__ void final_norm(const Params& p, int gw, int NGW, int lane) {
    f32x4 g4[4];
#pragma unroll
    for (int j = 0; j < 4; ++j) g4[j] = *(const f32x4*)(p.final_g + 4 * lane + 256 * j);
    for (int row = gw; row < T - NCTX; row += NGW) {
        float* rp = p.out + (size_t)row * 1024; f32x4 xv[4]; float s = 0.f;
#pragma unroll
        for (int j = 0; j < 4; ++j) { xv[j] = *(const f32x4*)(rp + 4 * lane + 256 * j); s += (xv[j][0] * xv[j][0] + xv[j][1] * xv[j][1]) + (xv[j][2] * xv[j][2] + xv[j][3] * xv[j][3]); }
        const float rstd = rsqrtf(wave_sum(s) * (1.0f / 1024.0f) + EPS);
#pragma unroll
        for (int j = 0; j < 4; ++j) { f32x4 o = xv[j] * rstd * g4[j];
#ifdef DBG_SANITIZE
#pragma unroll
            for (int e = 0; e < 4; ++e) if (!(fabsf(o[e]) < 1e30f)) o[e] = 10000.0f;
#endif
            *(f32x4*)(rp + 4 * lane + 256 * j) = o; }
    }
}

constexpr size_t OFF_FLAG = 300 * 1024;
#define FLAGBAD(cond, code) do { if (cond) atomicMin((unsigned*)(p.ws + OFF_FLAG), (unsigned)(code)); } while (0)
constexpr int LROW = 272;
__device__ __forceinline__ float wave_incl_sum(float v, int lane) {
#pragma unroll
    for (int o = 1; o < 64; o <<= 1) { const float t = __shfl_up(v, o); if (lane >= o) v += t; }
    return v;
}
__device__ __forceinline__ float wave_incl_max(float v, int lane) {
#pragma unroll
    for (int o = 1; o < 64; o <<= 1) { const float t = __shfl_up(v, o); if (lane >= o) v = fmaxf(v, t); }
    return v;
}

__device__ __forceinline__ void mixA_mlstm(const Params& p, int l, int c, int h, LAS unsigned char* lds, int tid, int wave, int lane) {
    const int fr = lane & 15, fq = lane >> 4;
    bf16_t* Z = (bf16_t*)(p.ws + OFF_Z); bf16_t* QK = (bf16_t*)(p.ws + OFF_QK); bf16_t* ST = (bf16_t*)(p.ws + OFF_ST);
    const float* G = (const float*)(p.ws + OFF_G); float* SC = (float*)(p.ws + OFF_SC); float* NS = (float*)(p.ws + OFF_NS);
    LAS unsigned char* KT = lds; LAS unsigned char* VT = lds + 128 * LROW;
    LAS float* wsrc = (LAS float*)(lds + 384 * LROW); LAS float* red = wsrc + 256;
    const int t0 = c * 128; const int seq_lo = (c < 2) ? 0 : NCTX, seq_hi = (c < 2) ? NCTX : T;
    const int gdir = wave & 1;
    const int gr0 = gdir ? 127 - 2 * lane : 2 * lane, gr1 = gdir ? gr0 - 1 : gr0 + 1;
    const float* gpp = G + (size_t)t0 * 16 + gdir * 8 + h;
    const float gi0 = gpp[gr0 * 16], gf0 = gpp[gr0 * 16 + 4], gi1 = gpp[gr1 * 16], gf1 = gpp[gr1 * 16 + 4];
    const float* cw = p.conv_w + (size_t)l * 5 * 1024; const float* cb_ = p.conv_b + (size_t)l * 1024;
#pragma unroll 1
    for (int qk = 0; qk < 2; ++qk) {
        const int tg = tid >> 4, cb = tid & 15;
        const int ch = qk * 512 + h * 128 + cb * 8;
        u32x4 rr[8];
#pragma unroll
        for (int i = 0; i < 8; ++i) { const int tt = t0 + tg * 4 - 2 + i; const int ttc = tt < seq_lo ? seq_lo : (tt >= seq_hi ? seq_hi - 1 : tt);
            rr[i] = *(const u32x4*)(Z + (size_t)ttc * 1024 + ch); }
        float wv[5][8], bv[8];
#pragma unroll
        for (int j = 0; j < 5; ++j) { const f32x4 a = *(const f32x4*)(cw + j * 1024 + ch), b = *(const f32x4*)(cw + j * 1024 + ch + 4);
            wv[j][0] = a[0]; wv[j][1] = a[1]; wv[j][2] = a[2]; wv[j][3] = a[3]; wv[j][4] = b[0]; wv[j][5] = b[1]; wv[j][6] = b[2]; wv[j][7] = b[3]; }
        { const f32x4 a = *(const f32x4*)(cb_ + ch), b = *(const f32x4*)(cb_ + ch + 4); bv[0] = a[0]; bv[1] = a[1]; bv[2] = a[2]; bv[3] = a[3]; bv[4] = b[0]; bv[5] = b[1]; bv[6] = b[2]; bv[7] = b[3]; }
        float xin[8][8];
#pragma unroll
        for (int i = 0; i < 8; ++i) { const int tt = t0 + tg * 4 - 2 + i; const bool ok = (tt >= seq_lo) && (tt < seq_hi);
            const unsigned w4[4] = {rr[i].x, rr[i].y, rr[i].z, rr[i].w};
#pragma unroll
            for (int e = 0; e < 4; ++e) { xin[i][2 * e] = ok ? bf_lo(w4[e]) : 0.f; xin[i][2 * e + 1] = ok ? bf_hi(w4[e]) : 0.f; } }
        const float scl = qk ? 1.0f : 0.08838834764831845f;
        unsigned outw[4][4];
#pragma unroll
        for (int o = 0; o < 4; ++o) { float a[8];
#pragma unroll
            for (int e = 0; e < 8; ++e) { float acc = bv[e];
#pragma unroll
                for (int j = 0; j < 5; ++j) acc += wv[j][e] * xin[o + j][e];
                a[e] = siluf_(acc) * scl; }
            outw[o][0] = cvt_pk_bf16(a[0], a[1]); outw[o][1] = cvt_pk_bf16(a[2], a[3]); outw[o][2] = cvt_pk_bf16(a[4], a[5]); outw[o][3] = cvt_pk_bf16(a[6], a[7]);
            u32x4 w; w.x = outw[o][0]; w.y = outw[o][1]; w.z = outw[o][2]; w.w = outw[o][3];
            *(u32x4*)(QK + (size_t)(t0 + tg * 4 + o) * 1024 + ch) = w; }
        if (qk) {
#pragma unroll
            for (int e = 0; e < 8; ++e) { const int sh = (e & 1) * 16; const int wi = e >> 1;
                const unsigned t0v = (outw[0][wi] >> sh) & 0xffffu, t1v = (outw[1][wi] >> sh) & 0xffffu, t2v = (outw[2][wi] >> sh) & 0xffffu, t3v = (outw[3][wi] >> sh) & 0xffffu;
                u32x2 pk; pk.x = t0v | (t1v << 16); pk.y = t2v | (t3v << 16);
                *(LAS u32x2*)(KT + (cb * 8 + e) * LROW + tg * 8) = pk; }
        }
    }
    bf16_t* Zv = Z + PLANE + (size_t)t0 * 1024 + h * 256;
#pragma unroll
    for (int ps = 0; ps < 8; ++ps) {
        const int tok = tid & 127; const int d0 = ((tid >> 7) + 4 * ps) * 8;
        const u32x4 r = *(const u32x4*)(Zv + (size_t)tok * 1024 + d0);
        const unsigned ww[4] = {r.x, r.y, r.z, r.w};
#pragma unroll
        for (int e = 0; e < 8; ++e) *(LAS bf16_t*)(VT + (d0 + e) * LROW + tok * 2) = (bf16_t)((e & 1) ? (ww[e >> 1] >> 16) : (ww[e >> 1] & 0xffffu));
    }
    if (wave < 2) {
        const int dir = wave;
        const int r0 = gr0, r1 = gr1;
        const float i0 = gi0, f0 = gf0, i1 = gi1, f1 = gf1;
        const float s = f0 + f1; const float incl = wave_incl_sum(s, lane); const float b0 = incl - s + f0, b1 = incl;
        const float B0 = i0 - b0, B1 = i1 - b1;
        const float cmB = wave_max(fmaxf(B0, B1)); const float bend = __shfl(b1, 63);
        wsrc[dir * 128 + r0] = __expf(B0 - cmB); wsrc[dir * 128 + r1] = __expf(B1 - cmB);
        if (lane == 0) { SC[((c * 2 + dir) * 4 + h) * 2] = bend; SC[((c * 2 + dir) * 4 + h) * 2 + 1] = bend + cmB; }
    }
    LDS_BARRIER();
#pragma unroll
    for (int ps = 0; ps < 8; ++ps) {
        const int dv = (tid >> 4) + 32 * ps, chn = tid & 15;
        const u32x4 r = *(const LAS u32x4*)(VT + dv * LROW + chn * 16);
        *(u32x4*)(Zv + (size_t)(dv >> 1) * 1024 + (dv & 1) * 128 + chn * 8) = r;
    }
#pragma unroll 1
    for (int dir = 0; dir < 2; ++dir) {
        f32x4 acc[2][8];
#pragma unroll
        for (int m = 0; m < 2; ++m)
#pragma unroll
            for (int n = 0; n < 8; ++n) acc[m][n] = (f32x4){0.f, 0.f, 0.f, 0.f};
#pragma unroll
        for (int ks = 0; ks < 4; ++ks) {
            const LAS float* wp = wsrc + dir * 128 + 32 * ks + 8 * fq;
            const f32x4 w0 = *(const LAS f32x4*)wp, w1 = *(const LAS f32x4*)(wp + 4);
#ifdef DBG_CHECK
            if (l == 0) { bool b = false;
                for (int e = 0; e < 4; ++e) { if (!(w0[e] >= 0.f && w0[e] <= 1.0001f)) b = true; if (!(w1[e] >= 0.f && w1[e] <= 1.0001f)) b = true; }
                FLAGBAD(b, 71); }
#endif
            bf16x8 af[2];
#pragma unroll
            for (int m = 0; m < 2; ++m) { const u32x4 r = *(const LAS u32x4*)(VT + (32 * wave + 16 * m + fr) * LROW + 64 * ks + 16 * fq);
                u32x4 o; o.x = cvt_pk_bf16(bf_lo(r.x) * w0[0], bf_hi(r.x) * w0[1]); o.y = cvt_pk_bf16(bf_lo(r.y) * w0[2], bf_hi(r.y) * w0[3]);
                o.z = cvt_pk_bf16(bf_lo(r.z) * w1[0], bf_hi(r.z) * w1[1]); o.w = cvt_pk_bf16(bf_lo(r.w) * w1[2], bf_hi(r.w) * w1[3]);
                af[m] = __builtin_bit_cast(bf16x8, o);
#ifdef DBG_CHECK
                if (l == 0) { bool b = false; const unsigned rr[4] = {r.x, r.y, r.z, r.w};
                    for (int e = 0; e < 4; ++e) { if (!(fabsf(bf_lo(rr[e])) < 1e4f)) b = true; if (!(fabsf(bf_hi(rr[e])) < 1e4f)) b = true; }
                    FLAGBAD(b, 72); }
#endif
            }
#pragma unroll
            for (int n = 0; n < 8; ++n) { const bf16x8 bfv = *(const LAS bf16x8*)(KT + (16 * n + fr) * LROW + 64 * ks + 16 * fq);
#ifdef DBG_CHECK
                if (l == 0) { bool b = false; const u32x4 rk = __builtin_bit_cast(u32x4, bfv); const unsigned rr[4] = {rk.x, rk.y, rk.z, rk.w};
                    for (int e = 0; e < 4; ++e) { if (!(fabsf(bf_lo(rr[e])) < 1e4f)) b = true; if (!(fabsf(bf_hi(rr[e])) < 1e4f)) b = true; }
                    FLAGBAD(b, 73); }
#endif
#pragma unroll
                for (int m = 0; m < 2; ++m) acc[m][n] = __builtin_amdgcn_mfma_f32_16x16x32_bf16(bfv, af[m], acc[m][n], 0, 0, 0); }
        }
#ifdef DBG_CHECK
        if (l == 0) { bool b = false;
            for (int m = 0; m < 2; ++m) for (int n = 0; n < 8; ++n) for (int e = 0; e < 4; ++e) if (!(fabsf(acc[m][n][e]) < 1e6f)) b = true;
            FLAGBAD(b, 74); }
#endif
        bf16_t* st = ST + (size_t)((c * 2 + dir) * 4 + h) * 32768;
#pragma unroll
        for (int m = 0; m < 2; ++m)
#pragma unroll
            for (int n = 0; n < 8; ++n) { u32x2 w; w.x = cvt_pk_bf16(acc[m][n][0], acc[m][n][1]); w.y = cvt_pk_bf16(acc[m][n][2], acc[m][n][3]);
                *(u32x2*)(st + (32 * wave + 16 * m + fr) * 128 + 16 * n + 4 * fq) = w; }
        { const int dk = tid & 127, part = tid >> 7; float s = 0.f;
#pragma unroll 8
          for (int e = 0; e < 32; ++e) { const int sidx = part * 32 + e; s += wsrc[dir * 128 + sidx] * __uint_as_float(((unsigned)*(const LAS bf16_t*)(KT + dk * LROW + sidx * 2)) << 16); }
          red[(dir * 4 + part) * 128 + dk] = s; }
    }
    LDS_BARRIER();
    if (tid < 256) { const int dir = tid >> 7, dk = tid & 127;
        NS[(size_t)((c * 2 + dir) * 4 + h) * 128 + dk] = (red[(dir * 4 + 0) * 128 + dk] + red[(dir * 4 + 1) * 128 + dk]) + (red[(dir * 4 + 2) * 128 + dk] + red[(dir * 4 + 3) * 128 + dk]); }
    LDS_BARRIER();
}

__device__ __forceinline__ void mixA_spatial(const Params& p, int l, int c, int g, LAS unsigned char* lds, int tid, int wave, int lane) {
    const int fr = lane & 15, fq = lane >> 4;
    const bf16_t* Z = (const bf16_t*)(p.ws + OFF_Z); bf16_t* YB = (bf16_t*)(p.ws + OFF_H);
    LAS unsigned char* VBT = lds; LAS unsigned char* WS = lds + 256 * LROW;
    const int t0 = c * 128;
    const bf16_t* Zvb = Z + 4 * PLANE + (size_t)t0 * 1024;
    LAS float* rstdv = (LAS float*)(lds + 384 * LROW);
    if (tid < 128) { const float* sp = (const float*)(p.ws + OFF_SSQ) + (size_t)(t0 + tid) * 16;
        const f32x4 a = *(const f32x4*)sp, b = *(const f32x4*)(sp + 4), c4 = *(const f32x4*)(sp + 8), d = *(const f32x4*)(sp + 12);
        const float tot = ((a[0] + a[1]) + (a[2] + a[3])) + ((b[0] + b[1]) + (b[2] + b[3])) + ((c4[0] + c4[1]) + (c4[2] + c4[3])) + ((d[0] + d[1]) + (d[2] + d[3]));
        rstdv[tid] = rsqrtf(tot * (1.0f / 1024.0f) + EPS); }
    LDS_BARRIER();
#pragma unroll
    for (int ps = 0; ps < 8; ++ps) {
        const int tok = tid & 127; const int d0 = ((tid >> 7) + 4 * ps) * 8;
        const u32x4 r = *(const u32x4*)(Zvb + (size_t)tok * 1024 + 256 * g + d0);
        const float* vn = p.vnorm_g + (size_t)l * 1024 + 256 * g + d0; const f32x4 ga = *(const f32x4*)vn, gb = *(const f32x4*)(vn + 4);
        const float rs = rstdv[tok];
        const unsigned rr[4] = {r.x, r.y, r.z, r.w}; const float gg[8] = {ga[0], ga[1], ga[2], ga[3], gb[0], gb[1], gb[2], gb[3]};
#pragma unroll
        for (int e = 0; e < 4; ++e) { const unsigned w = cvt_pk_bf16(bf_lo(rr[e]) * rs * gg[2 * e], bf_hi(rr[e]) * rs * gg[2 * e + 1]);
            *(LAS bf16_t*)(VBT + (d0 + 2 * e) * LROW + tok * 2) = (bf16_t)(w & 0xffffu); *(LAS bf16_t*)(VBT + (d0 + 2 * e + 1) * LROW + tok * 2) = (bf16_t)(w >> 16); }
    }
    { const float* wsp = p.w_sp + ((size_t)l * 4 + g) * 16384;
#pragma unroll
      for (int i = 0; i < 8; ++i) { const int idx = tid + 512 * i; const int t = idx >> 5, s4 = idx & 31; const f32x4 w4 = *(const f32x4*)(wsp + (size_t)idx * 4);
          u32x2 o; o.x = cvt_pk_bf16(w4[0], w4[1]); o.y = cvt_pk_bf16(w4[2], w4[3]); *(LAS u32x2*)(WS + t * LROW + s4 * 8) = o; } }
    LDS_BARRIER();
    f32x4 acc[8][2];
#pragma unroll
    for (int m = 0; m < 8; ++m)
#pragma unroll
        for (int n = 0; n < 2; ++n) acc[m][n] = (f32x4){0.f, 0.f, 0.f, 0.f};
#pragma unroll
    for (int ks = 0; ks < 4; ++ks) {
        bf16x8 bfv[2];
#pragma unroll
        for (int n = 0; n < 2; ++n) bfv[n] = *(const LAS bf16x8*)(VBT + (32 * wave + 16 * n + fr) * LROW + 64 * ks + 16 * fq);
#pragma unroll
        for (int m = 0; m < 8; ++m) { const bf16x8 af = *(const LAS bf16x8*)(WS + (16 * m + fr) * LROW + 64 * ks + 16 * fq);
#pragma unroll
            for (int n = 0; n < 2; ++n) acc[m][n] = __builtin_amdgcn_mfma_f32_16x16x32_bf16(bfv[n], af, acc[m][n], 0, 0, 0); }
    }
    const bf16_t* Zu = Z + 3 * PLANE + (size_t)t0 * 1024 + 256 * g;
    const float* bsp = p.b_sp + ((size_t)l * 4 + g) * 128;
#pragma unroll
    for (int m = 0; m < 8; ++m) { const int t = 16 * m + fr; const float bb = bsp[t];
#pragma unroll
        for (int n = 0; n < 2; ++n) { const int d = 32 * wave + 16 * n + 4 * fq;
            const u32x2 ur = *(const u32x2*)(Zu + (size_t)t * 1024 + d);
            const float y0 = bf_lo(ur.x) * (acc[m][n][0] + bb), y1 = bf_hi(ur.x) * (acc[m][n][1] + bb), y2 = bf_lo(ur.y) * (acc[m][n][2] + bb), y3 = bf_hi(ur.y) * (acc[m][n][3] + bb);
            u32x2 o; o.x = cvt_pk_bf16(y0, y1); o.y = cvt_pk_bf16(y2, y3);
            *(u32x2*)(YB + (size_t)(t0 + t) * 1024 + 256 * g + d) = o; } }
    LDS_BARRIER();
}

__device__ __forceinline__ int scan_chunk(int dir, int k) { return dir ? (k < 2 ? 1 - k : 131 - k) : k; }
__device__ __forceinline__ void scan_phase(const Params& p, int tid) {
    bf16_t* ST = (bf16_t*)(p.ws + OFF_ST); const float* SC = (const float*)(p.ws + OFF_SC); float* MP = (float*)(p.ws + OFF_MP); float* NS = (float*)(p.ws + OFF_NS);
    const int gid = blockIdx.x * NTHREADS + tid, gsz = gridDim.x * NTHREADS;
    for (int pr = gid; pr < 8 * 16384; pr += gsz) {
        const int dh = pr >> 14, e = pr & 16383, dir = dh >> 2, h = dh & 3;
        float c0 = 0.f, c1 = 0.f, m = 0.f;
#pragma unroll 1
        for (int k0 = 0; k0 < NCH; k0 += 26) {
            unsigned dv[26]; float be[26], ml[26];
#pragma unroll
            for (int j = 0; j < 26; ++j) { const int c = scan_chunk(dir, k0 + j); const int sl = (c * 2 + dir) * 4 + h;
                dv[j] = *(const unsigned*)(ST + (size_t)sl * 32768 + 2 * e); be[j] = SC[sl * 2]; ml[j] = SC[sl * 2 + 1]; }
#pragma unroll
            for (int j = 0; j < 26; ++j) { const int c = scan_chunk(dir, k0 + j); const int sl = (c * 2 + dir) * 4 + h;
                *(unsigned*)(ST + (size_t)sl * 32768 + 2 * e) = cvt_pk_bf16(c0, c1);
                if (e == 0) MP[sl] = m;
                const float mn = fmaxf(be[j] + m, ml[j]); const float wc = __expf(be[j] + m - mn), wl = __expf(ml[j] - mn);
                c0 = wc * c0 + wl * bf_lo(dv[j]); c1 = wc * c1 + wl * bf_hi(dv[j]); m = mn; }
        }
    }
    const int rg = gsz - 1 - gid;
    if (rg < 1024) {
        const int dh = rg >> 7, dk = rg & 127, dir = dh >> 2, h = dh & 3;
        float n = 0.f, m = 0.f;
#pragma unroll 1
        for (int k0 = 0; k0 < NCH; k0 += 26) {
            float dn[26], be[26], ml[26];
#pragma unroll
            for (int j = 0; j < 26; ++j) { const int c = scan_chunk(dir, k0 + j); const int sl = (c * 2 + dir) * 4 + h; dn[j] = NS[(size_t)sl * 128 + dk]; be[j] = SC[sl * 2]; ml[j] = SC[sl * 2 + 1]; }
#pragma unroll
            for (int j = 0; j < 26; ++j) { const int c = scan_chunk(dir, k0 + j); const int sl = (c * 2 + dir) * 4 + h;
                NS[(size_t)sl * 128 + dk] = n;
                const float mn = fmaxf(be[j] + m, ml[j]); n = __expf(be[j] + m - mn) * n + __expf(ml[j] - mn) * dn[j]; m = mn; }
        }
    }
}

__device__ __forceinline__ void mixC_item(const Params& p, int l, int c, int h, LAS unsigned char* lds, int tid, int wave, int lane) {
    const int fr = lane & 15, fq = lane >> 4;
    const bf16_t* Z = (const bf16_t*)(p.ws + OFF_Z); const bf16_t* QK = (const bf16_t*)(p.ws + OFF_QK); const bf16_t* ST = (const bf16_t*)(p.ws + OFF_ST);
    bf16_t* YA = (bf16_t*)(p.ws + OFF_Z);
    const float* G = (const float*)(p.ws + OFF_G); const float* MP = (const float*)(p.ws + OFF_MP); const float* NS = (const float*)(p.ws + OFF_NS);
    LAS unsigned char* Qs = lds; LAS unsigned char* Ks = lds + 128 * LROW; LAS unsigned char* QBs = lds + 256 * LROW;
    LAS float* vec = (LAS float*)(lds + 384 * LROW);
    LAS float* Bv = vec;
    LAS float* Mx = vec + 256;
    LAS float* bt = vec + 512;
    LAS float* npv = vec + 768;
    LAS float* qnp = vec + 1024;
    LAS float* cfv = vec + 2048;
    LAS float* ssq = vec + 2304;
    LAS float* mpv = vec + 3328;
    const int t0 = c * 128;
#pragma unroll
    for (int ps = 0; ps < 4; ++ps) { const int tok = (tid >> 4) + 32 * ps, chn = tid & 15;
        const u32x4 q = *(const u32x4*)(QK + (size_t)(t0 + tok) * 1024 + h * 128 + chn * 8), k = *(const u32x4*)(QK + (size_t)(t0 + tok) * 1024 + 512 + h * 128 + chn * 8);
        *(LAS u32x4*)(Qs + tok * LROW + chn * 16) = q; *(LAS u32x4*)(Ks + tok * LROW + chn * 16) = k; }
    if (wave < 2) {
        const int dir = wave; const int sl = (c * 2 + dir) * 4 + h;
        const int r0 = dir ? 127 - 2 * lane : 2 * lane, r1 = dir ? r0 - 1 : r0 + 1;
        const float* gp = G + (size_t)t0 * 16 + dir * 8 + h;
        const float i0 = gp[r0 * 16], f0 = gp[r0 * 16 + 4], i1 = gp[r1 * 16], f1 = gp[r1 * 16 + 4];
        const float s = f0 + f1; const float incl = wave_incl_sum(s, lane); const float b0 = incl - s + f0, b1 = incl;
        const float B0 = i0 - b0, B1 = i1 - b1;
        const float pm = fmaxf(B0, B1); const float cmi = wave_incl_max(pm, lane);
        float cme = __shfl_up(cmi, 1); if (lane == 0) cme = -INFINITY;
        const float mprev = MP[sl];
        const float cm0 = fmaxf(cme, B0), cm1 = cmi;
        Bv[dir * 128 + r0] = B0; Bv[dir * 128 + r1] = B1;
        Mx[dir * 128 + r0] = fmaxf(mprev, cm0); Mx[dir * 128 + r1] = fmaxf(mprev, cm1);
        bt[dir * 128 + r0] = b0; bt[dir * 128 + r1] = b1;
        npv[dir * 128 + lane] = NS[(size_t)sl * 128 + lane]; npv[dir * 128 + 64 + lane] = NS[(size_t)sl * 128 + 64 + lane];
        if (lane == 0) mpv[dir] = mprev;
    }
    LDS_BARRIER();
    f32x4 S[8];
#pragma unroll
    for (int n = 0; n < 8; ++n) S[n] = (f32x4){0.f, 0.f, 0.f, 0.f};
#pragma unroll
    for (int ks = 0; ks < 4; ++ks) { const bf16x8 af = *(const LAS bf16x8*)(Qs + (16 * wave + fr) * LROW + 64 * ks + 16 * fq);
#pragma unroll
        for (int n = 0; n < 8; ++n) { const bf16x8 bfv = *(const LAS bf16x8*)(Ks + (16 * n + fr) * LROW + 64 * ks + 16 * fq);
            S[n] = __builtin_amdgcn_mfma_f32_16x16x32_bf16(bfv, af, S[n], 0, 0, 0); } }
    { const int t = tid & 127, part = tid >> 7; float sf = 0.f, sb = 0.f;
#pragma unroll
      for (int e8 = 0; e8 < 4; ++e8) { const u32x4 r = *(const LAS u32x4*)(Qs + t * LROW + part * 64 + e8 * 16); const int d = part * 32 + e8 * 8;
          const float qv[8] = {bf_lo(r.x), bf_hi(r.x), bf_lo(r.y), bf_hi(r.y), bf_lo(r.z), bf_hi(r.z), bf_lo(r.w), bf_hi(r.w)};
#pragma unroll
          for (int e = 0; e < 8; ++e) { sf += qv[e] * npv[d + e]; sb += qv[e] * npv[128 + d + e]; } }
      qnp[(0 * 4 + part) * 128 + t] = sf; qnp[(1 * 4 + part) * 128 + t] = sb; }
    LDS_BARRIER();
    {
        const int t = 16 * wave + fr;
        const float mxf = Mx[t], mxb = Mx[128 + t];
        float pf[8][4], pb[8][4]; float sumf = 0.f, sumb = 0.f;
#pragma unroll
        for (int n = 0; n < 8; ++n) { const f32x4 bf4 = *(const LAS f32x4*)(Bv + 16 * n + 4 * fq), bb4 = *(const LAS f32x4*)(Bv + 128 + 16 * n + 4 * fq);
#pragma unroll
            for (int j = 0; j < 4; ++j) { const int s = 16 * n + 4 * fq + j;
                const float ef = (s <= t) ? __expf(bf4[j] - mxf) : 0.f; const float eb = (s >= t) ? __expf(bb4[j] - mxb) : 0.f;
                pf[n][j] = S[n][j] * ef; pb[n][j] = S[n][j] * eb; sumf += pf[n][j]; sumb += pb[n][j]; } }
        sumf += __shfl_xor(sumf, 16); sumf += __shfl_xor(sumf, 32); sumb += __shfl_xor(sumb, 16); sumb += __shfl_xor(sumb, 32);
        const float qnf = (qnp[0 * 128 + t] + qnp[1 * 128 + t]) + (qnp[2 * 128 + t] + qnp[3 * 128 + t]);
        const float qnb = (qnp[4 * 128 + t] + qnp[5 * 128 + t]) + (qnp[6 * 128 + t] + qnp[7 * 128 + t]);
        const float wpf = __expf(mpv[0] - mxf), wpb = __expf(mpv[1] - mxb);
        const float denf = sumf + wpf * qnf, denb = sumb + wpb * qnb;
        const float rsf = 1.0f / fmaxf(fabsf(denf), __expf(-(bt[t] + mxf))), rsb = 1.0f / fmaxf(fabsf(denb), __expf(-(bt[128 + t] + mxb)));
        if (fq == 0) { cfv[t] = wpf * rsf; cfv[128 + t] = wpb * rsb; }
#pragma unroll
        for (int n = 0; n < 8; ++n) { u32x2 o; o.x = cvt_pk_bf16(pf[n][0] * rsf + pb[n][0] * rsb, pf[n][1] * rsf + pb[n][1] * rsb); o.y = cvt_pk_bf16(pf[n][2] * rsf + pb[n][2] * rsb, pf[n][3] * rsf + pb[n][3] * rsb);
            *(LAS u32x2*)(Ks + t * LROW + 32 * n + 8 * fq) = o; }
    }
    LDS_BARRIER();
    f32x4 acc[8][2];
#pragma unroll
    for (int m = 0; m < 8; ++m)
#pragma unroll
        for (int n = 0; n < 2; ++n) acc[m][n] = (f32x4){0.f, 0.f, 0.f, 0.f};
    const bf16_t* Zv = Z + PLANE + (size_t)t0 * 1024 + h * 256;
    const bf16_t* Zo = Z + 2 * PLANE + (size_t)t0 * 1024 + h * 256;
    u32x2 orw[8][2];
#pragma unroll
    for (int m = 0; m < 8; ++m)
#pragma unroll
        for (int n = 0; n < 2; ++n) orw[m][n] = *(const u32x2*)(Zo + (size_t)(16 * m + fr) * 1024 + 32 * wave + 16 * n + 4 * fq);
    const float* hg = p.head_g + ((size_t)l * 4 + h) * 256;
    f32x4 hg4[2];
#pragma unroll
    for (int n = 0; n < 2; ++n) hg4[n] = *(const f32x4*)(hg + 32 * wave + 16 * n + 4 * fq);
    {
        bf16x8 bfv[2][4];
#pragma unroll
        for (int n = 0; n < 2; ++n) { const int dv = 32 * wave + 16 * n + fr; const bf16_t* bp = Zv + (size_t)(dv >> 1) * 1024 + (dv & 1) * 128;
#pragma unroll
            for (int ks = 0; ks < 4; ++ks) bfv[n][ks] = *(const bf16x8*)(bp + 32 * ks + 8 * fq); }
#pragma unroll
        for (int ks = 0; ks < 4; ++ks)
#pragma unroll
            for (int m = 0; m < 8; ++m) { const bf16x8 af = *(const LAS bf16x8*)(Ks + (16 * m + fr) * LROW + 64 * ks + 16 * fq);
#pragma unroll
                for (int n = 0; n < 2; ++n) acc[m][n] = __builtin_amdgcn_mfma_f32_16x16x32_bf16(bfv[n][ks], af, acc[m][n], 0, 0, 0); }
    }
#pragma unroll 1
    for (int sg = 0; sg < 2; ++sg) {
        asm volatile("" ::: "memory");
        bf16x8 bfv[2][4];
#pragma unroll
        for (int n = 0; n < 2; ++n) { const int dv = 32 * wave + 16 * n + fr; const bf16_t* bp = ST + (size_t)((c * 2 + sg) * 4 + h) * 32768 + dv * 128;
#pragma unroll
            for (int ks = 0; ks < 4; ++ks) bfv[n][ks] = *(const bf16x8*)(bp + 32 * ks + 8 * fq); }
#pragma unroll
        for (int mh = 0; mh < 2; ++mh) {
            f32x4 tmp[4][2];
#pragma unroll
            for (int m = 0; m < 4; ++m)
#pragma unroll
                for (int n = 0; n < 2; ++n) tmp[m][n] = (f32x4){0.f, 0.f, 0.f, 0.f};
#pragma unroll
            for (int ks = 0; ks < 4; ++ks)
#pragma unroll
                for (int m = 0; m < 4; ++m) { const bf16x8 af = *(const LAS bf16x8*)(Qs + (16 * (4 * mh + m) + fr) * LROW + 64 * ks + 16 * fq);
#pragma unroll
                    for (int n = 0; n < 2; ++n) tmp[m][n] = __builtin_amdgcn_mfma_f32_16x16x32_bf16(bfv[n][ks], af, tmp[m][n], 0, 0, 0); }
#pragma unroll
            for (int m = 0; m < 4; ++m) { const float cs_ = cfv[sg * 128 + 16 * (4 * mh + m) + fr];
#pragma unroll
                for (int n = 0; n < 2; ++n) acc[4 * mh + m][n] += tmp[m][n] * cs_; }
        }
    }
#pragma unroll
    for (int m = 0; m < 8; ++m) { float s = 0.f;
#pragma unroll
        for (int n = 0; n < 2; ++n) s += (acc[m][n][0] * acc[m][n][0] + acc[m][n][1] * acc[m][n][1]) + (acc[m][n][2] * acc[m][n][2] + acc[m][n][3] * acc[m][n][3]);
        s += __shfl_xor(s, 16); s += __shfl_xor(s, 32);
        if (fq == 0) ssq[wave * 128 + 16 * m + fr] = s; }
    LDS_BARRIER();
#pragma unroll
    for (int m = 0; m < 8; ++m) { const int t = 16 * m + fr; float tot = 0.f;
#pragma unroll
        for (int w8 = 0; w8 < 8; ++w8) tot += ssq[w8 * 128 + t];
        const float rstd = rsqrtf(tot * (1.0f / 256.0f) + EPS);
#pragma unroll
        for (int n = 0; n < 2; ++n) { const int dv = 32 * wave + 16 * n + 4 * fq;
            const u32x2 ow = orw[m][n];
            const float y0 = acc[m][n][0] * rstd * hg4[n][0] * sigmoidf_(bf_lo(ow.x)), y1 = acc[m][n][1] * rstd * hg4[n][1] * sigmoidf_(bf_hi(ow.x));
            const float y2 = acc[m][n][2] * rstd * hg4[n][2] * sigmoidf_(bf_lo(ow.y)), y3 = acc[m][n][3] * rstd * hg4[n][3] * sigmoidf_(bf_hi(ow.y));
            u32x2 o; o.x = cvt_pk_bf16(y0, y1); o.y = cvt_pk_bf16(y2, y3);
            *(u32x2*)(YA + (size_t)(t0 + t) * 1024 + h * 256 + dv) = o; } }
    LDS_BARRIER();
}


template <int MODE>
__device__ __forceinline__ void ctx_gemm_tile(const bf16_t* A0, const bf16_t* A1, const bf16_t* Bt, const int K, const bf16_t* GA, const bf16_t* GB, bf16_t* O, float* cs, const float* gc,
                                              LAS unsigned char* lds, int tile, int tid, int wave, int lane) {
    const int fr = lane & 15, fq = lane >> 4;
    const int row0 = (tile >> 5) * 32, col0 = (tile & 31) * 32;
    const int seg = (MODE == 0) ? (wave >> 2) : 0;
    const int kw = (MODE == 0) ? K / 4 : K / 8;
    const int kb = ((MODE == 0) ? (wave & 3) : wave) * kw;
    const bf16_t* A = (seg ? A1 : A0) + (size_t)(row0 + fr) * K + kb + 8 * fq;
    const bf16_t* B = Bt + (size_t)(seg * 1024 + col0 + fr) * K + kb + 8 * fq;
    f32x4 acc[2][2];
#pragma unroll
    for (int m = 0; m < 2; ++m)
#pragma unroll
        for (int n = 0; n < 2; ++n) acc[m][n] = (f32x4){0.f, 0.f, 0.f, 0.f};
#pragma unroll 4
    for (int k = 0; k < kw; k += 32) {
        bf16x8 a[2], b[2];
#pragma unroll
        for (int m = 0; m < 2; ++m) a[m] = *(const bf16x8*)(A + (size_t)(16 * m) * K + k);
#pragma unroll
        for (int n = 0; n < 2; ++n) b[n] = *(const bf16x8*)(B + (size_t)(16 * n) * K + k);
#pragma unroll
        for (int m = 0; m < 2; ++m)
#pragma unroll
            for (int n = 0; n < 2; ++n) acc[m][n] = __builtin_amdgcn_mfma_f32_16x16x32_bf16(b[n], a[m], acc[m][n], 0, 0, 0);
    }
    LAS float* red = (LAS float*)lds;
#pragma unroll
    for (int m = 0; m < 2; ++m)
#pragma unroll
        for (int n = 0; n < 2; ++n) *(LAS f32x4*)(red + wave * 1024 + (16 * m + fr) * 32 + 16 * n + 4 * fq) = acc[m][n];
    __syncthreads();
    const int r = tid >> 4, c2 = (tid & 15) * 2;
    float pa0 = 0.f, pa1 = 0.f, pb0 = 0.f, pb1 = 0.f;
#pragma unroll
    for (int w = 0; w < 8; ++w) { const f32x2 v = *(const LAS f32x2*)(red + w * 1024 + r * 32 + c2);
        if (MODE == 0 && w >= 4) { pb0 += v[0]; pb1 += v[1]; } else { pa0 += v[0]; pa1 += v[1]; } }
    const size_t o = (size_t)(row0 + r) * 1024 + col0 + c2;
    if (MODE == 0) {
        const unsigned ga = *(const unsigned*)(GA + o), gb = *(const unsigned*)(GB + o);
        const float m0 = sigmoidf_(bf_lo(ga)) * pa0 + sigmoidf_(bf_lo(gb)) * pb0, m1 = sigmoidf_(bf_hi(ga)) * pa1 + sigmoidf_(bf_hi(gb)) * pb1;
        *(unsigned*)(O + o) = cvt_pk_bf16(m0, m1);
    } else {
        const f32x2 g2 = *(const f32x2*)(gc + col0 + c2); f32x2* pp = (f32x2*)(cs + o); f32x2 x = *pp; x[0] += g2[0] * pa0; x[1] += g2[1] * pa1; *pp = x;
    }
    __syncthreads();
}


constexpr size_t OFF_BAR = 280 * 1024;
#define XB_TMO      128
#define XB_XCNT(j)  (256  + 64 * (j))
#define XB_XSUB(j)  (1280 + 64 * (j))
#define XB_XGEN(j)  (2304 + 64 * (j))
#define XB_TOP      3328
#define XB_TOPGEN   3392
#define XCD_BAR_WORDS 3456
#define XB_SPIN_CAP (1u << 22)
__device__ __forceinline__ unsigned xb_ld(unsigned* p)              { return __hip_atomic_load(p, __ATOMIC_RELAXED, __HIP_MEMORY_SCOPE_AGENT); }
__device__ __forceinline__ unsigned xb_add(unsigned* p, unsigned v) { return __hip_atomic_fetch_add(p, v, __ATOMIC_RELAXED, __HIP_MEMORY_SCOPE_AGENT); }
__device__ __forceinline__ unsigned xb_xcc_id() { return (unsigned)__builtin_amdgcn_s_getreg((3 << 11) | 20) & 0xFu; }
#define XB_SPIN(cond, bar) do { unsigned _sp = 0; while (cond) { __builtin_amdgcn_s_sleep(1); \
    if ((++_sp & 255u) == 0u) { if (xb_ld(&(bar)[XB_TMO])) break; if (_sp > XB_SPIN_CAP) { atomicAdd(&(bar)[XB_TMO], 1u); break; } } } } while (0)
struct XcdBarrier { unsigned* bar; unsigned x; volatile LAS unsigned* st; };
__device__ __forceinline__ void xcd_barrier_complete(unsigned* bar, unsigned x, unsigned& nloc, unsigned& nx) {
    const unsigned G = gridDim.x * gridDim.y * gridDim.z;
    unsigned sum, cnt, mine, sp = 0u;
    for (;;) {
        sum = 0u; cnt = 0u; mine = 0u;
#pragma unroll
        for (unsigned j = 0; j < 16; ++j) { const unsigned c = xb_ld(&bar[XB_XCNT(j)]); sum += c; cnt += (c > 0u) ? 1u : 0u; mine = (j == x) ? c : mine; }
        if (sum == G) break;
        __builtin_amdgcn_s_sleep(1);
        if ((++sp & 255u) == 0u) { if (xb_ld(&bar[XB_TMO])) break; if (sp > XB_SPIN_CAP) { atomicAdd(&bar[XB_TMO], 1u); break; } }
    }
    nloc = mine > 0u ? mine : 1u; nx = cnt > 0u ? cnt : 1u;
}
__device__ __forceinline__ void xcd_barrier(const XcdBarrier& b) {
    asm volatile("s_waitcnt vmcnt(0)" ::: "memory");
    __syncthreads();
    if (threadIdx.x == 0) {
        unsigned* bar = b.bar;
        __builtin_amdgcn_s_waitcnt(0);
        unsigned nloc = b.st[0], nx = b.st[1];
        if (nloc == 0u) { xcd_barrier_complete(bar, b.x, nloc, nx); b.st[0] = nloc; b.st[1] = nx; }
        const unsigned old = xb_add(&bar[XB_XSUB(b.x)], 1u);
        const unsigned gen = old / nloc;
        if (old + 1u == (gen + 1u) * nloc) {
            __builtin_amdgcn_fence(__ATOMIC_RELEASE, "agent");
            asm volatile("s_waitcnt vmcnt(0)" ::: "memory");
            const unsigned og = xb_add(&bar[XB_TOP], 1u);
            const unsigned tg = og / nx;
            if (og + 1u == (tg + 1u) * nx) xb_add(&bar[XB_TOPGEN], 1u);
            else XB_SPIN(xb_ld(&bar[XB_TOPGEN]) == tg, bar);
            __builtin_amdgcn_fence(__ATOMIC_ACQUIRE, "agent");
            xb_add(&bar[XB_XGEN(b.x)], 1u);
            asm volatile("s_waitcnt vmcnt(0)" ::: "memory");
        } else {
            XB_SPIN(xb_ld(&bar[XB_XGEN(b.x)]) == gen, bar);
            __builtin_amdgcn_fence(__ATOMIC_ACQUIRE, "agent");
            asm volatile("s_waitcnt vmcnt(0)" ::: "memory");
        }
    }
    __syncthreads();
}
#define XB_ST ((volatile LAS unsigned*)(lds + 144384))

#define GRID_SYNC_CG() do { T_BEGIN(); asm volatile("s_waitcnt vmcnt(0) lgkmcnt(0)" ::: "memory"); grid.sync(); T_END(12); } while (0)
#ifdef DBG_TIME
#define TACC ((LAS unsigned long long*)(lds + 143360))
#define T_BEGIN() unsigned long long t0_ = __builtin_amdgcn_s_memrealtime()
#define T_END(k) do { if (blockIdx.x == 0 && threadIdx.x == 0) TACC[k] += __builtin_amdgcn_s_memrealtime() - t0_; } while (0)
#else
#define T_BEGIN() do {} while (0)
#define T_END(k) do {} while (0)
#endif
#define GRID_SYNC() do { T_BEGIN(); { const Params pb_ = LOADP(); XcdBarrier b_; b_.bar = (unsigned*)(pb_.ws + OFF_BAR); b_.x = xb_xcc_id(); b_.st = XB_ST; xcd_barrier(b_); } T_END(12); } while (0)
typedef const __attribute__((address_space(4))) Params* KP;
typedef const __attribute__((address_space(4))) unsigned long long* KP64;
#define GPTR(T, v) ((T*)(__attribute__((address_space(1))) T*)(v))
__device__ __forceinline__ Params load_params(KP q) {
    KP64 s = (KP64)q; Params p;
    p.x = GPTR(const float, s[0]); p.c = GPTR(const float, s[1]); p.ctx = GPTR(const float, s[2]); p.c_ctx = GPTR(const float, s[3]); p.w_ada = GPTR(const float, s[4]); p.b_ada = GPTR(const float, s[5]);
    p.norm1_g = GPTR(const float, s[6]); p.norm2_g = GPTR(const float, s[7]); p.w_in = GPTR(const float, s[8]); p.conv_w = GPTR(const float, s[9]); p.conv_b = GPTR(const float, s[10]); p.gate_b = GPTR(const float, s[11]);
    p.head_g = GPTR(const float, s[12]); p.vnorm_g = GPTR(const float, s[13]); p.w_sp = GPTR(const float, s[14]); p.b_sp = GPTR(const float, s[15]); p.w_pa = GPTR(const float, s[16]); p.w_pb = GPTR(const float, s[17]);
    p.w_out = GPTR(const float, s[18]); p.w_ff1 = GPTR(const float, s[19]); p.w_ff3 = GPTR(const float, s[20]); p.w_ff2 = GPTR(const float, s[21]); p.final_g = GPTR(const float, s[22]);
    p.out = GPTR(float, s[23]); p.ws = GPTR(unsigned char, s[24]);
    return p;
}
#define LOADP() ({ KP q_ = kp; asm volatile("" : "+s"(q_)); load_params(q_); })
#define TIDS() int t_ = threadIdx.x; asm volatile("" : "+v"(t_)); const int tid = t_, lane = tid & 63, wave = __builtin_amdgcn_readfirstlane(tid >> 6); const int gw = bx * NWAVES + wave; (void)lane; (void)gw;

#ifdef DBG_CHECK
__device__ __forceinline__ void chk_bf16(const Params& p, const bf16_t* b, size_t n, unsigned code, bool on, int tid) {
    if (!on) return; unsigned* flag = (unsigned*)(p.ws + OFF_FLAG); bool bad = false;
    for (size_t i = (size_t)blockIdx.x * NTHREADS + tid; i < n; i += (size_t)gridDim.x * NTHREADS) { const float v = __uint_as_float(((unsigned)b[i]) << 16); if (!(fabsf(v) < 1e6f)) bad = true; }
    if (bad) atomicMin(flag, code);
}
__device__ __forceinline__ void chk_f32(const Params& p, const float* b, size_t n, unsigned code, bool on, int tid) {
    if (!on) return; unsigned* flag = (unsigned*)(p.ws + OFF_FLAG); bool bad = false;
    for (size_t i = (size_t)blockIdx.x * NTHREADS + tid; i < n; i += (size_t)gridDim.x * NTHREADS) { const float v = b[i]; if (!(fabsf(v) < 1e6f)) bad = true; }
    if (bad) atomicMin(flag, code);
}
#define CHK(stmt) do { TIDS(); const Params p = LOADP(); stmt; } while (0)
#else
#define CHK(stmt) do {} while (0)
#endif
__global__ void __launch_bounds__(NTHREADS, 2) fwd_megakernel(Params pk) {
    extern __shared__ __attribute__((aligned(16))) unsigned char lds_raw[];
    LAS unsigned char* lds = (LAS unsigned char*)lds_raw;
    cg::grid_group grid = cg::this_grid();
    KP kp = (KP)__builtin_amdgcn_kernarg_segment_ptr();
    const int G = gridDim.x, bx = blockIdx.x;
    const int NGW = G * NWAVES;

    { const Params p = LOADP(); if (blockIdx.x == 0) for (int i = threadIdx.x; i < XCD_BAR_WORDS; i += NTHREADS) ((unsigned*)(p.ws + OFF_BAR))[i] = 0u;
      if (threadIdx.x == 0) { XB_ST[0] = 0u; XB_ST[1] = 0u; } }
#ifdef DBG_TIME
    if (threadIdx.x < 16) TACC[threadIdx.x] = 0ull;
    __syncthreads();
#endif
#ifdef DBG_CHECK
    { const Params p = LOADP(); if (blockIdx.x == 0 && threadIdx.x == 0) *(unsigned*)(p.ws + OFF_FLAG) = 9999u; }
#endif
    if (PH(0)) { T_BEGIN(); TIDS(); const Params p = LOADP(); mods_phase(p, lds, tid, wave, lane); T_END(0); }
    __syncthreads();
    if (PH(1)) { T_BEGIN(); TIDS(); const Params p = LOADP(); convert_weights(p, 0, lds, gw, NGW, wave, lane); T_END(0); }
    GRID_SYNC_CG();
    { const Params p = LOADP(); if (threadIdx.x == 0) (void)xb_add(&((unsigned*)(p.ws + OFF_BAR))[XB_XCNT(xb_xcc_id())], 1u); }
        CHK(chk_f32(p, (const float*)(p.ws + OFF_MOD), 4 * 2 * 6144, 1, true, tid); chk_bf16(p, (const bf16_t*)(p.ws + OFF_WB), WB_END / 2, 2, true, tid));

#pragma unroll 1
    for (int l = 0; l < DEPTH; ++l) {
        if (PH(1)) if (l > 0) { T_BEGIN(); TIDS(); const Params p = LOADP(); convert_weights(p, l, lds + 65536, gw, NGW, wave, lane); T_END(1); }
        if (PH(2)) { T_BEGIN(); TIDS(); const Params p = LOADP(); norm_phase<true>(p, l, lds, gw, NGW, tid, lane); T_END(1); }
        GRID_SYNC();
        CHK(chk_bf16(p, (const bf16_t*)(p.ws + OFF_H), PLANE, 3, l == 0, tid); chk_f32(p, (const float*)(p.ws + OFF_G), (size_t)T * 16, 4, l == 0, tid));
        if (PH(3)) { T_BEGIN(); TIDS(); const Params p = LOADP(); bf16_t* WB = (bf16_t*)(p.ws + OFF_WB); bf16_t* H = (bf16_t*)(p.ws + OFF_H); bf16_t* Z = (bf16_t*)(p.ws + OFF_Z);
          pg8::Gemm g{H, H, WB + WB_WIN / 2, 1024, 0}; pg8::Sched S; S.init(65, 28, G, bx, 1, 0); EpiZ E{Z, (float*)(p.ws + OFF_SSQ)};
          pg8::gemm_phase<EpiZ>(lds, g, S, E, tid); T_END(2); }
        GRID_SYNC();
        CHK(chk_bf16(p, (const bf16_t*)(p.ws + OFF_Z), 7 * PLANE, 5, l == 0, tid));
        for (int it = bx; it < NCH * 4; it += G) { if (PH(4)) { T_BEGIN(); TIDS(); const Params p = LOADP(); mixA_mlstm(p, l, it >> 2, it & 3, lds, tid, wave, lane); T_END(3); } }
        { const int nA = (G > 8) ? ((G - 8 < NCH * 4) ? G - 8 : NCH * 4) : 0;
          if (bx >= 8 && bx - 8 < nA) { if (PH(5)) { T_BEGIN(); TIDS(); const Params p = LOADP(); const int j = bx - 8; mixA_spatial(p, l, j >> 2, j & 3, lds, tid, wave, lane); T_END(3); } } }
        GRID_SYNC();
        if (PH(6)) { T_BEGIN(); TIDS(); const Params p = LOADP(); scan_phase(p, tid); T_END(4); }
        GRID_SYNC();
        CHK(chk_bf16(p, (const bf16_t*)(p.ws + OFF_ST), (size_t)NCH * 8 * 32768, 11, l == 0, tid); chk_f32(p, (const float*)(p.ws + OFF_NS), (size_t)NCH * 8 * 128, 12, l == 0, tid); chk_f32(p, (const float*)(p.ws + OFF_MP), (size_t)NCH * 8, 13, l == 0, tid));
        if (PH(7)) for (int it = bx + ((l == DEPTH - 1) ? 8 : 0); it < NCH * 4; it += G) { T_BEGIN(); TIDS(); const Params p = LOADP(); mixC_item(p, l, it >> 2, it & 3, lds, tid, wave, lane); T_END(5); }
        { const int nA = (G > 8) ? ((G - 8 < NCH * 4) ? G - 8 : NCH * 4) : 0;
          for (int j = nA + ((bx + G - 32) % G); j < NCH * 4; j += G) { if (PH(5)) { T_BEGIN(); TIDS(); const Params p = LOADP(); mixA_spatial(p, l, j >> 2, j & 3, lds, tid, wave, lane); T_END(5); } } }
        GRID_SYNC();
        CHK(chk_bf16(p, (const bf16_t*)(p.ws + OFF_Z), PLANE, 14, l == 0, tid));
        if (PH(8)) { T_BEGIN(); TIDS(); const Params p = LOADP(); bf16_t* WB = (bf16_t*)(p.ws + OFF_WB); bf16_t* H = (bf16_t*)(p.ws + OFF_H); bf16_t* Z = (bf16_t*)(p.ws + OFF_Z);
          if (l < DEPTH - 1) for (int tile = bx; tile < 256; tile += G) ctx_gemm_tile<0>(Z, H, WB + WB_WPAB / 2, 1024, Z + 5 * PLANE, Z + 6 * PLANE, Z + 3 * PLANE, nullptr, nullptr, lds, tile, tid, wave, lane);
          pg8::Gemm g{Z, H, WB + WB_WPAB / 2, 1024, 4}; pg8::Sched S; S.init(64, 4, G, bx, 2, 1); EpiMerge E{Z + 5 * PLANE, Z + 6 * PLANE, Z + 3 * PLANE};
          pg8::gemm_phase<EpiMerge>(lds, g, S, E, tid); T_END(6); }
        GRID_SYNC();
        CHK(chk_bf16(p, (const bf16_t*)(p.ws + OFF_Z) + 3 * PLANE, PLANE, 15, l == 0, tid));
        if (PH(9)) { T_BEGIN(); TIDS(); const Params p = LOADP(); bf16_t* WB = (bf16_t*)(p.ws + OFF_WB); bf16_t* Z = (bf16_t*)(p.ws + OFF_Z); const float* MOD = (const float*)(p.ws + OFF_MOD); float* CS = (float*)(p.ws + OFF_CS);
          if (l < DEPTH - 1) for (int tile = bx; tile < 256; tile += G) ctx_gemm_tile<1>(Z + 3 * PLANE, Z + 3 * PLANE, WB + WB_WOUT / 2, 1024, nullptr, nullptr, nullptr, CS, MOD + (size_t)(l * 2 + 1) * 6144 + 2048, lds, tile, tid, wave, lane);
          pg8::Gemm g{Z + 3 * PLANE, Z + 3 * PLANE, WB + WB_WOUT / 2, 1024, 0}; pg8::Sched S; S.init(64, 4, G, bx, 1, 1);
          EpiRes E{p.out, CS, MOD + (size_t)(l * 2 + 0) * 6144 + 2048, MOD + (size_t)(l * 2 + 1) * 6144 + 2048};
          pg8::gemm_phase<EpiRes>(lds, g, S, E, tid); T_END(7); }
        GRID_SYNC();
        CHK(chk_f32(p, p.out, (size_t)(T - NCTX) * 1024, 16, l == 0, tid); chk_f32(p, (const float*)(p.ws + OFF_CS), (size_t)NCTX * 1024, 16, l == 0, tid));
        if (PH(10)) { T_BEGIN(); TIDS(); const Params p = LOADP(); norm_phase<false>(p, l, lds, gw, NGW, tid, lane); T_END(8); }
        GRID_SYNC();
        CHK(chk_bf16(p, (const bf16_t*)(p.ws + OFF_H), PLANE, 17, l == 0, tid));
        if (PH(11)) { T_BEGIN(); TIDS(); const Params p = LOADP(); bf16_t* WB = (bf16_t*)(p.ws + OFF_WB); bf16_t* H = (bf16_t*)(p.ws + OFF_H); bf16_t* Z = (bf16_t*)(p.ws + OFF_Z);
          pg8::Gemm g{H, H, WB + WB_W13 / 2, 1024, 0}; pg8::Sched S; S.init(65, 22, G, bx, 1, 0); EpiSwiglu E{Z + PLANE};
          pg8::gemm_phase<EpiSwiglu>(lds, g, S, E, tid); T_END(9); }
        GRID_SYNC();
        CHK(chk_bf16(p, (const bf16_t*)(p.ws + OFF_Z) + PLANE, (size_t)T * DFF, 18, l == 0, tid));
        if (PH(12)) { T_BEGIN(); TIDS(); const Params p = LOADP(); bf16_t* WB = (bf16_t*)(p.ws + OFF_WB); bf16_t* Z = (bf16_t*)(p.ws + OFF_Z); const float* MOD = (const float*)(p.ws + OFF_MOD); float* CS = (float*)(p.ws + OFF_CS);
          if (l < DEPTH - 1) for (int tile = bx; tile < 256; tile += G) ctx_gemm_tile<1>(Z + PLANE, Z + PLANE, WB + WB_W2 / 2, DFF, nullptr, nullptr, nullptr, CS, MOD + (size_t)(l * 2 + 1) * 6144 + 5120, lds, tile, tid, wave, lane);
          pg8::Gemm g{Z + PLANE, Z + PLANE, WB + WB_W2 / 2, DFF, 0}; pg8::Sched S; S.init(64, 4, G, bx, 1, 1);
          EpiRes E{p.out, CS, MOD + (size_t)(l * 2 + 0) * 6144 + 5120, MOD + (size_t)(l * 2 + 1) * 6144 + 5120};
          pg8::gemm_phase<EpiRes>(lds, g, S, E, tid); T_END(10); }
        GRID_SYNC();
        CHK(chk_f32(p, p.out, (size_t)(T - NCTX) * 1024, 19 + l, true, tid));
    }
#ifdef DBG_CHECK
    GRID_SYNC();
    { const Params p = LOADP(); const unsigned f = *(volatile unsigned*)(p.ws + OFF_FLAG);
      if (f != 9999u) { for (size_t i = (size_t)blockIdx.x * NTHREADS + threadIdx.x; i < (size_t)(T - NCTX) * 1024; i += (size_t)gridDim.x * NTHREADS) p.out[i] = 100.0f * (float)f; return; } }
#endif
    if (PH(13)) { T_BEGIN(); TIDS(); const Params p = LOADP(); final_norm(p, gw, NGW, lane); T_END(11); }
#ifdef DBG_TIME
    { const Params p = LOADP(); float* tf = (float*)(p.ws + 300 * 1024);
      if (blockIdx.x == 0 && threadIdx.x == 0) { float x = 0.f, y = 0.f;
          for (int k = 0; k < 13; ++k) { const float us = (float)TACC[k] * 0.01f; if ((DBG_TX >> k) & 1) x += us; if ((DBG_TY >> k) & 1) y += us; }
          tf[0] = x; tf[1] = y; }
      GRID_SYNC();
      const float x = ((volatile float*)tf)[0], y = ((volatile float*)tf)[1];
      for (size_t i = (size_t)blockIdx.x * NTHREADS + threadIdx.x; i < (1u << 20) + 1; i += (size_t)gridDim.x * NTHREADS) p.out[i] += (i == 0) ? x : y; }
#endif
}

extern "C" void kernel_launch(void* const* d_in, const int* in_sizes, int n_in, void* d_out, int out_size, void* d_ws, size_t ws_size, hipStream_t stream) {
    static int grid = 0;
    if (grid == 0) {
        if (n_in != 23 || out_size != (T - NCTX) * D || ws_size < WS_END) { fprintf(stderr, "kernel_launch: unexpected shapes (n_in %d, out %d, ws %zu, need %zu)\n", n_in, out_size, ws_size, (size_t)WS_END); grid = -1; return; }
        int dev = 0, cus = 0, per_cu = 0;
        (void)hipGetDevice(&dev); (void)hipDeviceGetAttribute(&cus, hipDeviceAttributeMultiprocessorCount, dev);
        if (hipFuncSetAttribute((const void*)fwd_megakernel, hipFuncAttributeMaxDynamicSharedMemorySize, LDS_BYTES) != hipSuccess) { fprintf(stderr, "kernel_launch: hipFuncSetAttribute failed\n"); grid = -1; return; }
        if (hipOccupancyMaxActiveBlocksPerMultiprocessor(&per_cu, (const void*)fwd_megakernel, NTHREADS, LDS_BYTES) != hipSuccess || per_cu < 1) { fprintf(stderr, "kernel_launch: occupancy query says %d\n", per_cu); per_cu = 1; }
        (void)hipGetLastError();
        grid = cus;
    }
    if (grid < 0) return;
    Params p{};
    p.x = (const float*)d_in[0]; p.c = (const float*)d_in[1]; p.ctx = (const float*)d_in[2]; p.c_ctx = (const float*)d_in[3]; p.w_ada = (const float*)d_in[4]; p.b_ada = (const float*)d_in[5];
    p.norm1_g = (const float*)d_in[6]; p.norm2_g = (const float*)d_in[7]; p.w_in = (const float*)d_in[8]; p.conv_w = (const float*)d_in[9]; p.conv_b = (const float*)d_in[10]; p.gate_b = (const float*)d_in[11];
    p.head_g = (const float*)d_in[12]; p.vnorm_g = (const float*)d_in[13]; p.w_sp = (const float*)d_in[14]; p.b_sp = (const float*)d_in[15]; p.w_pa = (const float*)d_in[16]; p.w_pb = (const float*)d_in[17];
    p.w_out = (const float*)d_in[18]; p.w_ff1 = (const float*)d_in[19]; p.w_ff3 = (const float*)d_in[20]; p.w_ff2 = (const float*)d_in[21]; p.final_g = (const float*)d_in[22];
    p.out = (float*)d_out; p.ws = (unsigned char*)d_ws;
    void* args[] = {&p};
    hipError_t e = hipLaunchCooperativeKernel((const void*)fwd_megakernel, dim3(grid), dim3(NTHREADS), args, LDS_BYTES, stream);
    if (e != hipSuccess) fprintf(stderr, "kernel_launch: cooperative launch failed: %s (grid %d)\n", hipGetErrorString(e), grid);
}
```

```cpp
#include <hip/hip_runtime.h>
#include <hip/hip_cooperative_groups.h>
#include <cstdio>
namespace cg = cooperative_groups;

#define LAS __attribute__((address_space(3)))
typedef unsigned short bf16_t;
typedef short bf16x8 __attribute__((ext_vector_type(8)));
typedef float f32x4 __attribute__((ext_vector_type(4)));
typedef float f32x2 __attribute__((ext_vector_type(2)));
typedef unsigned u32x4 __attribute__((ext_vector_type(4)));
typedef unsigned u32x2 __attribute__((ext_vector_type(2)));

constexpr int T = 16640, NCTX = 256, D = 1024, NCH = 130, DFF = 2816, INW = 7184, ZW = 7168, DEPTH = 4;
constexpr size_t PLANE = (size_t)T * 1024;
constexpr float EPS = 1e-6f;
constexpr int NTHREADS = 512, NWAVES = 8;
constexpr int LDS_BYTES = 147456;
#ifndef PH_MASK
#define PH_MASK 0xFFFFF
#endif
#define PH(k) ((PH_MASK >> (k)) & 1)

constexpr size_t MiB = 1u << 20;
constexpr size_t OFF_MOD = 0;
constexpr size_t OFF_SC = 256 * 1024;
constexpr size_t OFF_MP = 256 * 1024 + 16 * 1024;
constexpr size_t OFF_NS = 320 * 1024;
constexpr size_t OFF_G = 1 * MiB;
constexpr size_t OFF_CS = 3 * MiB;
constexpr size_t OFF_WB = 4 * MiB;
constexpr size_t WB_WIN = 0, WB_WPAB = (size_t)ZW * 1024 * 2, WB_WOUT = WB_WPAB + (size_t)2048 * 1024 * 2, WB_W13 = WB_WOUT + (size_t)1024 * 1024 * 2,
                 WB_W2 = WB_W13 + (size_t)5632 * 1024 * 2, WB_END = WB_W2 + (size_t)1024 * 2816 * 2;
static_assert(WB_END <= 37 * MiB, "wb");
constexpr size_t OFF_H = 41 * MiB;
constexpr size_t OFF_QK = 74 * MiB;
constexpr size_t OFF_ST = 107 * MiB;
constexpr size_t OFF_Z = 172 * MiB;
constexpr size_t OFF_SSQ = 400 * MiB;
constexpr size_t WS_END = OFF_SSQ + 2 * MiB;
static_assert(OFF_Z + 7 * PLANE * 2 <= OFF_SSQ, "ws map 2");
static_assert(OFF_H + PLANE * 2 <= OFF_QK && OFF_QK + PLANE * 2 <= OFF_ST && OFF_ST + (size_t)NCH * 8 * 32768 * 2 <= OFF_Z, "ws map");

struct Params {
    const float *x, *c, *ctx, *c_ctx, *w_ada, *b_ada, *norm1_g, *norm2_g, *w_in, *conv_w, *conv_b, *gate_b, *head_g, *vnorm_g, *w_sp, *b_sp, *w_pa, *w_pb, *w_out, *w_ff1, *w_ff3, *w_ff2, *final_g;
    float* out; unsigned char* ws;
};

__device__ __forceinline__ float bf_lo(unsigned w) { return __uint_as_float(w << 16); }
__device__ __forceinline__ float bf_hi(unsigned w) { return __uint_as_float(w & 0xffff0000u); }
typedef __bf16 bf16v2_t __attribute__((ext_vector_type(2)));
__device__ __forceinline__ unsigned cvt_pk_bf16(float lo, float hi) { const f32x2 v = {lo, hi}; const bf16v2_t b = __builtin_convertvector(v, bf16v2_t); return __builtin_bit_cast(unsigned, b); }
__device__ __forceinline__ float wave_sum(float v) {
#pragma unroll
    for (int o = 1; o < 64; o <<= 1) v += __shfl_xor(v, o);
    return v;
}
__device__ __forceinline__ float wave_max(float v) {
#pragma unroll
    for (int o = 1; o < 64; o <<= 1) v = fmaxf(v, __shfl_xor(v, o));
    return v;
}
__device__ __forceinline__ float sigmoidf_(float x) { return __builtin_amdgcn_rcpf(1.0f + __expf(-x)); }
__device__ __forceinline__ float siluf_(float x) { return x * __builtin_amdgcn_rcpf(1.0f + __expf(-x)); }
__device__ __forceinline__ float geluf_(float x) {
    const float y2 = 1.5957691216057308f * (x + 0.044715f * x * x * x);
    return x * __builtin_amdgcn_rcpf(1.0f + __expf(-y2));
}
__device__ __forceinline__ float logsigf_(float x) { return fminf(x, 0.0f) - log1pf(__expf(-fabsf(x))); }
#define LDS_WAIT() asm volatile("s_waitcnt lgkmcnt(0)" ::: "memory")

namespace pg8 {
constexpr int BM = 256, BK = 64, HALF = 128, HTB = HALF * BK * 2, STAGE_BYTES = 8 * HTB, NXCD = 8, WGM = 8;
__host__ __device__ __forceinline__ int lds_byte(int r, int c) { const int st = (r >> 4) * 2 + (c >> 5), rr = r & 15, cc = c & 31, ob = rr * 64 + cc * 2; return st * 1024 + (ob ^ (((ob >> 9) & 1) << 5)); }
__host__ __device__ __forceinline__ void stage_rc(int b, int& R, int& C) { const int st = b / 1024, sb = b % 1024, swz = sb ^ (((sb >> 9) & 1) << 5); R = (st >> 1) * 16 + swz / 64; C = (st & 1) * 32 + (swz % 64) / 2; }
__host__ __device__ __forceinline__ int perm32(int rho) { const int n = rho >> 4, i = rho & 15; return 8 * (i >> 2) + 4 * n + (i & 3); }

struct Unit { int pm, pn, seg; };
struct Gemm { const bf16_t* A0; const bf16_t* A1; const bf16_t* Bt; int K; int seg_pn_off; };
struct Sched {
    int nM, nN, nwg, G, c, nseg, pm0;
    __device__ void init(int nM_, int nN_, int G_, int c_, int nseg_, int pm0_) { nM = nM_; nN = nN_; nwg = nM * nN; G = G_; c = c_; nseg = nseg_; pm0 = pm0_; }
    __device__ bool next(int i, Unit& u) const {
        const int ii = i / nseg; u.seg = i - ii * nseg;
        const long L = (long)ii * G + c; if (L >= nwg) return false;
        int wgid = (int)L; { const int q = nwg / NXCD, r = nwg % NXCD, xcd = wgid % NXCD, off = wgid / NXCD; wgid = (xcd < r ? xcd * (q + 1) : r * (q + 1) + (xcd - r) * q) + off; }
        const int nig = WGM * nN, gid = wgid / nig, fm = gid * WGM, gsz = (nM - fm) < WGM ? (nM - fm) : WGM;
        u.pm = pm0 + fm + ((wgid % nig) % gsz); u.pn = (wgid % nig) / gsz; return true;
    }
};

template <class Epi>
__device__ __forceinline__ void gemm_phase(LAS unsigned char* lds, const Gemm g, const Sched& S, const Epi& E, const int tid) {
    const int wid = __builtin_amdgcn_readfirstlane(tid >> 6), lane = tid & 63, wr = wid >> 2, wc = wid & 3, fr = lane & 15, fq = lane >> 4;
    const int K = g.K, nt = K / BK;
    unsigned voffA[2], voffB[2];
#pragma unroll
    for (int i = 0; i < 2; ++i) { int R, C; stage_rc(tid * 16 + i * 8192, R, C); const int Rb = Epi::PERM ? ((R & ~31) + perm32(R & 31)) : R;
        voffA[i] = (unsigned)(R * K + C) * 2u; voffB[i] = (unsigned)(Rb * K + C) * 2u; }
    const size_t kstep = (size_t)(BK * 2);
    const size_t hstep = (size_t)HALF * K * 2;
    const size_t tstep = 2 * hstep;
    const unsigned ldsw = (unsigned)wid * 1024u;
    const int aoff = lds_byte(wr * 64 + fr, fq * 8), boff = lds_byte(wc * 32 + fr, fq * 8);
#define PG8_SA(b, h) (((b) * 2 + (h)) * HTB)
#define PG8_SB(b, h) ((4 + (b) * 2 + (h)) * HTB)
#define PG8_STAGE(bufoff, gbase, voff) do { _Pragma("unroll") for (int _i = 0; _i < 2; ++_i) \
        __builtin_amdgcn_global_load_lds((const unsigned*)((const char*)(gbase) + (voff)[_i]), (LAS unsigned*)(lds + (bufoff) + ldsw + _i * 8192), 16, 0, 0); } while (0)
#define PG8_LDA(dst, b, h) do { _Pragma("unroll") for (int m = 0; m < 4; ++m) _Pragma("unroll") for (int k = 0; k < 2; ++k) dst[m][k] = *(const LAS bf16x8*)(lds + PG8_SA(b, h) + aoff + m * 2048 + k * 1024); } while (0)
#define PG8_LDB(dst, b, h) do { _Pragma("unroll") for (int n = 0; n < 2; ++n) _Pragma("unroll") for (int k = 0; k < 2; ++k) dst[n][k] = *(const LAS bf16x8*)(lds + PG8_SB(b, h) + boff + n * 2048 + k * 1024); } while (0)
#define PG8_MMA(ai, bj, At, Bt) do { __builtin_amdgcn_s_setprio(1); _Pragma("unroll") for (int m = 0; m < 4; ++m) _Pragma("unroll") for (int n = 0; n < 2; ++n) _Pragma("unroll") for (int k = 0; k < 2; ++k) \
        acc[ai][bj][m][n] = __builtin_amdgcn_mfma_f32_16x16x32_bf16(Bt[n][k], At[m][k], acc[ai][bj][m][n], 0, 0, 0); __builtin_amdgcn_s_setprio(0); } while (0)
#define PG8_WAIT_V(n) asm volatile("s_waitcnt vmcnt(" #n ")" ::: "memory")
#define PG8_WAIT_L(n) asm volatile("s_waitcnt lgkmcnt(" #n ")" ::: "memory")
#define PG8_BAR __builtin_amdgcn_s_barrier()
#define PG8_SCHED __builtin_amdgcn_sched_barrier(0)
    Unit cur, nxt; int ui = 0;
    if (!S.next(0, cur)) return;
    f32x4 acc[2][2][4][2];
#pragma unroll
    for (int a = 0; a < 2; ++a)
#pragma unroll
        for (int b = 0; b < 2; ++b)
#pragma unroll
            for (int m = 0; m < 4; ++m)
#pragma unroll
                for (int n = 0; n < 2; ++n) acc[a][b][m][n] = (f32x4){0.f, 0.f, 0.f, 0.f};
    bf16x8 At[4][2], B0[2][2], B1[2][2];
    const char* cA = (const char*)(cur.seg ? g.A1 : g.A0) + (size_t)cur.pm * tstep; const char* cB = (const char*)g.Bt + (size_t)(cur.pn + cur.seg * g.seg_pn_off) * tstep;
    PG8_STAGE(PG8_SB(0, 0), cB, voffB); PG8_STAGE(PG8_SA(0, 0), cA, voffA); PG8_STAGE(PG8_SB(0, 1), cB + hstep, voffB); PG8_STAGE(PG8_SA(0, 1), cA + hstep, voffA);
    if (wr == 1) PG8_BAR;
    PG8_WAIT_V(4); PG8_BAR;
    PG8_STAGE(PG8_SB(1, 0), cB + kstep, voffB); PG8_STAGE(PG8_SA(1, 0), cA + kstep, voffA); PG8_STAGE(PG8_SB(1, 1), cB + hstep + kstep, voffB);
    PG8_WAIT_V(6); PG8_BAR;
    for (;;) {
        const bool has_next = S.next(ui + 1, nxt);
        const char* nA = has_next ? (const char*)(nxt.seg ? g.A1 : g.A0) + (size_t)nxt.pm * tstep : cA;
        const char* nB = has_next ? (const char*)g.Bt + (size_t)(nxt.pn + nxt.seg * g.seg_pn_off) * tstep : cB;
        for (int t = 0; t < nt; t += 2) {
            const bool last = (t == nt - 2);
            const char* a1 = cA + (size_t)(t + 1) * kstep;
            const char* a2 = last ? nA : cA + (size_t)(t + 2) * kstep; const char* b2 = last ? nB : cB + (size_t)(t + 2) * kstep;
            const char* a3 = a2 + kstep; const char* b3 = b2 + kstep;
            PG8_LDB(B0, 0, 0); PG8_SCHED; PG8_LDA(At, 0, 0); PG8_STAGE(PG8_SA(1, 1), a1 + hstep, voffA);
            PG8_WAIT_L(8); PG8_BAR; PG8_WAIT_L(0); PG8_MMA(0, 0, At, B0); PG8_BAR; PG8_SCHED;
            PG8_LDB(B1, 0, 1); PG8_STAGE(PG8_SB(0, 0), b2, voffB);
            PG8_BAR; PG8_WAIT_L(0); PG8_MMA(0, 1, At, B1); PG8_BAR;
            PG8_LDA(At, 0, 1); PG8_STAGE(PG8_SA(0, 0), a2, voffA);
            PG8_BAR; PG8_WAIT_L(0); PG8_MMA(1, 0, At, B0); PG8_BAR; PG8_SCHED;
            PG8_STAGE(PG8_SB(0, 1), b2 + hstep, voffB);
            PG8_WAIT_V(6); PG8_BAR; PG8_MMA(1, 1, At, B1); PG8_BAR;
            PG8_LDB(B0, 1, 0); PG8_SCHED; PG8_LDA(At, 1, 0); PG8_STAGE(PG8_SA(0, 1), a2 + hstep, voffA);
            PG8_WAIT_L(8); PG8_BAR; PG8_WAIT_L(0); PG8_MMA(0, 0, At, B0); PG8_BAR; PG8_SCHED;
            PG8_LDB(B1, 1, 1); PG8_STAGE(PG8_SB(1, 0), b3, voffB);
            PG8_BAR; PG8_WAIT_L(0); PG8_MMA(0, 1, At, B1); PG8_BAR;
            PG8_LDA(At, 1, 1); PG8_STAGE(PG8_SA(1, 0), a3, voffA);
            PG8_BAR; PG8_WAIT_L(0); PG8_MMA(1, 0, At, B0); PG8_BAR; PG8_SCHED;
            PG8_STAGE(PG8_SB(1, 1), b3 + hstep, voffB);
            PG8_WAIT_V(6); PG8_BAR; PG8_MMA(1, 1, At, B1); PG8_BAR;
        }
        const bool zero = E(acc, cur, wr, wc, fr, fq);
        if (!has_next) break;
        if (zero) {
#pragma unroll
            for (int a = 0; a < 2; ++a)
#pragma unroll
                for (int b = 0; b < 2; ++b)
#pragma unroll
                    for (int m = 0; m < 4; ++m)
#pragma unroll
                        for (int n = 0; n < 2; ++n) acc[a][b][m][n] = (f32x4){0.f, 0.f, 0.f, 0.f};
        }
        cur = nxt; cA = nA; cB = nB; ++ui;
    }
    PG8_WAIT_V(0);
    if (wr == 0) PG8_BAR;
    PG8_BAR;
#undef PG8_SA
#undef PG8_SB
#undef PG8_STAGE
#undef PG8_LDA
#undef PG8_LDB
#undef PG8_MMA
#undef PG8_WAIT_V
#undef PG8_WAIT_L
#undef PG8_BAR
#undef PG8_SCHED
}
}

typedef f32x4 AccT[2][2][4][2];
struct EpiZ {
    static constexpr bool PERM = true;
    bf16_t* Z; float* SSQP;
    __device__ __forceinline__ bool operator()(AccT& acc, const pg8::Unit& u, int wr, int wc, int fr, int fq) const {
        const int row0 = u.pm * 256 + wr * 64 + fr; const int colt = u.pn * 256; const int plane = colt >> 10;
        bf16_t* base = Z + (size_t)plane * PLANE + (colt & 1023) + wc * 32 + 8 * fq;
        const bool act = (plane == 3) || (plane == 4);
#pragma unroll
        for (int ai = 0; ai < 2; ++ai)
#pragma unroll
            for (int m = 0; m < 4; ++m) { const int row = row0 + ai * 128 + m * 16; bf16_t* rowp = base + (size_t)row * 1024; float ss = 0.f;
#pragma unroll
                for (int bj = 0; bj < 2; ++bj) { f32x4 v0 = acc[ai][bj][m][0], v1 = acc[ai][bj][m][1];
                    if (act) {
#pragma unroll
                        for (int j = 0; j < 4; ++j) { v0[j] = geluf_(v0[j]); v1[j] = geluf_(v1[j]); ss += v0[j] * v0[j] + v1[j] * v1[j]; } }
                    u32x4 w; w.x = cvt_pk_bf16(v0[0], v0[1]); w.y = cvt_pk_bf16(v0[2], v0[3]); w.z = cvt_pk_bf16(v1[0], v1[1]); w.w = cvt_pk_bf16(v1[2], v1[3]);
                    *(u32x4*)(rowp + bj * 128) = w; }
                if (plane == 4) { ss += __shfl_xor(ss, 16); ss += __shfl_xor(ss, 32); if (fq == 0) SSQP[(size_t)row * 16 + (u.pn & 3) * 4 + wc] = ss; } }
        return true;
    }
};
struct EpiMerge {
    static constexpr bool PERM = true;
    const bf16_t* GA; const bf16_t* GB; bf16_t* O;
    __device__ __forceinline__ bool operator()(AccT& acc, const pg8::Unit& u, int wr, int wc, int fr, int fq) const {
        const int row0 = u.pm * 256 + wr * 64 + fr; const int col0 = u.pn * 256 + wc * 32 + 8 * fq;
#pragma unroll
        for (int ai = 0; ai < 2; ++ai)
#pragma unroll
            for (int m = 0; m < 4; ++m) { const size_t ro = (size_t)(row0 + ai * 128 + m * 16) * 1024 + col0;
#pragma unroll
                for (int bj = 0; bj < 2; ++bj) {
                    const u32x4 gb = *(const u32x4*)(GB + ro + bj * 128);
                    float b[8] = {bf_lo(gb.x), bf_hi(gb.x), bf_lo(gb.y), bf_hi(gb.y), bf_lo(gb.z), bf_hi(gb.z), bf_lo(gb.w), bf_hi(gb.w)};
                    if (u.seg == 0) {
                        const u32x4 ga = *(const u32x4*)(GA + ro + bj * 128);
                        float a[8] = {bf_lo(ga.x), bf_hi(ga.x), bf_lo(ga.y), bf_hi(ga.y), bf_lo(ga.z), bf_hi(ga.z), bf_lo(ga.w), bf_hi(ga.w)};
#pragma unroll
                        for (int j = 0; j < 8; ++j) { const float r = sigmoidf_(a[j]) * (1.0f + __expf(-b[j])); acc[ai][bj][m][j >> 2][j & 3] *= r; }
                    } else {
                        float v[8];
#pragma unroll
                        for (int j = 0; j < 8; ++j) v[j] = acc[ai][bj][m][j >> 2][j & 3] * sigmoidf_(b[j]);
                        u32x4 w; w.x = cvt_pk_bf16(v[0], v[1]); w.y = cvt_pk_bf16(v[2], v[3]); w.z = cvt_pk_bf16(v[4], v[5]); w.w = cvt_pk_bf16(v[6], v[7]);
                        *(u32x4*)(O + ro + bj * 128) = w;
                    }
                } }
        return u.seg != 0;
    }
};
struct EpiRes {
    static constexpr bool PERM = false;
    float* out; float* cs; const float* gx; const float* gc;
    __device__ __forceinline__ bool operator()(AccT& acc, const pg8::Unit& u, int wr, int wc, int fr, int fq) const {
        const bool isc = (u.pm == 0);
        float* base = isc ? cs : out - (size_t)NCTX * 1024; const float* gv = isc ? gc : gx;
        const int row0 = u.pm * 256 + wr * 64 + fr, col0 = u.pn * 256 + wc * 32 + 4 * fq;
        f32x4 g4[2][2];
#pragma unroll
        for (int bj = 0; bj < 2; ++bj)
#pragma unroll
            for (int n = 0; n < 2; ++n) g4[bj][n] = *(const f32x4*)(gv + col0 + bj * 128 + n * 16);
#pragma unroll
        for (int ai = 0; ai < 2; ++ai)
#pragma unroll
            for (int m = 0; m < 4; ++m) { float* rowp = base + (size_t)(row0 + ai * 128 + m * 16) * 1024 + col0;
#pragma unroll
                for (int bj = 0; bj < 2; ++bj)
#pragma unroll
                    for (int n = 0; n < 2; ++n) { f32x4* p = (f32x4*)(rowp + bj * 128 + n * 16); *p = *p + g4[bj][n] * acc[ai][bj][m][n]; } }
        return true;
    }
};
struct EpiSwiglu {
    static constexpr bool PERM = true;
    bf16_t* FM;
    __device__ __forceinline__ bool operator()(AccT& acc, const pg8::Unit& u, int wr, int wc, int fr, int fq) const {
        const int row0 = u.pm * 256 + wr * 64 + fr, col0 = u.pn * 128 + wc * 32 + 8 * fq;
#pragma unroll
        for (int ai = 0; ai < 2; ++ai)
#pragma unroll
            for (int m = 0; m < 4; ++m) {
                float v[8];
#pragma unroll
                for (int j = 0; j < 8; ++j) v[j] = siluf_(acc[ai][0][m][j >> 2][j & 3]) * acc[ai][1][m][j >> 2][j & 3];
                u32x4 w; w.x = cvt_pk_bf16(v[0], v[1]); w.y = cvt_pk_bf16(v[2], v[3]); w.z = cvt_pk_bf16(v[4], v[5]); w.w = cvt_pk_bf16(v[6], v[7]);
                *(u32x4*)(FM + (size_t)(row0 + ai * 128 + m * 16) * DFF + col0) = w; }
        return true;
    }
};

__device__ __forceinline__ void transpose_item(const float* W, int ldw, int src_col0, int k0, bf16_t* WT, int K, int dst_row0, LAS float* scr, int lane) {
    float tv[32];
#pragma unroll
    for (int i = 0; i < 32; ++i) { const int kk = 2 * i + (lane >> 5); tv[i] = W[(size_t)(k0 + kk) * ldw + src_col0 + (lane & 31)]; }
#pragma unroll
    for (int i = 0; i < 32; ++i) { const int kk = 2 * i + (lane >> 5); scr[kk * 33 + (lane & 31)] = tv[i]; }
    LDS_WAIT();
    const int c = lane & 7;
#pragma unroll
    for (int j = 0; j < 4; ++j) { const int n = (lane >> 3) + 8 * j; const LAS float* s = scr + (8 * c) * 33 + n;
        u32x4 o; o.x = cvt_pk_bf16(s[0 * 33], s[1 * 33]); o.y = cvt_pk_bf16(s[2 * 33], s[3 * 33]); o.z = cvt_pk_bf16(s[4 * 33], s[5 * 33]); o.w = cvt_pk_bf16(s[6 * 33], s[7 * 33]);
        *(u32x4*)(WT + (size_t)(dst_row0 + n) * K + k0 + 8 * c) = o; }
    LDS_WAIT();
}
__device__ __forceinline__ void convert_weights(const Params& p, int l, LAS unsigned char* lds_scr, int gw, int NGW, int wave, int lane) {
    LAS float* scr = (LAS float*)(lds_scr + wave * 8448);
    bf16_t* wb = (bf16_t*)(p.ws + OFF_WB);
    constexpr int I_IN = 16 * 224, I_SQ = 16 * 32, I_F = 16 * 88, I_2 = 44 * 32;
    constexpr int NIT = I_IN + 3 * I_SQ + 2 * I_F + I_2;
    for (int it = gw; it < NIT; it += NGW) {
        int r = it;
        if (r < I_IN) { const int kb = r / 224, nb = r % 224; const int dc = nb * 32; const int sc = dc + (dc >= 3072 ? 16 : 0);
            transpose_item(p.w_in + (size_t)l * 1024 * INW, INW, sc, kb * 64, wb + WB_WIN / 2, 1024, dc, scr, lane); continue; } r -= I_IN;
        if (r < I_SQ) { const int kb = r / 32, nb = r % 32; transpose_item(p.w_pa + (size_t)l * 1024 * 1024, 1024, nb * 32, kb * 64, wb + WB_WPAB / 2, 1024, nb * 32, scr, lane); continue; } r -= I_SQ;
        if (r < I_SQ) { const int kb = r / 32, nb = r % 32; transpose_item(p.w_pb + (size_t)l * 1024 * 1024, 1024, nb * 32, kb * 64, wb + WB_WPAB / 2, 1024, 1024 + nb * 32, scr, lane); continue; } r -= I_SQ;
        if (r < I_SQ) { const int kb = r / 32, nb = r % 32; transpose_item(p.w_out + (size_t)l * 1024 * 1024, 1024, nb * 32, kb * 64, wb + WB_WOUT / 2, 1024, nb * 32, scr, lane); continue; } r -= I_SQ;
        if (r < I_F) { const int kb = r / 88, nb = r % 88; const int j0 = nb * 32; transpose_item(p.w_ff1 + (size_t)l * 1024 * DFF, DFF, j0, kb * 64, wb + WB_W13 / 2, 1024, 256 * (j0 >> 7) + (j0 & 127), scr, lane); continue; } r -= I_F;
        if (r < I_F) { const int kb = r / 88, nb = r % 88; const int j0 = nb * 32; transpose_item(p.w_ff3 + (size_t)l * 1024 * DFF, DFF, j0, kb * 64, wb + WB_W13 / 2, 1024, 256 * (j0 >> 7) + 128 + (j0 & 127), scr, lane); continue; } r -= I_F;
        { const int kb = r / 32, nb = r % 32; transpose_item(p.w_ff2 + (size_t)l * DFF * 1024, 1024, nb * 32, kb * 64, wb + WB_W2 / 2, DFF, nb * 32, scr, lane); }
    }
}

__device__ __forceinline__ void mods_phase(const Params& p, LAS unsigned char* lds, int tid, int wave, int lane) {
    LAS float* sc = (LAS float*)lds; LAS float* scc = sc + 1024; LAS float* red = scc + 1024;
    float* MOD = (float*)(p.ws + OFF_MOD);
    for (int i = tid; i < 1024; i += NTHREADS) { sc[i] = siluf_(p.c[i]); scc[i] = siluf_(p.c_ctx[i]); }
    __syncthreads();
    for (int item = blockIdx.x; item < 4 * 96; item += gridDim.x) {
        const int l = item / 96, col = (item % 96) * 64 + lane;
        const float* w = p.w_ada + (size_t)l * 1024 * 6144 + col;
        float ax = 0.f, ac = 0.f;
#pragma unroll 8
        for (int d = wave * 128; d < wave * 128 + 128; ++d) { const float wv = w[(size_t)d * 6144]; ax += sc[d] * wv; ac += scc[d] * wv; }
        red[(wave * 64 + lane) * 2] = ax; red[(wave * 64 + lane) * 2 + 1] = ac;
        __syncthreads();
        if (wave == 0) { float sx = 0.f, s2 = 0.f;
#pragma unroll
            for (int w8 = 0; w8 < 8; ++w8) { sx += red[(w8 * 64 + lane) * 2]; s2 += red[(w8 * 64 + lane) * 2 + 1]; }
            const float b = p.b_ada[l * 6144 + col];
            MOD[(size_t)(l * 2 + 0) * 6144 + col] = sx + b; MOD[(size_t)(l * 2 + 1) * 6144 + col] = s2 + b; }
        __syncthreads();
    }
}

template <bool GATES>
__device__ __forceinline__ void norm_phase(const Params& p, int l, LAS unsigned char* lds, int gw, int NGW, int tid, int lane) {
    const float* MOD = (const float*)(p.ws + OFF_MOD);
    float* CS = (float*)(p.ws + OFF_CS); bf16_t* H = (bf16_t*)(p.ws + OFF_H); float* G = (float*)(p.ws + OFF_G);
    const float* ng = (GATES ? p.norm1_g : p.norm2_g) + l * 1024;
    LAS float* wg = (LAS float*)lds;
    if (GATES) {
        const float* wsrc = p.w_in + (size_t)l * 1024 * INW + 3072;
        for (int i = tid; i < 16384; i += NTHREADS) { const int k = i >> 4, j = i & 15; wg[j * 1024 + k] = wsrc[(size_t)k * INW + j]; }
        __syncthreads();
    }
    const bool first = GATES && (l == 0);
    const bool spread = (NGW >= 64 * 32);
    const int n_lat = (T / 4 - 64 - gw + NGW - 1) / NGW;
    const int has_ctx = spread ? (((gw & 31) == 0 && (gw >> 5) < 64) ? 1 : 0) : 0;
    const int n_it = spread ? n_lat + has_ctx : (T / 4 - gw + NGW - 1) / NGW;
    for (int it = 0; it < n_it; ++it) {
        const int grp = spread ? ((it < n_lat) ? 64 + gw + it * NGW : (gw >> 5)) : gw + it * NGW;
        const int row0 = grp * 4; const bool isc = row0 < NCTX;
        const float* modp = MOD + (size_t)(l * 2 + (isc ? 1 : 0)) * 6144 + (GATES ? 0 : 3072);
        f32x4 gm[4], sh[4];
#pragma unroll
        for (int j = 0; j < 4; ++j) { const int col = 4 * lane + 256 * j; const f32x4 g4 = *(const f32x4*)(ng + col); const f32x4 s4 = *(const f32x4*)(modp + 1024 + col);
            sh[j] = *(const f32x4*)(modp + col); gm[j] = g4 * (s4 + 1.0f); }
        f32x4 xv[4][4];
#pragma unroll
        for (int r = 0; r < 4; ++r) {
            const int row = row0 + r;
            const float* src = first ? (isc ? p.ctx + (size_t)row * 1024 : p.x + (size_t)(row - NCTX) * 1024) : (isc ? CS + (size_t)row * 1024 : p.out + (size_t)(row - NCTX) * 1024);
#pragma unroll
            for (int j = 0; j < 4; ++j) xv[r][j] = *(const f32x4*)(src + 4 * lane + 256 * j);
        }
        if (first) {
#pragma unroll
            for (int r = 0; r < 4; ++r) { const int row = row0 + r; float* dst = isc ? CS + (size_t)row * 1024 : p.out + (size_t)(row - NCTX) * 1024;
#pragma unroll
                for (int j = 0; j < 4; ++j) *(f32x4*)(dst + 4 * lane + 256 * j) = xv[r][j]; }
        }
#pragma unroll
        for (int r = 0; r < 4; ++r) {
            float s = 0.f;
#pragma unroll
            for (int j = 0; j < 4; ++j) s += (xv[r][j][0] * xv[r][j][0] + xv[r][j][1] * xv[r][j][1]) + (xv[r][j][2] * xv[r][j][2] + xv[r][j][3] * xv[r][j][3]);
            const float rstd = rsqrtf(wave_sum(s) * (1.0f / 1024.0f) + EPS);
            bf16_t* hrow = H + (size_t)(row0 + r) * 1024;
#pragma unroll
            for (int j = 0; j < 4; ++j) { xv[r][j] = xv[r][j] * rstd * gm[j] + sh[j];
                u32x2 w; w.x = cvt_pk_bf16(xv[r][j][0], xv[r][j][1]); w.y = cvt_pk_bf16(xv[r][j][2], xv[r][j][3]);
                *(u32x2*)(hrow + 4 * lane + 256 * j) = w; }
        }
        if (GATES) {
            float v[64];
#pragma unroll
            for (int i = 0; i < 64; ++i) v[i] = 0.f;
#pragma unroll
            for (int gi = 0; gi < 16; ++gi) {
                if ((gi & 1) == 0) asm volatile("" ::: "memory");
#pragma unroll
                for (int j = 0; j < 4; ++j) { const f32x4 w4 = *(const LAS f32x4*)(wg + gi * 1024 + 4 * lane + 256 * j);
#pragma unroll
                    for (int r = 0; r < 4; ++r) v[r * 16 + gi] += (xv[r][j][0] * w4[0] + xv[r][j][1] * w4[1]) + (xv[r][j][2] * w4[2] + xv[r][j][3] * w4[3]); } }
#pragma unroll
            for (int i = 0; i < 32; ++i) { const bool hi = (lane & 32) != 0; const float keep = hi ? v[i + 32] : v[i]; const float send = hi ? v[i] : v[i + 32]; v[i] = keep + __shfl_xor(send, 32); }
#pragma unroll
            for (int i = 0; i < 16; ++i) { const bool hi = (lane & 16) != 0; const float keep = hi ? v[i + 16] : v[i]; const float send = hi ? v[i] : v[i + 16]; v[i] = keep + __shfl_xor(send, 16); }
#pragma unroll
            for (int i = 0; i < 8; ++i) { const bool hi = (lane & 8) != 0; const float keep = hi ? v[i + 8] : v[i]; const float send = hi ? v[i] : v[i + 8]; v[i] = keep + __shfl_xor(send, 8); }
#pragma unroll
            for (int i = 0; i < 4; ++i) { const bool hi = (lane & 4) != 0; const float keep = hi ? v[i + 4] : v[i]; const float send = hi ? v[i] : v[i + 4]; v[i] = keep + __shfl_xor(send, 4); }
#pragma unroll
            for (int i = 0; i < 2; ++i) { const bool hi = (lane & 2) != 0; const float keep = hi ? v[i + 2] : v[i]; const float send = hi ? v[i] : v[i + 2]; v[i] = keep + __shfl_xor(send, 2); }
            { const bool hi = (lane & 1) != 0; const float keep = hi ? v[1] : v[0]; const float send = hi ? v[0] : v[1]; v[0] = keep + __shfl_xor(send, 1); }
            const int gate = lane & 15;
            float val = v[0] + p.gate_b[l * 16 + gate];
            if (gate & 4) val = logsigf_(val);
            G[(size_t)row0 * 16 + lane] = val;
        }
    }
}

__device__ __forceinline__ void final_norm(const Params& p, int gw, int NGW, int lane) {
    f32x4 g4[4];
#pragma unroll
    for (int j = 0; j < 4; ++j) g4[j] = *(const f32x4*)(p.final_g + 4 * lane + 256 * j);
    for (int row = gw; row < T - NCTX; row += NGW) {
        float* rp = p.out + (size_t)row * 1024; f32x4 xv[4]; float s = 0.f;
#pragma unroll
        for (int j = 0; j < 4; ++j) { xv[j] = *(const f32x4*)(rp + 4 * lane + 256 * j); s += (xv[j][0] * xv[j][0] + xv[j][1] * xv[j][1]) + (xv[j][2] * xv[j][2] + xv[j][3] * xv[j][3]); }
        const float rstd = rsqrtf(wave_sum(s) * (1.0f / 1024.0f) + EPS);
#pragma unroll
        for (int j = 0; j < 4; ++j) { f32x4 o = xv[j] * rstd * g4[j];
#ifdef DBG_SANITIZE
#pragma unroll
            for (int e = 0; e < 4; ++e) if (!(fabsf(o[e]) < 1e30f)) o[e] = 10000.0f;
#endif
            *(f32x4*)(rp + 4 * lane + 256 * j) = o; }
    }
}

constexpr size_t OFF_FLAG = 300 * 1024;
#define FLAGBAD(cond, code) do { if (cond) atomicMin((unsigned*)(p.ws + OFF_FLAG), (unsigned)(code)); } while (0)
constexpr int LROW = 272;
__device__ __forceinline__ float wave_incl_sum(float v, int lane) {
#pragma unroll
    for (int o = 1; o < 64; o <<= 1) { const float t = __shfl_up(v, o); if (lane >= o) v += t; }
    return v;
}
__device__ __forceinline__ float wave_incl_max(float v, int lane) {
#pragma unroll
    for (int o = 1; o < 64; o <<= 1) { const float t = __shfl_up(v, o); if (lane >= o) v = fmaxf(v, t); }
    return v;
}

__device__ __forceinline__ void mixA_mlstm(const Params& p, int l, int c, int h, LAS unsigned char* lds, int tid, int wave, int lane) {
    const int fr = lane & 15, fq = lane >> 4;
    bf16_t* Z = (bf16_t*)(p.ws + OFF_Z); bf16_t* QK = (bf16_t*)(p.ws + OFF_QK); bf16_t* ST = (bf16_t*)(p.ws + OFF_ST);
    const float* G = (const float*)(p.ws + OFF_G); float* SC = (float*)(p.ws + OFF_SC); float* NS = (float*)(p.ws + OFF_NS);
    LAS unsigned char* KT = lds; LAS unsigned char* VT = lds + 128 * LROW;
    LAS float* wsrc = (LAS float*)(lds + 384 * LROW); LAS float* red = wsrc + 256;
    const int t0 = c * 128; const int seq_lo = (c < 2) ? 0 : NCTX, seq_hi = (c < 2) ? NCTX : T;
    const int gdir = wave & 1;
    const int gr0 = gdir ? 127 - 2 * lane : 2 * lane, gr1 = gdir ? gr0 - 1 : gr0 + 1;
    const float* gpp = G + (size_t)t0 * 16 + gdir * 8 + h;
    const float gi0 = gpp[gr0 * 16], gf0 = gpp[gr0 * 16 + 4], gi1 = gpp[gr1 * 16], gf1 = gpp[gr1 * 16 + 4];
    const float* cw = p.conv_w + (size_t)l * 5 * 1024; const float* cb_ = p.conv_b + (size_t)l * 1024;
#pragma unroll 1
    for (int qk = 0; qk < 2; ++qk) {
        const int tg = tid >> 4, cb = tid & 15;
        const int ch = qk * 512 + h * 128 + cb * 8;
        u32x4 rr[8];
#pragma unroll
        for (int i = 0; i < 8; ++i) { const int tt = t0 + tg * 4 - 2 + i; const int ttc = tt < seq_lo ? seq_lo : (tt >= seq_hi ? seq_hi - 1 : tt);
            rr[i] = *(const u32x4*)(Z + (size_t)ttc * 1024 + ch); }
        float wv[5][8], bv[8];
#pragma unroll
        for (int j = 0; j < 5; ++j) { const f32x4 a = *(const f32x4*)(cw + j * 1024 + ch), b = *(const f32x4*)(cw + j * 1024 + ch + 4);
            wv[j][0] = a[0]; wv[j][1] = a[1]; wv[j][2] = a[2]; wv[j][3] = a[3]; wv[j][4] = b[0]; wv[j][5] = b[1]; wv[j][6] = b[2]; wv[j][7] = b[3]; }
        { const f32x4 a = *(const f32x4*)(cb_ + ch), b = *(const f32x4*)(cb_ + ch + 4); bv[0] = a[0]; bv[1] = a[1]; bv[2] = a[2]; bv[3] = a[3]; bv[4] = b[0]; bv[5] = b[1]; bv[6] = b[2]; bv[7] = b[3]; }
        float xin[8][8];
#pragma unroll
        for (int i = 0; i < 8; ++i) { const int tt = t0 + tg * 4 - 2 + i; const bool ok = (tt >= seq_lo) && (tt < seq_hi);
            const unsigned w4[4] = {rr[i].x, rr[i].y, rr[i].z, rr[i].w};
#pragma unroll
            for (int e = 0; e < 4; ++e) { xin[i][2 * e] = ok ? bf_lo(w4[e]) : 0.f; xin[i][2 * e + 1] = ok ? bf_hi(w4[e]) : 0.f; } }
        const float scl = qk ? 1.0f : 0.08838834764831845f;
        unsigned outw[4][4];
#pragma unroll
        for (int o = 0; o < 4; ++o) { float a[8];
#pragma unroll
            for (int e = 0; e < 8; ++e) { float acc = bv[e];
#pragma unroll
                for (int j = 0; j < 5; ++j) acc += wv[j][e] * xin[o + j][e];
                a[e] = siluf_(acc) * scl; }
            outw[o][0] = cvt_pk_bf16(a[0], a[1]); outw[o][1] = cvt_pk_bf16(a[2], a[3]); outw[o][2] = cvt_pk_bf16(a[4], a[5]); outw[o][3] = cvt_pk_bf16(a[6], a[7]);
            u32x4 w; w.x = outw[o][0]; w.y = outw[o][1]; w.z = outw[o][2]; w.w = outw[o][3];
            *(u32x4*)(QK + (size_t)(t0 + tg * 4 + o) * 1024 + ch) = w; }
        if (qk) {
#pragma unroll
            for (int e = 0; e < 8; ++e) { const int sh = (e & 1) * 16; const int wi = e >> 1;
                const unsigned t0v = (outw[0][wi] >> sh) & 0xffffu, t1v = (outw[1][wi] >> sh) & 0xffffu, t2v = (outw[2][wi] >> sh) & 0xffffu, t3v = (outw[3][wi] >> sh) & 0xffffu;
                u32x2 pk; pk.x = t0v | (t1v << 16); pk.y = t2v | (t3v << 16);
                *(LAS u32x2*)(KT + (cb * 8 + e) * LROW + tg * 8) = pk; }
        }
    }
    bf16_t* Zv = Z + PLANE + (size_t)t0 * 1024 + h * 256;
#pragma unroll
    for (int ps = 0; ps < 8; ++ps) {
        const int tok = tid & 127; const int d0 = ((tid >> 7) + 4 * ps) * 8;
        const u32x4 r = *(const u32x4*)(Zv + (size_t)tok * 1024 + d0);
        const unsigned ww[4] = {r.x, r.y, r.z, r.w};
#pragma unroll
        for (int e = 0; e < 8; ++e) *(LAS bf16_t*)(VT + (d0 + e) * LROW + tok * 2) = (bf16_t)((e & 1) ? (ww[e >> 1] >> 16) : (ww[e >> 1] & 0xffffu));
    }
    if (wave < 2) {
        const int dir = wave;
        const int r0 = gr0, r1 = gr1;
        const float i0 = gi0, f0 = gf0, i1 = gi1, f1 = gf1;
        const float s = f0 + f1; const float incl = wave_incl_sum(s, lane); const float b0 = incl - s + f0, b1 = incl;
        const float B0 = i0 - b0, B1 = i1 - b1;
        const float cmB = wave_max(fmaxf(B0, B1)); const float bend = __shfl(b1, 63);
        wsrc[dir * 128 + r0] = __expf(B0 - cmB); wsrc[dir * 128 + r1] = __expf(B1 - cmB);
        if (lane == 0) { SC[((c * 2 + dir) * 4 + h) * 2] = bend; SC[((c * 2 + dir) * 4 + h) * 2 + 1] = bend + cmB; }
    }
    __syncthreads();
#pragma unroll
    for (int ps = 0; ps < 8; ++ps) {
        const int dv = (tid >> 4) + 32 * ps, chn = tid & 15;
        const u32x4 r = *(const LAS u32x4*)(VT + dv * LROW + chn * 16);
        *(u32x4*)(Zv + (size_t)(dv >> 1) * 1024 + (dv & 1) * 128 + chn * 8) = r;
    }
#pragma unroll 1
    for (int dir = 0; dir < 2; ++dir) {
        f32x4 acc[2][8];
#pragma unroll
        for (int m = 0; m < 2; ++m)
#pragma unroll
            for (int n = 0; n < 8; ++n) acc[m][n] = (f32x4){0.f, 0.f, 0.f, 0.f};
#pragma unroll
        for (int ks = 0; ks < 4; ++ks) {
            const LAS float* wp = wsrc + dir * 128 + 32 * ks + 8 * fq;
            const f32x4 w0 = *(const LAS f32x4*)wp, w1 = *(const LAS f32x4*)(wp + 4);
#ifdef DBG_CHECK
            if (l == 0) { bool b = false;
                for (int e = 0; e < 4; ++e) { if (!(w0[e] >= 0.f && w0[e] <= 1.0001f)) b = true; if (!(w1[e] >= 0.f && w1[e] <= 1.0001f)) b = true; }
                FLAGBAD(b, 71); }
#endif
            bf16x8 af[2];
#pragma unroll
            for (int m = 0; m < 2; ++m) { const u32x4 r = *(const LAS u32x4*)(VT + (32 * wave + 16 * m + fr) * LROW + 64 * ks + 16 * fq);
                u32x4 o; o.x = cvt_pk_bf16(bf_lo(r.x) * w0[0], bf_hi(r.x) * w0[1]); o.y = cvt_pk_bf16(bf_lo(r.y) * w0[2], bf_hi(r.y) * w0[3]);
                o.z = cvt_pk_bf16(bf_lo(r.z) * w1[0], bf_hi(r.z) * w1[1]); o.w = cvt_pk_bf16(bf_lo(r.w) * w1[2], bf_hi(r.w) * w1[3]);
                af[m] = __builtin_bit_cast(bf16x8, o);
#ifdef DBG_CHECK
                if (l == 0) { bool b = false; const unsigned rr[4] = {r.x, r.y, r.z, r.w};
                    for (int e = 0; e < 4; ++e) { if (!(fabsf(bf_lo(rr[e])) < 1e4f)) b = true; if (!(fabsf(bf_hi(rr[e])) < 1e4f)) b = true; }
                    FLAGBAD(b, 72); }
#endif
            }
#pragma unroll
            for (int n = 0; n < 8; ++n) { const bf16x8 bfv = *(const LAS bf16x8*)(KT + (16 * n + fr) * LROW + 64 * ks + 16 * fq);
#ifdef DBG_CHECK
                if (l == 0) { bool b = false; const u32x4 rk = __builtin_bit_cast(u32x4, bfv); const unsigned rr[4] = {rk.x, rk.y, rk.z, rk.w};
                    for (int e = 0; e < 4; ++e) { if (!(fabsf(bf_lo(rr[e])) < 1e4f)) b = true; if (!(fabsf(bf_hi(rr[e])) < 1e4f)) b = true; }
                    FLAGBAD(b, 73); }
#endif
#pragma unroll
                for (int m = 0; m < 2; ++m) acc[m][n] = __builtin_amdgcn_mfma_f32_16x16x32_bf16(bfv, af[m], acc[m][n], 0, 0, 0); }
        }
#ifdef DBG_CHECK
        if (l == 0) { bool b = false;
            for (int m = 0; m < 2; ++m) for (int n = 0; n < 8; ++n) for (int e = 0; e < 4; ++e) if (!(fabsf(acc[m][n][e]) < 1e6f)) b = true;
            FLAGBAD(b, 74); }
#endif
        bf16_t* st = ST + (size_t)((c * 2 + dir) * 4 + h) * 32768;
#pragma unroll
        for (int m = 0; m < 2; ++m)
#pragma unroll
            for (int n = 0; n < 8; ++n) { u32x2 w; w.x = cvt_pk_bf16(acc[m][n][0], acc[m][n][1]); w.y = cvt_pk_bf16(acc[m][n][2], acc[m][n][3]);
                *(u32x2*)(st + (32 * wave + 16 * m + fr) * 128 + 16 * n + 4 * fq) = w; }
        { const int dk = tid & 127, part = tid >> 7; float s = 0.f;
#pragma unroll 8
          for (int e = 0; e < 32; ++e) { const int sidx = part * 32 + e; s += wsrc[dir * 128 + sidx] * __uint_as_float(((unsigned)*(const LAS bf16_t*)(KT + dk * LROW + sidx * 2)) << 16); }
          red[(dir * 4 + part) * 128 + dk] = s; }
    }
    __syncthreads();
    if (tid < 256) { const int dir = tid >> 7, dk = tid & 127;
        NS[(size_t)((c * 2 + dir) * 4 + h) * 128 + dk] = (red[(dir * 4 + 0) * 128 + dk] + red[(dir * 4 + 1) * 128 + dk]) + (red[(dir * 4 + 2) * 128 + dk] + red[(dir * 4 + 3) * 128 + dk]); }
    __syncthreads();
}

__device__ __forceinline__ void mixA_spatial(const Params& p, int l, int c, int g, LAS unsigned char* lds, int tid, int wave, int lane) {
    const int fr = lane & 15, fq = lane >> 4;
    const bf16_t* Z = (const bf16_t*)(p.ws + OFF_Z); bf16_t* YB = (bf16_t*)(p.ws + OFF_H);
    LAS unsigned char* VBT = lds; LAS unsigned char* WS = lds + 256 * LROW;
    const int t0 = c * 128;
    const bf16_t* Zvb = Z + 4 * PLANE + (size_t)t0 * 1024;
    LAS float* rstdv = (LAS float*)(lds + 384 * LROW);
    if (tid < 128) { const float* sp = (const float*)(p.ws + OFF_SSQ) + (size_t)(t0 + tid) * 16;
        const f32x4 a = *(const f32x4*)sp, b = *(const f32x4*)(sp + 4), c4 = *(const f32x4*)(sp + 8), d = *(const f32x4*)(sp + 12);
        const float tot = ((a[0] + a[1]) + (a[2] + a[3])) + ((b[0] + b[1]) + (b[2] + b[3])) + ((c4[0] + c4[1]) + (c4[2] + c4[3])) + ((d[0] + d[1]) + (d[2] + d[3]));
        rstdv[tid] = rsqrtf(tot * (1.0f / 1024.0f) + EPS); }
    __syncthreads();
#pragma unroll
    for (int ps = 0; ps < 8; ++ps) {
        const int tok = tid & 127; const int d0 = ((tid >> 7) + 4 * ps) * 8;
        const u32x4 r = *(const u32x4*)(Zvb + (size_t)tok * 1024 + 256 * g + d0);
        const float* vn = p.vnorm_g + (size_t)l * 1024 + 256 * g + d0; const f32x4 ga = *(const f32x4*)vn, gb = *(const f32x4*)(vn + 4);
        const float rs = rstdv[tok];
        const unsigned rr[4] = {r.x, r.y, r.z, r.w}; const float gg[8] = {ga[0], ga[1], ga[2], ga[3], gb[0], gb[1], gb[2], gb[3]};
#pragma unroll
        for (int e = 0; e < 4; ++e) { const unsigned w = cvt_pk_bf16(bf_lo(rr[e]) * rs * gg[2 * e], bf_hi(rr[e]) * rs * gg[2 * e + 1]);
            *(LAS bf16_t*)(VBT + (d0 + 2 * e) * LROW + tok * 2) = (bf16_t)(w & 0xffffu); *(LAS bf16_t*)(VBT + (d0 + 2 * e + 1) * LROW + tok * 2) = (bf16_t)(w >> 16); }
    }
    { const float* wsp = p.w_sp + ((size_t)l * 4 + g) * 16384;
#pragma unroll
      for (int i = 0; i < 8; ++i) { const int idx = tid + 512 * i; const int t = idx >> 5, s4 = idx & 31; const f32x4 w4 = *(const f32x4*)(wsp + (size_t)idx * 4);
          u32x2 o; o.x = cvt_pk_bf16(w4[0], w4[1]); o.y = cvt_pk_bf16(w4[2], w4[3]); *(LAS u32x2*)(WS + t * LROW + s4 * 8) = o; } }
    __syncthreads();
    f32x4 acc[8][2];
#pragma unroll
    for (int m = 0; m < 8; ++m)
#pragma unroll
        for (int n = 0; n < 2; ++n) acc[m][n] = (f32x4){0.f, 0.f, 0.f, 0.f};
#pragma unroll
    for (int ks = 0; ks < 4; ++ks) {
        bf16x8 bfv[2];
#pragma unroll
        for (int n = 0; n < 2; ++n) bfv[n] = *(const LAS bf16x8*)(VBT + (32 * wave + 16 * n + fr) * LROW + 64 * ks + 16 * fq);
#pragma unroll
        for (int m = 0; m < 8; ++m) { const bf16x8 af = *(const LAS bf16x8*)(WS + (16 * m + fr) * LROW + 64 * ks + 16 * fq);
#pragma unroll
            for (int n = 0; n < 2; ++n) acc[m][n] = __builtin_amdgcn_mfma_f32_16x16x32_bf16(bfv[n], af, acc[m][n], 0, 0, 0); }
    }
    const bf16_t* Zu = Z + 3 * PLANE + (size_t)t0 * 1024 + 256 * g;
    const float* bsp = p.b_sp + ((size_t)l * 4 + g) * 128;
#pragma unroll
    for (int m = 0; m < 8; ++m) { const int t = 16 * m + fr; const float bb = bsp[t];
#pragma unroll
        for (int n = 0; n < 2; ++n) { const int d = 32 * wave + 16 * n + 4 * fq;
            const u32x2 ur = *(const u32x2*)(Zu + (size_t)t * 1024 + d);
            const float y0 = bf_lo(ur.x) * (acc[m][n][0] + bb), y1 = bf_hi(ur.x) * (acc[m][n][1] + bb), y2 = bf_lo(ur.y) * (acc[m][n][2] + bb), y3 = bf_hi(ur.y) * (acc[m][n][3] + bb);
            u32x2 o; o.x = cvt_pk_bf16(y0, y1); o.y = cvt_pk_bf16(y2, y3);
            *(u32x2*)(YB + (size_t)(t0 + t) * 1024 + 256 * g + d) = o; } }
    __syncthreads();
}

__device__ __forceinline__ int scan_chunk(int dir, int k) { return dir ? (k < 2 ? 1 - k : 131 - k) : k; }
__device__ __forceinline__ void scan_phase(const Params& p, int tid) {
    bf16_t* ST = (bf16_t*)(p.ws + OFF_ST); const float* SC = (const float*)(p.ws + OFF_SC); float* MP = (float*)(p.ws + OFF_MP); float* NS = (float*)(p.ws + OFF_NS);
    const int gid = blockIdx.x * NTHREADS + tid, gsz = gridDim.x * NTHREADS;
    for (int pr = gid; pr < 8 * 16384; pr += gsz) {
        const int dh = __builtin_amdgcn_readfirstlane(pr >> 14), e = pr & 16383, dir = dh >> 2, h = dh & 3;
        int lz; asm volatile("v_mov_b32 %0, 0" : "=v"(lz));
        float c0 = 0.f, c1 = 0.f, m = 0.f;
        const bool nth = (e < 64);
        float n0 = 0.f, n1 = 0.f;
#pragma unroll 1
        for (int k0 = 0; k0 < NCH; k0 += 26) {
            unsigned dv[26]; float be[26], ml[26]; f32x2 dn2[26];
#pragma unroll
            for (int j = 0; j < 26; ++j) { const int c = scan_chunk(dir, k0 + j); const int sl = (c * 2 + dir) * 4 + h;
                dv[j] = *(const unsigned*)(ST + (size_t)sl * 32768 + 2 * e); be[j] = SC[sl * 2 + lz]; ml[j] = SC[sl * 2 + 1 + lz];
                if (nth) dn2[j] = *(const f32x2*)(NS + (size_t)sl * 128 + 2 * e); }
#pragma unroll
            for (int j = 0; j < 26; ++j) { const int c = scan_chunk(dir, k0 + j); const int sl = (c * 2 + dir) * 4 + h;
                *(unsigned*)(ST + (size_t)sl * 32768 + 2 * e) = cvt_pk_bf16(c0, c1);
                if (e == 0) MP[sl] = m;
                const float mn = fmaxf(be[j] + m, ml[j]); const float wc = __expf(be[j] + m - mn), wl = __expf(ml[j] - mn);
                c0 = wc * c0 + wl * bf_lo(dv[j]); c1 = wc * c1 + wl * bf_hi(dv[j]); m = mn;
                if (nth) { *(f32x2*)(NS + (size_t)sl * 128 + 2 * e) = (f32x2){n0, n1}; n0 = wc * n0 + wl * dn2[j][0]; n1 = wc * n1 + wl * dn2[j][1]; } }
        }
    }
}

__device__ __forceinline__ void mixC_item(const Params& p, int l, int c, int h, LAS unsigned char* lds, int tid, int wave, int lane) {
    const int fr = lane & 15, fq = lane >> 4;
    const bf16_t* Z = (const bf16_t*)(p.ws + OFF_Z); const bf16_t* QK = (const bf16_t*)(p.ws + OFF_QK); const bf16_t* ST = (const bf16_t*)(p.ws + OFF_ST);
    bf16_t* YA = (bf16_t*)(p.ws + OFF_Z);
    const float* G = (const float*)(p.ws + OFF_G); const float* MP = (const float*)(p.ws + OFF_MP); const float* NS = (const float*)(p.ws + OFF_NS);
    LAS unsigned char* Qs = lds; LAS unsigned char* Ks = lds + 128 * LROW; LAS unsigned char* QBs = lds + 256 * LROW;
    LAS float* vec = (LAS float*)(lds + 384 * LROW);
    LAS float* Bv = vec;
    LAS float* Mx = vec + 256;
    LAS float* bt = vec + 512;
    LAS float* npv = vec + 768;
    LAS float* qnp = vec + 1024;
    LAS float* cfv = vec + 2048;
    LAS float* ssq = vec + 2304;
    LAS float* mpv = vec + 3328;
    const int t0 = c * 128;
#pragma unroll
    for (int ps = 0; ps < 4; ++ps) { const int tok = (tid >> 4) + 32 * ps, chn = tid & 15;
        const u32x4 q = *(const u32x4*)(QK + (size_t)(t0 + tok) * 1024 + h * 128 + chn * 8), k = *(const u32x4*)(QK + (size_t)(t0 + tok) * 1024 + 512 + h * 128 + chn * 8);
        *(LAS u32x4*)(Qs + tok * LROW + chn * 16) = q; *(LAS u32x4*)(Ks + tok * LROW + chn * 16) = k; }
    if (wave < 2) {
        const int dir = wave; const int sl = (c * 2 + dir) * 4 + h;
        const int r0 = dir ? 127 - 2 * lane : 2 * lane, r1 = dir ? r0 - 1 : r0 + 1;
        const float* gp = G + (size_t)t0 * 16 + dir * 8 + h;
        const float i0 = gp[r0 * 16], f0 = gp[r0 * 16 + 4], i1 = gp[r1 * 16], f1 = gp[r1 * 16 + 4];
        const float s = f0 + f1; const float incl = wave_incl_sum(s, lane); const float b0 = incl - s + f0, b1 = incl;
        const float B0 = i0 - b0, B1 = i1 - b1;
        const float pm = fmaxf(B0, B1); const float cmi = wave_incl_max(pm, lane);
        float cme = __shfl_up(cmi, 1); if (lane == 0) cme = -INFINITY;
        const float mprev = MP[sl];
        const float cm0 = fmaxf(cme, B0), cm1 = cmi;
        Bv[dir * 128 + r0] = B0; Bv[dir * 128 + r1] = B1;
        Mx[dir * 128 + r0] = fmaxf(mprev, cm0); Mx[dir * 128 + r1] = fmaxf(mprev, cm1);
        bt[dir * 128 + r0] = b0; bt[dir * 128 + r1] = b1;
        npv[dir * 128 + lane] = NS[(size_t)sl * 128 + lane]; npv[dir * 128 + 64 + lane] = NS[(size_t)sl * 128 + 64 + lane];
        if (lane == 0) mpv[dir] = mprev;
    }
    __syncthreads();
    f32x4 S[8];
#pragma unroll
    for (int n = 0; n < 8; ++n) S[n] = (f32x4){0.f, 0.f, 0.f, 0.f};
#pragma unroll
    for (int ks = 0; ks < 4; ++ks) { const bf16x8 af = *(const LAS bf16x8*)(Qs + (16 * wave + fr) * LROW + 64 * ks + 16 * fq);
#pragma unroll
        for (int n = 0; n < 8; ++n) { const bf16x8 bfv = *(const LAS bf16x8*)(Ks + (16 * n + fr) * LROW + 64 * ks + 16 * fq);
            S[n] = __builtin_amdgcn_mfma_f32_16x16x32_bf16(bfv, af, S[n], 0, 0, 0); } }
    { const int t = tid & 127, part = tid >> 7; float sf = 0.f, sb = 0.f;
#pragma unroll
      for (int e8 = 0; e8 < 4; ++e8) { const u32x4 r = *(const LAS u32x4*)(Qs + t * LROW + part * 64 + e8 * 16); const int d = part * 32 + e8 * 8;
          const float qv[8] = {bf_lo(r.x), bf_hi(r.x), bf_lo(r.y), bf_hi(r.y), bf_lo(r.z), bf_hi(r.z), bf_lo(r.w), bf_hi(r.w)};
#pragma unroll
          for (int e = 0; e < 8; ++e) { sf += qv[e] * npv[d + e]; sb += qv[e] * npv[128 + d + e]; } }
      qnp[(0 * 4 + part) * 128 + t] = sf; qnp[(1 * 4 + part) * 128 + t] = sb; }
    __syncthreads();
    {
        const int t = 16 * wave + fr;
        const float mxf = Mx[t], mxb = Mx[128 + t];
        float pf[8][4], pb[8][4]; float sumf = 0.f, sumb = 0.f;
#pragma unroll
        for (int n = 0; n < 8; ++n) { const f32x4 bf4 = *(const LAS f32x4*)(Bv + 16 * n + 4 * fq), bb4 = *(const LAS f32x4*)(Bv + 128 + 16 * n + 4 * fq);
#pragma unroll
            for (int j = 0; j < 4; ++j) { const int s = 16 * n + 4 * fq + j;
                const float ef = (s <= t) ? __expf(bf4[j] - mxf) : 0.f; const float eb = (s >= t) ? __expf(bb4[j] - mxb) : 0.f;
                pf[n][j] = S[n][j] * ef; pb[n][j] = S[n][j] * eb; sumf += pf[n][j]; sumb += pb[n][j]; } }
        sumf += __shfl_xor(sumf, 16); sumf += __shfl_xor(sumf, 32); sumb += __shfl_xor(sumb, 16); sumb += __shfl_xor(sumb, 32);
        const float qnf = (qnp[0 * 128 + t] + qnp[1 * 128 + t]) + (qnp[2 * 128 + t] + qnp[3 * 128 + t]);
        const float qnb = (qnp[4 * 128 + t] + qnp[5 * 128 + t]) + (qnp[6 * 128 + t] + qnp[7 * 128 + t]);
        const float wpf = __expf(mpv[0] - mxf), wpb = __expf(mpv[1] - mxb);
        const float denf = sumf + wpf * qnf, denb = sumb + wpb * qnb;
        const float rsf = 1.0f / fmaxf(fabsf(denf), __expf(-(bt[t] + mxf))), rsb = 1.0f / fmaxf(fabsf(denb), __expf(-(bt[128 + t] + mxb)));
        if (fq == 0) { cfv[t] = wpf * rsf; cfv[128 + t] = wpb * rsb; }
#pragma unroll
        for (int n = 0; n < 8; ++n) { u32x2 o; o.x = cvt_pk_bf16(pf[n][0] * rsf + pb[n][0] * rsb, pf[n][1] * rsf + pb[n][1] * rsb); o.y = cvt_pk_bf16(pf[n][2] * rsf + pb[n][2] * rsb, pf[n][3] * rsf + pb[n][3] * rsb);
            *(LAS u32x2*)(Ks + t * LROW + 32 * n + 8 * fq) = o; }
    }
    __syncthreads();
    f32x4 acc[8][2];
#pragma unroll
    for (int m = 0; m < 8; ++m)
#pragma unroll
        for (int n = 0; n < 2; ++n) acc[m][n] = (f32x4){0.f, 0.f, 0.f, 0.f};
    const bf16_t* Zv = Z + PLANE + (size_t)t0 * 1024 + h * 256;
    {
        bf16x8 bfv[2][4];
#pragma unroll
        for (int n = 0; n < 2; ++n) { const int dv = 32 * wave + 16 * n + fr; const bf16_t* bp = Zv + (size_t)(dv >> 1) * 1024 + (dv & 1) * 128;
#pragma unroll
            for (int ks = 0; ks < 4; ++ks) bfv[n][ks] = *(const bf16x8*)(bp + 32 * ks + 8 * fq); }
#pragma unroll
        for (int ks = 0; ks < 4; ++ks)
#pragma unroll
            for (int m = 0; m < 8; ++m) { const bf16x8 af = *(const LAS bf16x8*)(Ks + (16 * m + fr) * LROW + 64 * ks + 16 * fq);
#pragma unroll
                for (int n = 0; n < 2; ++n) acc[m][n] = __builtin_amdgcn_mfma_f32_16x16x32_bf16(bfv[n][ks], af, acc[m][n], 0, 0, 0); }
    }
#pragma unroll 1
    for (int sg = 0; sg < 2; ++sg) {
        asm volatile("" ::: "memory");
        bf16x8 bfv[2][4];
#pragma unroll
        for (int n = 0; n < 2; ++n) { const int dv = 32 * wave + 16 * n + fr; const bf16_t* bp = ST + (size_t)((c * 2 + sg) * 4 + h) * 32768 + dv * 128;
#pragma unroll
            for (int ks = 0; ks < 4; ++ks) bfv[n][ks] = *(const bf16x8*)(bp + 32 * ks + 8 * fq); }
#pragma unroll
        for (int mh = 0; mh < 2; ++mh) {
            f32x4 tmp[4][2];
#pragma unroll
            for (int m = 0; m < 4; ++m)
#pragma unroll
                for (int n = 0; n < 2; ++n) tmp[m][n] = (f32x4){0.f, 0.f, 0.f, 0.f};
#pragma unroll
            for (int ks = 0; ks < 4; ++ks)
#pragma unroll
                for (int m = 0; m < 4; ++m) { const bf16x8 af = *(const LAS bf16x8*)(Qs + (16 * (4 * mh + m) + fr) * LROW + 64 * ks + 16 * fq);
#pragma unroll
                    for (int n = 0; n < 2; ++n) tmp[m][n] = __builtin_amdgcn_mfma_f32_16x16x32_bf16(bfv[n][ks], af, tmp[m][n], 0, 0, 0); }
#pragma unroll
            for (int m = 0; m < 4; ++m) { const float cs_ = cfv[sg * 128 + 16 * (4 * mh + m) + fr];
#pragma unroll
                for (int n = 0; n < 2; ++n) acc[4 * mh + m][n] += tmp[m][n] * cs_; }
        }
    }
#pragma unroll
    for (int m = 0; m < 8; ++m) { float s = 0.f;
#pragma unroll
        for (int n = 0; n < 2; ++n) s += (acc[m][n][0] * acc[m][n][0] + acc[m][n][1] * acc[m][n][1]) + (acc[m][n][2] * acc[m][n][2] + acc[m][n][3] * acc[m][n][3]);
        s += __shfl_xor(s, 16); s += __shfl_xor(s, 32);
        if (fq == 0) ssq[wave * 128 + 16 * m + fr] = s; }
    __syncthreads();
    const float* hg = p.head_g + ((size_t)l * 4 + h) * 256;
    const bf16_t* Zo = Z + 2 * PLANE + (size_t)t0 * 1024 + h * 256;
    f32x4 hg4[2];
#pragma unroll
    for (int n = 0; n < 2; ++n) hg4[n] = *(const f32x4*)(hg + 32 * wave + 16 * n + 4 * fq);
#pragma unroll
    for (int m = 0; m < 8; ++m) { const int t = 16 * m + fr; float tot = 0.f;
#pragma unroll
        for (int w8 = 0; w8 < 8; ++w8) tot += ssq[w8 * 128 + t];
        const float rstd = rsqrtf(tot * (1.0f / 256.0f) + EPS);
#pragma unroll
        for (int n = 0; n < 2; ++n) { const int dv = 32 * wave + 16 * n + 4 * fq;
            const u32x2 orw = *(const u32x2*)(Zo + (size_t)t * 1024 + dv);
            const float y0 = acc[m][n][0] * rstd * hg4[n][0] * sigmoidf_(bf_lo(orw.x)), y1 = acc[m][n][1] * rstd * hg4[n][1] * sigmoidf_(bf_hi(orw.x));
            const float y2 = acc[m][n][2] * rstd * hg4[n][2] * sigmoidf_(bf_lo(orw.y)), y3 = acc[m][n][3] * rstd * hg4[n][3] * sigmoidf_(bf_hi(orw.y));
            u32x2 o; o.x = cvt_pk_bf16(y0, y1); o.y = cvt_pk_bf16(y2, y3);
            *(u32x2*)(YA + (size_t)(t0 + t) * 1024 + h * 256 + dv) = o; } }
    __syncthreads();
}


template <int MODE>
__device__ __forceinline__ void ctx_gemm_tile(const bf16_t* A0, const bf16_t* A1, const bf16_t* Bt, const int K, const bf16_t* GA, const bf16_t* GB, bf16_t* O, float* cs, const float* gc,
                                              LAS unsigned char* lds, int tile, int tid, int wave, int lane) {
    const int fr = lane & 15, fq = lane >> 4;
    const int row0 = (tile >> 5) * 32, col0 = (tile & 31) * 32;
    const int seg = (MODE == 0) ? (wave >> 2) : 0;
    const int kw = (MODE == 0) ? K / 4 : K / 8;
    const int kb = ((MODE == 0) ? (wave & 3) : wave) * kw;
    const bf16_t* A = (seg ? A1 : A0) + (size_t)(row0 + fr) * K + kb + 8 * fq;
    const bf16_t* B = Bt + (size_t)(seg * 1024 + col0 + fr) * K + kb + 8 * fq;
    f32x4 acc[2][2];
#pragma unroll
    for (int m = 0; m < 2; ++m)
#pragma unroll
        for (int n = 0; n < 2; ++n) acc[m][n] = (f32x4){0.f, 0.f, 0.f, 0.f};
#pragma unroll 4
    for (int k = 0; k < kw; k += 32) {
        bf16x8 a[2], b[2];
#pragma unroll
        for (int m = 0; m < 2; ++m) a[m] = *(const bf16x8*)(A + (size_t)(16 * m) * K + k);
#pragma unroll
        for (int n = 0; n < 2; ++n) b[n] = *(const bf16x8*)(B + (size_t)(16 * n) * K + k);
#pragma unroll
        for (int m = 0; m < 2; ++m)
#pragma unroll
            for (int n = 0; n < 2; ++n) acc[m][n] = __builtin_amdgcn_mfma_f32_16x16x32_bf16(b[n], a[m], acc[m][n], 0, 0, 0);
    }
    LAS float* red = (LAS float*)lds;
#pragma unroll
    for (int m = 0; m < 2; ++m)
#pragma unroll
        for (int n = 0; n < 2; ++n) *(LAS f32x4*)(red + wave * 1024 + (16 * m + fr) * 32 + 16 * n + 4 * fq) = acc[m][n];
    __syncthreads();
    const int r = tid >> 4, c2 = (tid & 15) * 2;
    float pa0 = 0.f, pa1 = 0.f, pb0 = 0.f, pb1 = 0.f;
#pragma unroll
    for (int w = 0; w < 8; ++w) { const f32x2 v = *(const LAS f32x2*)(red + w * 1024 + r * 32 + c2);
        if (MODE == 0 && w >= 4) { pb0 += v[0]; pb1 += v[1]; } else { pa0 += v[0]; pa1 += v[1]; } }
    const size_t o = (size_t)(row0 + r) * 1024 + col0 + c2;
    if (MODE == 0) {
        const unsigned ga = *(const unsigned*)(GA + o), gb = *(const unsigned*)(GB + o);
        const float m0 = sigmoidf_(bf_lo(ga)) * pa0 + sigmoidf_(bf_lo(gb)) * pb0, m1 = sigmoidf_(bf_hi(ga)) * pa1 + sigmoidf_(bf_hi(gb)) * pb1;
        *(unsigned*)(O + o) = cvt_pk_bf16(m0, m1);
    } else {
        const f32x2 g2 = *(const f32x2*)(gc + col0 + c2); f32x2* pp = (f32x2*)(cs + o); f32x2 x = *pp; x[0] += g2[0] * pa0; x[1] += g2[1] * pa1; *pp = x;
    }
    __syncthreads();
}


constexpr size_t OFF_BAR = 280 * 1024;
#define XB_TMO      128
#define XB_XCNT(j)  (256  + 64 * (j))
#define XB_XSUB(j)  (1280 + 64 * (j))
#define XB_XGEN(j)  (2304 + 64 * (j))
#define XB_TOP      3328
#define XB_TOPGEN   3392
#define XCD_BAR_WORDS 3456
#define XB_SPIN_CAP (1u << 22)
__device__ __forceinline__ unsigned xb_ld(unsigned* p)              { return __hip_atomic_load(p, __ATOMIC_RELAXED, __HIP_MEMORY_SCOPE_AGENT); }
__device__ __forceinline__ unsigned xb_add(unsigned* p, unsigned v) { return __hip_atomic_fetch_add(p, v, __ATOMIC_RELAXED, __HIP_MEMORY_SCOPE_AGENT); }
__device__ __forceinline__ unsigned xb_xcc_id() { return (unsigned)__builtin_amdgcn_s_getreg((3 << 11) | 20) & 0xFu; }
#define XB_SPIN(cond, bar) do { unsigned _sp = 0; while (cond) { __builtin_amdgcn_s_sleep(1); \
    if ((++_sp & 255u) == 0u) { if (xb_ld(&(bar)[XB_TMO])) break; if (_sp > XB_SPIN_CAP) { atomicAdd(&(bar)[XB_TMO], 1u); break; } } } } while (0)
struct XcdBarrier { unsigned* bar; unsigned x; volatile LAS unsigned* st; };
__device__ __forceinline__ void xcd_barrier_complete(unsigned* bar, unsigned x, unsigned& nloc, unsigned& nx) {
    const unsigned G = gridDim.x * gridDim.y * gridDim.z;
    unsigned sum, cnt, mine, sp = 0u;
    for (;;) {
        sum = 0u; cnt = 0u; mine = 0u;
#pragma unroll
        for (unsigned j = 0; j < 16; ++j) { const unsigned c = xb_ld(&bar[XB_XCNT(j)]); sum += c; cnt += (c > 0u) ? 1u : 0u; mine = (j == x) ? c : mine; }
        if (sum == G) break;
        __builtin_amdgcn_s_sleep(1);
        if ((++sp & 255u) == 0u) { if (xb_ld(&bar[XB_TMO])) break; if (sp > XB_SPIN_CAP) { atomicAdd(&bar[XB_TMO], 1u); break; } }
    }
    nloc = mine > 0u ? mine : 1u; nx = cnt > 0u ? cnt : 1u;
}
__device__ __forceinline__ void xcd_barrier(const XcdBarrier& b) {
    asm volatile("s_waitcnt vmcnt(0)" ::: "memory");
    __syncthreads();
    if (threadIdx.x == 0) {
        unsigned* bar = b.bar;
        __builtin_amdgcn_s_waitcnt(0);
        unsigned nloc = b.st[0], nx = b.st[1];
        if (nloc == 0u) { xcd_barrier_complete(bar, b.x, nloc, nx); b.st[0] = nloc; b.st[1] = nx; }
        const unsigned old = xb_add(&bar[XB_XSUB(b.x)], 1u);
        const unsigned gen = old / nloc;
        if (old + 1u == (gen + 1u) * nloc) {
            __builtin_amdgcn_fence(__ATOMIC_RELEASE, "agent");
            asm volatile("s_waitcnt vmcnt(0)" ::: "memory");
            const unsigned og = xb_add(&bar[XB_TOP], 1u);
            const unsigned tg = og / nx;
            if (og + 1u == (tg + 1u) * nx) xb_add(&bar[XB_TOPGEN], 1u);
            else XB_SPIN(xb_ld(&bar[XB_TOPGEN]) == tg, bar);
            __builtin_amdgcn_fence(__ATOMIC_ACQUIRE, "agent");
            xb_add(&bar[XB_XGEN(b.x)], 1u);
            asm volatile("s_waitcnt vmcnt(0)" ::: "memory");
        } else {
            XB_SPIN(xb_ld(&bar[XB_XGEN(b.x)]) == gen, bar);
            __builtin_amdgcn_fence(__ATOMIC_ACQUIRE, "agent");
            asm volatile("s_waitcnt vmcnt(0)" ::: "memory");
        }
    }
    __syncthreads();
}
#define XB_ST ((volatile LAS unsigned*)(lds + 144384))

#define GRID_SYNC_CG() do { T_BEGIN(); asm volatile("s_waitcnt vmcnt(0) lgkmcnt(0)" ::: "memory"); grid.sync(); T_END(12); } while (0)
#ifdef DBG_TIME
#define TACC ((LAS unsigned long long*)(lds + 143360))
#define T_BEGIN() unsigned long long t0_ = __builtin_amdgcn_s_memrealtime()
#define T_END(k) do { if (blockIdx.x == 0 && threadIdx.x == 0) TACC[k] += __builtin_amdgcn_s_memrealtime() - t0_; } while (0)
#else
#define T_BEGIN() do {} while (0)
#define T_END(k) do {} while (0)
#endif
#define GRID_SYNC() do { T_BEGIN(); { const Params pb_ = LOADP(); XcdBarrier b_; b_.bar = (unsigned*)(pb_.ws + OFF_BAR); b_.x = xb_xcc_id(); b_.st = XB_ST; xcd_barrier(b_); } T_END(12); } while (0)
typedef const __attribute__((address_space(4))) Params* KP;
typedef const __attribute__((address_space(4))) unsigned long long* KP64;
#define GPTR(T, v) ((T*)(__attribute__((address_space(1))) T*)(v))
__device__ __forceinline__ Params load_params(KP q) {
    KP64 s = (KP64)q; Params p;
    p.x = GPTR(const float, s[0]); p.c = GPTR(const float, s[1]); p.ctx = GPTR(const float, s[2]); p.c_ctx = GPTR(const float, s[3]); p.w_ada = GPTR(const float, s[4]); p.b_ada = GPTR(const float, s[5]);
    p.norm1_g = GPTR(const float, s[6]); p.norm2_g = GPTR(const float, s[7]); p.w_in = GPTR(const float, s[8]); p.conv_w = GPTR(const float, s[9]); p.conv_b = GPTR(const float, s[10]); p.gate_b = GPTR(const float, s[11]);
    p.head_g = GPTR(const float, s[12]); p.vnorm_g = GPTR(const float, s[13]); p.w_sp = GPTR(const float, s[14]); p.b_sp = GPTR(const float, s[15]); p.w_pa = GPTR(const float, s[16]); p.w_pb = GPTR(const float, s[17]);
    p.w_out = GPTR(const float, s[18]); p.w_ff1 = GPTR(const float, s[19]); p.w_ff3 = GPTR(const float, s[20]); p.w_ff2 = GPTR(const float, s[21]); p.final_g = GPTR(const float, s[22]);
    p.out = GPTR(float, s[23]); p.ws = GPTR(unsigned char, s[24]);
    return p;
}
#define LOADP() ({ KP q_ = kp; asm volatile("" : "+s"(q_)); load_params(q_); })
#define TIDS() int t_ = threadIdx.x; asm volatile("" : "+v"(t_)); const int tid = t_, lane = tid & 63, wave = __builtin_amdgcn_readfirstlane(tid >> 6); const int gw = bx * NWAVES + wave; (void)lane; (void)gw;

#ifdef DBG_CHECK
__device__ __forceinline__ void chk_bf16(const Params& p, const bf16_t* b, size_t n, unsigned code, bool on, int tid) {
    if (!on) return; unsigned* flag = (unsigned*)(p.ws + OFF_FLAG); bool bad = false;
    for (size_t i = (size_t)blockIdx.x * NTHREADS + tid; i < n; i += (size_t)gridDim.x * NTHREADS) { const float v = __uint_as_float(((unsigned)b[i]) << 16); if (!(fabsf(v) < 1e6f)) bad = true; }
    if (bad) atomicMin(flag, code);
}
__device__ __forceinline__ void chk_f32(const Params& p, const float* b, size_t n, unsigned code, bool on, int tid) {
    if (!on) return; unsigned* flag = (unsigned*)(p.ws + OFF_FLAG); bool bad = false;
    for (size_t i = (size_t)blockIdx.x * NTHREADS + tid; i < n; i += (size_t)gridDim.x * NTHREADS) { const float v = b[i]; if (!(fabsf(v) < 1e6f)) bad = true; }
    if (bad) atomicMin(flag, code);
}
#define CHK(stmt) do { TIDS(); const Params p = LOADP(); stmt; } while (0)
#else
#define CHK(stmt) do {} while (0)
#endif
__global__ void __launch_bounds__(NTHREADS, 2) fwd_megakernel(Params pk) {
    extern __shared__ __attribute__((aligned(16))) unsigned char lds_raw[];
    LAS unsigned char* lds = (LAS unsigned char*)lds_raw;
    cg::grid_group grid = cg::this_grid();
    KP kp = (KP)__builtin_amdgcn_kernarg_segment_ptr();
    const int G = gridDim.x, bx = blockIdx.x;
    const int NGW = G * NWAVES;

    { const Params p = LOADP(); if (blockIdx.x == 0) for (int i = threadIdx.x; i < XCD_BAR_WORDS; i += NTHREADS) ((unsigned*)(p.ws + OFF_BAR))[i] = 0u;
      if (threadIdx.x == 0) { XB_ST[0] = 0u; XB_ST[1] = 0u; } }
#ifdef DBG_TIME
    if (threadIdx.x < 16) TACC[threadIdx.x] = 0ull;
    __syncthreads();
#endif
#ifdef DBG_CHECK
    { const Params p = LOADP(); if (blockIdx.x == 0 && threadIdx.x == 0) *(unsigned*)(p.ws + OFF_FLAG) = 9999u; }
#endif
    if (PH(0)) { T_BEGIN(); TIDS(); const Params p = LOADP(); mods_phase(p, lds, tid, wave, lane); T_END(0); }
    __syncthreads();
    if (PH(1)) { T_BEGIN(); TIDS(); const Params p = LOADP(); convert_weights(p, 0, lds, gw, NGW, wave, lane); T_END(0); }
    GRID_SYNC_CG();
    { const Params p = LOADP(); if (threadIdx.x == 0) (void)xb_add(&((unsigned*)(p.ws + OFF_BAR))[XB_XCNT(xb_xcc_id())], 1u); }
        CHK(chk_f32(p, (const float*)(p.ws + OFF_MOD), 4 * 2 * 6144, 1, true, tid); chk_bf16(p, (const bf16_t*)(p.ws + OFF_WB), WB_END / 2, 2, true, tid));

#pragma unroll 1
    for (int l = 0; l < DEPTH; ++l) {
        if (PH(1)) if (l > 0) { T_BEGIN(); TIDS(); const Params p = LOADP(); convert_weights(p, l, lds + 65536, gw, NGW, wave, lane); T_END(1); }
        if (PH(2)) { T_BEGIN(); TIDS(); const Params p = LOADP(); norm_phase<true>(p, l, lds, gw, NGW, tid, lane); T_END(1); }
        GRID_SYNC();
        CHK(chk_bf16(p, (const bf16_t*)(p.ws + OFF_H), PLANE, 3, l == 0, tid); chk_f32(p, (const float*)(p.ws + OFF_G), (size_t)T * 16, 4, l == 0, tid));
        if (PH(3)) { T_BEGIN(); TIDS(); const Params p = LOADP(); bf16_t* WB = (bf16_t*)(p.ws + OFF_WB); bf16_t* H = (bf16_t*)(p.ws + OFF_H); bf16_t* Z = (bf16_t*)(p.ws + OFF_Z);
          pg8::Gemm g{H, H, WB + WB_WIN / 2, 1024, 0}; pg8::Sched S; S.init(65, 28, G, bx, 1, 0); EpiZ E{Z, (float*)(p.ws + OFF_SSQ)};
          pg8::gemm_phase<EpiZ>(lds, g, S, E, tid); T_END(2); }
        GRID_SYNC();
        CHK(chk_bf16(p, (const bf16_t*)(p.ws + OFF_Z), 7 * PLANE, 5, l == 0, tid));
        for (int it = bx; it < NCH * 4; it += G) { if (PH(4)) { T_BEGIN(); TIDS(); const Params p = LOADP(); mixA_mlstm(p, l, it >> 2, it & 3, lds, tid, wave, lane); T_END(3); } }
        { const int nA = (G > 8) ? ((G - 8 < NCH * 4) ? G - 8 : NCH * 4) : 0;
          if (bx >= 8 && bx - 8 < nA) { if (PH(5)) { T_BEGIN(); TIDS(); const Params p = LOADP(); const int j = bx - 8; mixA_spatial(p, l, j >> 2, j & 3, lds, tid, wave, lane); T_END(3); } } }
        GRID_SYNC();
        if (PH(6)) { T_BEGIN(); TIDS(); const Params p = LOADP(); scan_phase(p, tid); T_END(4); }
        GRID_SYNC();
        CHK(chk_bf16(p, (const bf16_t*)(p.ws + OFF_ST), (size_t)NCH * 8 * 32768, 11, l == 0, tid); chk_f32(p, (const float*)(p.ws + OFF_NS), (size_t)NCH * 8 * 128, 12, l == 0, tid); chk_f32(p, (const float*)(p.ws + OFF_MP), (size_t)NCH * 8, 13, l == 0, tid));
        if (PH(7)) for (int it = bx + ((l == DEPTH - 1) ? 8 : 0); it < NCH * 4; it += G) { T_BEGIN(); TIDS(); const Params p = LOADP(); mixC_item(p, l, it >> 2, it & 3, lds, tid, wave, lane); T_END(5); }
        { const int nA = (G > 8) ? ((G - 8 < NCH * 4) ? G - 8 : NCH * 4) : 0;
          for (int j = nA + ((bx + G - 32) % G); j < NCH * 4; j += G) { if (PH(5)) { T_BEGIN(); TIDS(); const Params p = LOADP(); mixA_spatial(p, l, j >> 2, j & 3, lds, tid, wave, lane); T_END(5); } } }
        GRID_SYNC();
        CHK(chk_bf16(p, (const bf16_t*)(p.ws + OFF_Z), PLANE, 14, l == 0, tid));
        if (PH(8)) { T_BEGIN(); TIDS(); const Params p = LOADP(); bf16_t* WB = (bf16_t*)(p.ws + OFF_WB); bf16_t* H = (bf16_t*)(p.ws + OFF_H); bf16_t* Z = (bf16_t*)(p.ws + OFF_Z);
          if (l < DEPTH - 1) for (int tile = bx; tile < 256; tile += G) ctx_gemm_tile<0>(Z, H, WB + WB_WPAB / 2, 1024, Z + 5 * PLANE, Z + 6 * PLANE, Z + 3 * PLANE, nullptr, nullptr, lds, tile, tid, wave, lane);
          pg8::Gemm g{Z, H, WB + WB_WPAB / 2, 1024, 4}; pg8::Sched S; S.init(64, 4, G, bx, 2, 1); EpiMerge E{Z + 5 * PLANE, Z + 6 * PLANE, Z + 3 * PLANE};
          pg8::gemm_phase<EpiMerge>(lds, g, S, E, tid); T_END(6); }
        GRID_SYNC();
        CHK(chk_bf16(p, (const bf16_t*)(p.ws + OFF_Z) + 3 * PLANE, PLANE, 15, l == 0, tid));
        if (PH(9)) { T_BEGIN(); TIDS(); const Params p = LOADP(); bf16_t* WB = (bf16_t*)(p.ws + OFF_WB); bf16_t* Z = (bf16_t*)(p.ws + OFF_Z); const float* MOD = (const float*)(p.ws + OFF_MOD); float* CS = (float*)(p.ws + OFF_CS);
          if (l < DEPTH - 1) for (int tile = bx; tile < 256; tile += G) ctx_gemm_tile<1>(Z + 3 * PLANE, Z + 3 * PLANE, WB + WB_WOUT / 2, 1024, nullptr, nullptr, nullptr, CS, MOD + (size_t)(l * 2 + 1) * 6144 + 2048, lds, tile, tid, wave, lane);
          pg8::Gemm g{Z + 3 * PLANE, Z + 3 * PLANE, WB + WB_WOUT / 2, 1024, 0}; pg8::Sched S; S.init(64, 4, G, bx, 1, 1);
          EpiRes E{p.out, CS, MOD + (size_t)(l * 2 + 0) * 6144 + 2048, MOD + (size_t)(l * 2 + 1) * 6144 + 2048};
          pg8::gemm_phase<EpiRes>(lds, g, S, E, tid); T_END(7); }
        GRID_SYNC();
        CHK(chk_f32(p, p.out, (size_t)(T - NCTX) * 1024, 16, l == 0, tid); chk_f32(p, (const float*)(p.ws + OFF_CS), (size_t)NCTX * 1024, 16, l == 0, tid));
        if (PH(10)) { T_BEGIN(); TIDS(); const Params p = LOADP(); norm_phase<false>(p, l, lds, gw, NGW, tid, lane); T_END(8); }
        GRID_SYNC();
        CHK(chk_bf16(p, (const bf16_t*)(p.ws + OFF_H), PLANE, 17, l == 0, tid));
        if (PH(11)) { T_BEGIN(); TIDS(); const Params p = LOADP(); bf16_t* WB = (bf16_t*)(p.ws + OFF_WB); bf16_t* H = (bf16_t*)(p.ws + OFF_H); bf16_t* Z = (bf16_t*)(p.ws + OFF_Z);
          pg8::Gemm g{H, H, WB + WB_W13 / 2, 1024, 0}; pg8::Sched S; S.init(65, 22, G, bx, 1, 0); EpiSwiglu E{Z + PLANE};
          pg8::gemm_phase<EpiSwiglu>(lds, g, S, E, tid); T_END(9); }
        GRID_SYNC();
        CHK(chk_bf16(p, (const bf16_t*)(p.ws + OFF_Z) + PLANE, (size_t)T * DFF, 18, l == 0, tid));
        if (PH(12)) { T_BEGIN(); TIDS(); const Params p = LOADP(); bf16_t* WB = (bf16_t*)(p.ws + OFF_WB); bf16_t* Z = (bf16_t*)(p.ws + OFF_Z); const float* MOD = (const float*)(p.ws + OFF_MOD); float* CS = (float*)(p.ws + OFF_CS);
          if (l < DEPTH - 1) for (int tile = bx; tile < 256; tile += G) ctx_gemm_tile<1>(Z + PLANE, Z + PLANE, WB + WB_W2 / 2, DFF, nullptr, nullptr, nullptr, CS, MOD + (size_t)(l * 2 + 1) * 6144 + 5120, lds, tile, tid, wave, lane);
          pg8::Gemm g{Z + PLANE, Z + PLANE, WB + WB_W2 / 2, DFF, 0}; pg8::Sched S; S.init(64, 4, G, bx, 1, 1);
          EpiRes E{p.out, CS, MOD + (size_t)(l * 2 + 0) * 6144 + 5120, MOD + (size_t)(l * 2 + 1) * 6144 + 5120};
          pg8::gemm_phase<EpiRes>(lds, g, S, E, tid); T_END(10); }
        GRID_SYNC();
        CHK(chk_f32(p, p.out, (size_t)(T - NCTX) * 1024, 19 + l, true, tid));
    }
#ifdef DBG_CHECK
    GRID_SYNC();
    { const Params p = LOADP(); const unsigned f = *(volatile unsigned*)(p.ws + OFF_FLAG);
      if (f != 9999u) { for (size_t i = (size_t)blockIdx.x * NTHREADS + threadIdx.x; i < (size_t)(T - NCTX) * 1024; i += (size_t)gridDim.x * NTHREADS) p.out[i] = 100.0f * (float)f; return; } }
#endif
    if (PH(13)) { T_BEGIN(); TIDS(); const Params p = LOADP(); final_norm(p, gw, NGW, lane); T_END(11); }
#ifdef DBG_TIME
    { const Params p = LOADP(); float* tf = (float*)(p.ws + 300 * 1024);
      if (blockIdx.x == 0 && threadIdx.x == 0) { float x = 0.f, y = 0.f;
          for (int k = 0; k < 13; ++k) { const float us = (float)TACC[k] * 0.01f; if ((DBG_TX >> k) & 1) x += us; if ((DBG_TY >> k) & 1) y += us; }
          tf[0] = x; tf[1] = y; }
      GRID_SYNC();
      const float x = ((volatile float*)tf)[0], y = ((volatile float*)tf)[1];
      for (size_t i = (size_t)blockIdx.x * NTHREADS + threadIdx.x; i < (1u << 20) + 1; i += (size_t)gridDim.x * NTHREADS) p.out[i] += (i == 0) ? x : y; }
#endif
}

extern "C" void kernel_launch(void* const* d_in, const int* in_sizes, int n_in, void* d_out, int out_size, void* d_ws, size_t ws_size, hipStream_t stream) {
    static int grid = 0;
    if (grid == 0) {
        if (n_in != 23 || out_size != (T - NCTX) * D || ws_size < WS_END) { fprintf(stderr, "kernel_launch: unexpected shapes (n_in %d, out %d, ws %zu, need %zu)\n", n_in, out_size, ws_size, (size_t)WS_END); grid = -1; return; }
        int dev = 0, cus = 0, per_cu = 0;
        (void)hipGetDevice(&dev); (void)hipDeviceGetAttribute(&cus, hipDeviceAttributeMultiprocessorCount, dev);
        if (hipFuncSetAttribute((const void*)fwd_megakernel, hipFuncAttributeMaxDynamicSharedMemorySize, LDS_BYTES) != hipSuccess) { fprintf(stderr, "kernel_launch: hipFuncSetAttribute failed\n"); grid = -1; return; }
        if (hipOccupancyMaxActiveBlocksPerMultiprocessor(&per_cu, (const void*)fwd_megakernel, NTHREADS, LDS_BYTES) != hipSuccess || per_cu < 1) { fprintf(stderr, "kernel_launch: occupancy query says %d\n", per_cu); per_cu = 1; }
        (void)hipGetLastError();
        grid = cus;
    }
    if (grid < 0) return;
    Params p{};
    p.x = (const float*)d_in[0]; p.c = (const float*)d_in[1]; p.ctx = (const float*)d_in[2]; p.c_ctx = (const float*)d_in[3]; p.w_ada = (const float*)d_in[4]; p.b_ada = (const float*)d_in[5];
    p.norm1_g = (const float*)d_in[6]; p.norm2_g = (const float*)d_in[7]; p.w_in = (const float*)d_in[8]; p.conv_w = (const float*)d_in[9]; p.conv_b = (const float*)d_in[10]; p.gate_b = (const float*)d_in[11];
    p.head_g = (const float*)d_in[12]; p.vnorm_g = (const float*)d_in[13]; p.w_sp = (const float*)d_in[14]; p.b_sp = (const float*)d_in[15]; p.w_pa = (const float*)d_in[16]; p.w_pb = (const float*)d_in[17];
    p.w_out = (const float*)d_in[18]; p.w_ff1 = (const float*)d_in[19]; p.w_ff3 = (const float*)d_in[20]; p.w_ff2 = (const float*)d_in[21]; p.final_g = (const float*)d_in[22];
    p.out = (float*)d_out; p.ws = (unsigned char*)d_ws;
    void* args[] = {&p};
    hipError_t e = hipLaunchCooperativeKernel((const void*)fwd_megakernel, dim3(grid), dim3(NTHREADS), args, LDS_BYTES, stream);
    if (e != hipSuccess) fprintf(stderr, "kernel_launch: cooperative launch failed: %s (grid %d)\n", hipGetErrorString(e), grid);
}
```

```cpp
#include <hip/hip_runtime.h>
#include <hip/hip_cooperative_groups.h>
#include <cstdio>
namespace cg = cooperative_groups;

#define LAS __attribute__((address_space(3)))
typedef unsigned short bf16_t;
typedef short bf16x8 __attribute__((ext_vector_type(8)));
typedef float f32x4 __attribute__((ext_vector_type(4)));
typedef float f32x2 __attribute__((ext_vector_type(2)));
typedef unsigned u32x4 __attribute__((ext_vector_type(4)));
typedef unsigned u32x2 __attribute__((ext_vector_type(2)));

constexpr int T = 16640, NCTX = 256, D = 1024, NCH = 130, DFF = 2816, INW = 7184, ZW = 7168, DEPTH = 4;
constexpr size_t PLANE = (size_t)T * 1024;
constexpr float EPS = 1e-6f;
constexpr int NTHREADS = 512, NWAVES = 8;
constexpr int LDS_BYTES = 147456;
#ifndef PH_MASK
#define PH_MASK 0xFFFFF
#endif
#define PH(k) ((PH_MASK >> (k)) & 1)

constexpr size_t MiB = 1u << 20;
constexpr size_t OFF_MOD = 0;
constexpr size_t OFF_SC = 256 * 1024;
constexpr size_t OFF_MP = 256 * 1024 + 16 * 1024;
constexpr size_t OFF_NS = 320 * 1024;
constexpr size_t OFF_G = 1 * MiB;
constexpr size_t OFF_CS = 3 * MiB;
constexpr size_t OFF_WB = 4 * MiB;
constexpr size_t WB_WIN = 0, WB_WPAB = (size_t)ZW * 1024 * 2, WB_WOUT = WB_WPAB + (size_t)2048 * 1024 * 2, WB_W13 = WB_WOUT + (size_t)1024 * 1024 * 2,
                 WB_W2 = WB_W13 + (size_t)5632 * 1024 * 2, WB_END = WB_W2 + (size_t)1024 * 2816 * 2;
static_assert(WB_END <= 37 * MiB, "wb");
constexpr size_t OFF_H = 41 * MiB;
constexpr size_t OFF_QK = 74 * MiB;
constexpr size_t OFF_ST = 107 * MiB;
constexpr size_t OFF_Z = 172 * MiB;
constexpr size_t OFF_SSQ = 400 * MiB;
constexpr size_t WS_END = OFF_SSQ + 2 * MiB;
static_assert(OFF_Z + 7 * PLANE * 2 <= OFF_SSQ, "ws map 2");
static_assert(OFF_H + PLANE * 2 <= OFF_QK && OFF_QK + PLANE * 2 <= OFF_ST && OFF_ST + (size_t)NCH * 8 * 32768 * 2 <= OFF_Z, "ws map");

struct Params {
    const float *x, *c, *ctx, *c_ctx, *w_ada, *b_ada, *norm1_g, *norm2_g, *w_in, *conv_w, *conv_b, *gate_b, *head_g, *vnorm_g, *w_sp, *b_sp, *w_pa, *w_pb, *w_out, *w_ff1, *w_ff3, *w_ff2, *final_g;
    float* out; unsigned char* ws;
};

__device__ __forceinline__ float bf_lo(unsigned w) { return __uint_as_float(w << 16); }
__device__ __forceinline__ float bf_hi(unsigned w) { return __uint_as_float(w & 0xffff0000u); }
typedef __bf16 bf16v2_t __attribute__((ext_vector_type(2)));
__device__ __forceinline__ unsigned cvt_pk_bf16(float lo, float hi) { const f32x2 v = {lo, hi}; const bf16v2_t b = __builtin_convertvector(v, bf16v2_t); return __builtin_bit_cast(unsigned, b); }
__device__ __forceinline__ float wave_sum(float v) {
#pragma unroll
    for (int o = 1; o < 64; o <<= 1) v += __shfl_xor(v, o);
    return v;
}
__device__ __forceinline__ float wave_max(float v) {
#pragma unroll
    for (int o = 1; o < 64; o <<= 1) v = fmaxf(v, __shfl_xor(v, o));
    return v;
}
__device__ __forceinline__ float sigmoidf_(float x) { return __builtin_amdgcn_rcpf(1.0f + __expf(-x)); }
__device__ __forceinline__ float siluf_(float x) { return x * __builtin_amdgcn_rcpf(1.0f + __expf(-x)); }
__device__ __forceinline__ float geluf_(float x) {
    const float y2 = 1.5957691216057308f * (x + 0.044715f * x * x * x);
    return x * __builtin_amdgcn_rcpf(1.0f + __expf(-y2));
}
__device__ __forceinline__ float logsigf_(float x) { return fminf(x, 0.0f) - log1pf(__expf(-fabsf(x))); }
#define LDS_WAIT() asm volatile("s_waitcnt lgkmcnt(0)" ::: "memory")

namespace pg8 {
constexpr int BM = 256, BK = 64, HALF = 128, HTB = HALF * BK * 2, STAGE_BYTES = 8 * HTB, NXCD = 8, WGM = 8;
__host__ __device__ __forceinline__ int lds_byte(int r, int c) { const int st = (r >> 4) * 2 + (c >> 5), rr = r & 15, cc = c & 31, ob = rr * 64 + cc * 2; return st * 1024 + (ob ^ (((ob >> 9) & 1) << 5)); }
__host__ __device__ __forceinline__ void stage_rc(int b, int& R, int& C) { const int st = b / 1024, sb = b % 1024, swz = sb ^ (((sb >> 9) & 1) << 5); R = (st >> 1) * 16 + swz / 64; C = (st & 1) * 32 + (swz % 64) / 2; }
__host__ __device__ __forceinline__ int perm32(int rho) { const int n = rho >> 4, i = rho & 15; return 8 * (i >> 2) + 4 * n + (i & 3); }

struct Unit { int pm, pn, seg; };
struct Gemm { const bf16_t* A0; const bf16_t* A1; const bf16_t* Bt; int K; int seg_pn_off; };
struct Sched {
    int nM, nN, nwg, G, c, nseg, pm0;
    __device__ void init(int nM_, int nN_, int G_, int c_, int nseg_, int pm0_) { nM = nM_; nN = nN_; nwg = nM * nN; G = G_; c = c_; nseg = nseg_; pm0 = pm0_; }
    __device__ bool next(int i, Unit& u) const {
        const int ii = i / nseg; u.seg = i - ii * nseg;
        const long L = (long)ii * G + c; if (L >= nwg) return false;
        int wgid = (int)L; { const int q = nwg / NXCD, r = nwg % NXCD, xcd = wgid % NXCD, off = wgid / NXCD; wgid = (xcd < r ? xcd * (q + 1) : r * (q + 1) + (xcd - r) * q) + off; }
        const int nig = WGM * nN, gid = wgid / nig, fm = gid * WGM, gsz = (nM - fm) < WGM ? (nM - fm) : WGM;
        u.pm = pm0 + fm + ((wgid % nig) % gsz); u.pn = (wgid % nig) / gsz; return true;
    }
};

template <class Epi>
__device__ __forceinline__ void gemm_phase(LAS unsigned char* lds, const Gemm g, const Sched& S, const Epi& E, const int tid) {
    const int wid = __builtin_amdgcn_readfirstlane(tid >> 6), lane = tid & 63, wr = wid >> 2, wc = wid & 3, fr = lane & 15, fq = lane >> 4;
    const int K = g.K, nt = K / BK;
    unsigned voffA[2], voffB[2];
#pragma unroll
    for (int i = 0; i < 2; ++i) { int R, C; stage_rc(tid * 16 + i * 8192, R, C); const int Rb = Epi::PERM ? ((R & ~31) + perm32(R & 31)) : R;
        voffA[i] = (unsigned)(R * K + C) * 2u; voffB[i] = (unsigned)(Rb * K + C) * 2u; }
    const size_t kstep = (size_t)(BK * 2);
    const size_t hstep = (size_t)HALF * K * 2;
    const size_t tstep = 2 * hstep;
    const unsigned ldsw = (unsigned)wid * 1024u;
    const int aoff = lds_byte(wr * 64 + fr, fq * 8), boff = lds_byte(wc * 32 + fr, fq * 8);
#define PG8_SA(b, h) (((b) * 2 + (h)) * HTB)
#define PG8_SB(b, h) ((4 + (b) * 2 + (h)) * HTB)
#define PG8_STAGE(bufoff, gbase, voff) do { _Pragma("unroll") for (int _i = 0; _i < 2; ++_i) \
        __builtin_amdgcn_global_load_lds((const unsigned*)((const char*)(gbase) + (voff)[_i]), (LAS unsigned*)(lds + (bufoff) + ldsw + _i * 8192), 16, 0, 0); } while (0)
#define PG8_LDA(dst, b, h) do { _Pragma("unroll") for (int m = 0; m < 4; ++m) _Pragma("unroll") for (int k = 0; k < 2; ++k) dst[m][k] = *(const LAS bf16x8*)(lds + PG8_SA(b, h) + aoff + m * 2048 + k * 1024); } while (0)
#define PG8_LDB(dst, b, h) do { _Pragma("unroll") for (int n = 0; n < 2; ++n) _Pragma("unroll") for (int k = 0; k < 2; ++k) dst[n][k] = *(const LAS bf16x8*)(lds + PG8_SB(b, h) + boff + n * 2048 + k * 1024); } while (0)
#define PG8_MMA(ai, bj, At, Bt) do { __builtin_amdgcn_s_setprio(1); _Pragma("unroll") for (int m = 0; m < 4; ++m) _Pragma("unroll") for (int n = 0; n < 2; ++n) _Pragma("unroll") for (int k = 0; k < 2; ++k) \
        acc[ai][bj][m][n] = __builtin_amdgcn_mfma_f32_16x16x32_bf16(Bt[n][k], At[m][k], acc[ai][bj][m][n], 0, 0, 0); __builtin_amdgcn_s_setprio(0); } while (0)
#define PG8_WAIT_V(n) asm volatile("s_waitcnt vmcnt(" #n ")" ::: "memory")
#define PG8_WAIT_L(n) asm volatile("s_waitcnt lgkmcnt(" #n ")" ::: "memory")
#define PG8_BAR __builtin_amdgcn_s_barrier()
#define PG8_SCHED __builtin_amdgcn_sched_barrier(0)
    Unit cur, nxt; int ui = 0;
    if (!S.next(0, cur)) return;
    f32x4 acc[2][2][4][2];
#pragma unroll
    for (int a = 0; a < 2; ++a)
#pragma unroll
        for (int b = 0; b < 2; ++b)
#pragma unroll
            for (int m = 0; m < 4; ++m)
#pragma unroll
                for (int n = 0; n < 2; ++n) acc[a][b][m][n] = (f32x4){0.f, 0.f, 0.f, 0.f};
    bf16x8 At[4][2], B0[2][2], B1[2][2];
    const char* cA = (const char*)(cur.seg ? g.A1 : g.A0) + (size_t)cur.pm * tstep; const char* cB = (const char*)g.Bt + (size_t)(cur.pn + cur.seg * g.seg_pn_off) * tstep;
    PG8_STAGE(PG8_SB(0, 0), cB, voffB); PG8_STAGE(PG8_SA(0, 0), cA, voffA); PG8_STAGE(PG8_SB(0, 1), cB + hstep, voffB); PG8_STAGE(PG8_SA(0, 1), cA + hstep, voffA);
    if (wr == 1) PG8_BAR;
    PG8_WAIT_V(4); PG8_BAR;
    PG8_STAGE(PG8_SB(1, 0), cB + kstep, voffB); PG8_STAGE(PG8_SA(1, 0), cA + kstep, voffA); PG8_STAGE(PG8_SB(1, 1), cB + hstep + kstep, voffB);
    PG8_WAIT_V(6); PG8_BAR;
    for (;;) {
        const bool has_next = S.next(ui + 1, nxt);
        const char* nA = has_next ? (const char*)(nxt.seg ? g.A1 : g.A0) + (size_t)nxt.pm * tstep : cA;
        const char* nB = has_next ? (const char*)g.Bt + (size_t)(nxt.pn + nxt.seg * g.seg_pn_off) * tstep : cB;
        for (int t = 0; t < nt; t += 2) {
            const bool last = (t == nt - 2);
            const char* a1 = cA + (size_t)(t + 1) * kstep;
            const char* a2 = last ? nA : cA + (size_t)(t + 2) * kstep; const char* b2 = last ? nB : cB + (size_t)(t + 2) * kstep;
            const char* a3 = a2 + kstep; const char* b3 = b2 + kstep;
            PG8_LDB(B0, 0, 0); PG8_SCHED; PG8_LDA(At, 0, 0); PG8_STAGE(PG8_SA(1, 1), a1 + hstep, voffA);
            PG8_WAIT_L(8); PG8_BAR; PG8_WAIT_L(0); PG8_MMA(0, 0, At, B0); PG8_BAR; PG8_SCHED;
            PG8_LDB(B1, 0, 1); PG8_STAGE(PG8_SB(0, 0), b2, voffB);
            PG8_BAR; PG8_WAIT_L(0); PG8_MMA(0, 1, At, B1); PG8_BAR;
            PG8_LDA(At, 0, 1); PG8_STAGE(PG8_SA(0, 0), a2, voffA);
            PG8_BAR; PG8_WAIT_L(0); PG8_MMA(1, 0, At, B0); PG8_BAR; PG8_SCHED;
            PG8_STAGE(PG8_SB(0, 1), b2 + hstep, voffB);
            PG8_WAIT_V(6); PG8_BAR; PG8_MMA(1, 1, At, B1); PG8_BAR;
            PG8_LDB(B0, 1, 0); PG8_SCHED; PG8_LDA(At, 1, 0); PG8_STAGE(PG8_SA(0, 1), a2 + hstep, voffA);
            PG8_WAIT_L(8); PG8_BAR; PG8_WAIT_L(0); PG8_MMA(0, 0, At, B0); PG8_BAR; PG8_SCHED;
            PG8_LDB(B1, 1, 1); PG8_STAGE(PG8_SB(1, 0), b3, voffB);
            PG8_BAR; PG8_WAIT_L(0); PG8_MMA(0, 1, At, B1); PG8_BAR;
            PG8_LDA(At, 1, 1); PG8_STAGE(PG8_SA(1, 0), a3, voffA);
            PG8_BAR; PG8_WAIT_L(0); PG8_MMA(1, 0, At, B0); PG8_BAR; PG8_SCHED;
            PG8_STAGE(PG8_SB(1, 1), b3 + hstep, voffB);
            PG8_WAIT_V(6); PG8_BAR; PG8_MMA(1, 1, At, B1); PG8_BAR;
        }
        const bool zero = E(acc, cur, wr, wc, fr, fq);
        if (!has_next) break;
        if (zero) {
#pragma unroll
            for (int a = 0; a < 2; ++a)
#pragma unroll
                for (int b = 0; b < 2; ++b)
#pragma unroll
                    for (int m = 0; m < 4; ++m)
#pragma unroll
                        for (int n = 0; n < 2; ++n) acc[a][b][m][n] = (f32x4){0.f, 0.f, 0.f, 0.f};
        }
        cur = nxt; cA = nA; cB = nB; ++ui;
    }
    PG8_WAIT_V(0);
    if (wr == 0) PG8_BAR;
    PG8_BAR;
#undef PG8_SA
#undef PG8_SB
#undef PG8_STAGE
#undef PG8_LDA
#undef PG8_LDB
#undef PG8_MMA
#undef PG8_WAIT_V
#undef PG8_WAIT_L
#undef PG8_BAR
#undef PG8_SCHED
}
}

typedef f32x4 AccT[2][2][4][2];
struct EpiZ {
    static constexpr bool PERM = true;
    bf16_t* Z; float* SSQP;
    __device__ __forceinline__ bool operator()(AccT& acc, const pg8::Unit& u, int wr, int wc, int fr, int fq) const {
        const int row0 = u.pm * 256 + wr * 64 + fr; const int colt = u.pn * 256; const int plane = colt >> 10;
        bf16_t* base = Z + (size_t)plane * PLANE + (colt & 1023) + wc * 32 + 8 * fq;
        const bool act = (plane == 3) || (plane == 4);
#pragma unroll
        for (int ai = 0; ai < 2; ++ai)
#pragma unroll
            for (int m = 0; m < 4; ++m) { const int row = row0 + ai * 128 + m * 16; bf16_t* rowp = base + (size_t)row * 1024; float ss = 0.f;
#pragma unroll
                for (int bj = 0; bj < 2; ++bj) { f32x4 v0 = acc[ai][bj][m][0], v1 = acc[ai][bj][m][1];
                    if (act) {
#pragma unroll
                        for (int j = 0; j < 4; ++j) { v0[j] = geluf_(v0[j]); v1[j] = geluf_(v1[j]); ss += v0[j] * v0[j] + v1[j] * v1[j]; } }
                    u32x4 w; w.x = cvt_pk_bf16(v0[0], v0[1]); w.y = cvt_pk_bf16(v0[2], v0[3]); w.z = cvt_pk_bf16(v1[0], v1[1]); w.w = cvt_pk_bf16(v1[2], v1[3]);
                    *(u32x4*)(rowp + bj * 128) = w; }
                if (plane == 4) { ss += __shfl_xor(ss, 16); ss += __shfl_xor(ss, 32); if (fq == 0) SSQP[(size_t)row * 16 + (u.pn & 3) * 4 + wc] = ss; } }
        return true;
    }
};
struct EpiMerge {
    static constexpr bool PERM = true;
    const bf16_t* GA; const bf16_t* GB; bf16_t* O;
    __device__ __forceinline__ bool operator()(AccT& acc, const pg8::Unit& u, int wr, int wc, int fr, int fq) const {
        const int row0 = u.pm * 256 + wr * 64 + fr; const int col0 = u.pn * 256 + wc * 32 + 8 * fq;
#pragma unroll
        for (int ai = 0; ai < 2; ++ai)
#pragma unroll
            for (int m = 0; m < 4; ++m) { const size_t ro = (size_t)(row0 + ai * 128 + m * 16) * 1024 + col0;
#pragma unroll
                for (int bj = 0; bj < 2; ++bj) {
                    const u32x4 gb = *(const u32x4*)(GB + ro + bj * 128);
                    float b[8] = {bf_lo(gb.x), bf_hi(gb.x), bf_lo(gb.y), bf_hi(gb.y), bf_lo(gb.z), bf_hi(gb.z), bf_lo(gb.w), bf_hi(gb.w)};
                    if (u.seg == 0) {
                        const u32x4 ga = *(const u32x4*)(GA + ro + bj * 128);
                        float a[8] = {bf_lo(ga.x), bf_hi(ga.x), bf_lo(ga.y), bf_hi(ga.y), bf_lo(ga.z), bf_hi(ga.z), bf_lo(ga.w), bf_hi(ga.w)};
#pragma unroll
                        for (int j = 0; j < 8; ++j) { const float r = sigmoidf_(a[j]) * (1.0f + __expf(-b[j])); acc[ai][bj][m][j >> 2][j & 3] *= r; }
                    } else {
                        float v[8];
#pragma unroll
                        for (int j = 0; j < 8; ++j) v[j] = acc[ai][bj][m][j >> 2][j & 3] * sigmoidf_(b[j]);
                        u32x4 w; w.x = cvt_pk_bf16(v[0], v[1]); w.y = cvt_pk_bf16(v[2], v[3]); w.z = cvt_pk_bf16(v[4], v[5]); w.w = cvt_pk_bf16(v[6], v[7]);
                        *(u32x4*)(O + ro + bj * 128) = w;
                    }
                } }
        return u.seg != 0;
    }
};
struct EpiRes {
    static constexpr bool PERM = false;
    float* out; float* cs; const float* gx; const float* gc;
    __device__ __forceinline__ bool operator()(AccT& acc, const pg8::Unit& u, int wr, int wc, int fr, int fq) const {
        const bool isc = (u.pm == 0);
        float* base = isc ? cs : out - (size_t)NCTX * 1024; const float* gv = isc ? gc : gx;
        const int row0 = u.pm * 256 + wr * 64 + fr, col0 = u.pn * 256 + wc * 32 + 4 * fq;
        f32x4 g4[2][2];
#pragma unroll
        for (int bj = 0; bj < 2; ++bj)
#pragma unroll
            for (int n = 0; n < 2; ++n) g4[bj][n] = *(const f32x4*)(gv + col0 + bj * 128 + n * 16);
#pragma unroll
        for (int ai = 0; ai < 2; ++ai)
#pragma unroll
            for (int m = 0; m < 4; ++m) { float* rowp = base + (size_t)(row0 + ai * 128 + m * 16) * 1024 + col0;
#pragma unroll
                for (int bj = 0; bj < 2; ++bj)
#pragma unroll
                    for (int n = 0; n < 2; ++n) { f32x4* p = (f32x4*)(rowp + bj * 128 + n * 16); *p = *p + g4[bj][n] * acc[ai][bj][m][n]; } }
        return true;
    }
};
struct EpiSwiglu {
    static constexpr bool PERM = true;
    bf16_t* FM;
    __device__ __forceinline__ bool operator()(AccT& acc, const pg8::Unit& u, int wr, int wc, int fr, int fq) const {
        const int row0 = u.pm * 256 + wr * 64 + fr, col0 = u.pn * 128 + wc * 32 + 8 * fq;
#pragma unroll
        for (int ai = 0; ai < 2; ++ai)
#pragma unroll
            for (int m = 0; m < 4; ++m) {
                float v[8];
#pragma unroll
                for (int j = 0; j < 8; ++j) v[j] = siluf_(acc[ai][0][m][j >> 2][j & 3]) * acc[ai][1][m][j >> 2][j & 3];
                u32x4 w; w.x = cvt_pk_bf16(v[0], v[1]); w.y = cvt_pk_bf16(v[2], v[3]); w.z = cvt_pk_bf16(v[4], v[5]); w.w = cvt_pk_bf16(v[6], v[7]);
                *(u32x4*)(FM + (size_t)(row0 + ai * 128 + m * 16) * DFF + col0) = w; }
        return true;
    }
};

__device__ __forceinline__ void transpose_item(const float* W, int ldw, int src_col0, int k0, bf16_t* WT, int K, int dst_row0, LAS float* scr, int lane) {
    float tv[32];
#pragma unroll
    for (int i = 0; i < 32; ++i) { const int kk = 2 * i + (lane >> 5); tv[i] = W[(size_t)(k0 + kk) * ldw + src_col0 + (lane & 31)]; }
#pragma unroll
    for (int i = 0; i < 32; ++i) { const int kk = 2 * i + (lane >> 5); scr[kk * 33 + (lane & 31)] = tv[i]; }
    LDS_WAIT();
    const int c = lane & 7;
#pragma unroll
    for (int j = 0; j < 4; ++j) { const int n = (lane >> 3) + 8 * j; const LAS float* s = scr + (8 * c) * 33 + n;
        u32x4 o; o.x = cvt_pk_bf16(s[0 * 33], s[1 * 33]); o.y = cvt_pk_bf16(s[2 * 33], s[3 * 33]); o.z = cvt_pk_bf16(s[4 * 33], s[5 * 33]); o.w = cvt_pk_bf16(s[6 * 33], s[7 * 33]);
        *(u32x4*)(WT + (size_t)(dst_row0 + n) * K + k0 + 8 * c) = o; }
    LDS_WAIT();
}
__device__ __forceinline__ void convert_weights(const Params& p, int l, LAS unsigned char* lds_scr, int gw, int NGW, int wave, int lane) {
    LAS float* scr = (LAS float*)(lds_scr + wave * 8448);
    bf16_t* wb = (bf16_t*)(p.ws + OFF_WB);
    constexpr int I_IN = 16 * 224, I_SQ = 16 * 32, I_F = 16 * 88, I_2 = 44 * 32;
    constexpr int NIT = I_IN + 3 * I_SQ + 2 * I_F + I_2;
    for (int it = gw; it < NIT; it += NGW) {
        int r = it;
        if (r < I_IN) { const int kb = r / 224, nb = r % 224; const int dc = nb * 32; const int sc = dc + (dc >= 3072 ? 16 : 0);
            transpose_item(p.w_in + (size_t)l * 1024 * INW, INW, sc, kb * 64, wb + WB_WIN / 2, 1024, dc, scr, lane); continue; } r -= I_IN;
        if (r < I_SQ) { const int kb = r / 32, nb = r % 32; transpose_item(p.w_pa + (size_t)l * 1024 * 1024, 1024, nb * 32, kb * 64, wb + WB_WPAB / 2, 1024, nb * 32, scr, lane); continue; } r -= I_SQ;
        if (r < I_SQ) { const int kb = r / 32, nb = r % 32; transpose_item(p.w_pb + (size_t)l * 1024 * 1024, 1024, nb * 32, kb * 64, wb + WB_WPAB / 2, 1024, 1024 + nb * 32, scr, lane); continue; } r -= I_SQ;
        if (r < I_SQ) { const int kb = r / 32, nb = r % 32; transpose_item(p.w_out + (size_t)l * 1024 * 1024, 1024, nb * 32, kb * 64, wb + WB_WOUT / 2, 1024, nb * 32, scr, lane); continue; } r -= I_SQ;
        if (r < I_F) { const int kb = r / 88, nb = r % 88; const int j0 = nb * 32; transpose_item(p.w_ff1 + (size_t)l * 1024 * DFF, DFF, j0, kb * 64, wb + WB_W13 / 2, 1024, 256 * (j0 >> 7) + (j0 & 127), scr, lane); continue; } r -= I_F;
        if (r < I_F) { const int kb = r / 88, nb = r % 88; const int j0 = nb * 32; transpose_item(p.w_ff3 + (size_t)l * 1024 * DFF, DFF, j0, kb * 64, wb + WB_W13 / 2, 1024, 256 * (j0 >> 7) + 128 + (j0 & 127), scr, lane); continue; } r -= I_F;
        { const int kb = r / 32, nb = r % 32; transpose_item(p.w_ff2 + (size_t)l * DFF * 1024, 1024, nb * 32, kb * 64, wb + WB_W2 / 2, DFF, nb * 32, scr, lane); }
    }
}

__device__ __forceinline__ void mods_phase(const Params& p, LAS unsigned char* lds, int tid, int wave, int lane) {
    LAS float* sc = (LAS float*)lds; LAS float* scc = sc + 1024; LAS float* red = scc + 1024;
    float* MOD = (float*)(p.ws + OFF_MOD);
    for (int i = tid; i < 1024; i += NTHREADS) { sc[i] = siluf_(p.c[i]); scc[i] = siluf_(p.c_ctx[i]); }
    __syncthreads();
    for (int item = blockIdx.x; item < 4 * 96; item += gridDim.x) {
        const int l = item / 96, col = (item % 96) * 64 + lane;
        const float* w = p.w_ada + (size_t)l * 1024 * 6144 + col;
        float ax = 0.f, ac = 0.f;
#pragma unroll 8
        for (int d = wave * 128; d < wave * 128 + 128; ++d) { const float wv = w[(size_t)d * 6144]; ax += sc[d] * wv; ac += scc[d] * wv; }
        red[(wave * 64 + lane) * 2] = ax; red[(wave * 64 + lane) * 2 + 1] = ac;
        __syncthreads();
        if (wave == 0) { float sx = 0.f, s2 = 0.f;
#pragma unroll
            for (int w8 = 0; w8 < 8; ++w8) { sx += red[(w8 * 64 + lane) * 2]; s2 += red[(w8 * 64 + lane) * 2 + 1]; }
            const float b = p.b_ada[l * 6144 + col];
            MOD[(size_t)(l * 2 + 0) * 6144 + col] = sx + b; MOD[(size_t)(l * 2 + 1) * 6144 + col] = s2 + b; }
        __syncthreads();
    }
}

template <bool GATES>
__device__ __forceinline__ void norm_phase(const Params& p, int l, LAS unsigned char* lds, int gw, int NGW, int tid, int lane) {
    const float* MOD = (const float*)(p.ws + OFF_MOD);
    float* CS = (float*)(p.ws + OFF_CS); bf16_t* H = (bf16_t*)(p.ws + OFF_H); float* G = (float*)(p.ws + OFF_G);
    const float* ng = (GATES ? p.norm1_g : p.norm2_g) + l * 1024;
    LAS float* wg = (LAS float*)lds;
    if (GATES) {
        const float* wsrc = p.w_in + (size_t)l * 1024 * INW + 3072;
        for (int i = tid; i < 16384; i += NTHREADS) { const int k = i >> 4, j = i & 15; wg[j * 1024 + k] = wsrc[(size_t)k * INW + j]; }
        __syncthreads();
    }
    const bool first = GATES && (l == 0);
    const bool spread = (NGW >= 64 * 32);
    const int n_lat = (T / 4 - 64 - gw + NGW - 1) / NGW;
    const int has_ctx = spread ? (((gw & 31) == 0 && (gw >> 5) < 64) ? 1 : 0) : 0;
    const int n_it = spread ? n_lat + has_ctx : (T / 4 - gw + NGW - 1) / NGW;
    for (int it = 0; it < n_it; ++it) {
        const int grp = spread ? ((it < n_lat) ? 64 + gw + it * NGW : (gw >> 5)) : gw + it * NGW;
        const int row0 = grp * 4; const bool isc = row0 < NCTX;
        const float* modp = MOD + (size_t)(l * 2 + (isc ? 1 : 0)) * 6144 + (GATES ? 0 : 3072);
        f32x4 gm[4], sh[4];
#pragma unroll
        for (int j = 0; j < 4; ++j) { const int col = 4 * lane + 256 * j; const f32x4 g4 = *(const f32x4*)(ng + col); const f32x4 s4 = *(const f32x4*)(modp + 1024 + col);
            sh[j] = *(const f32x4*)(modp + col); gm[j] = g4 * (s4 + 1.0f); }
        f32x4 xv[4][4];
#pragma unroll
        for (int r = 0; r < 4; ++r) {
            const int row = row0 + r;
            const float* src = first ? (isc ? p.ctx + (size_t)row * 1024 : p.x + (size_t)(row - NCTX) * 1024) : (isc ? CS + (size_t)row * 1024 : p.out + (size_t)(row - NCTX) * 1024);
#pragma unroll
            for (int j = 0; j < 4; ++j) xv[r][j] = *(const f32x4*)(src + 4 * lane + 256 * j);
        }
        if (first) {
#pragma unroll
            for (int r = 0; r < 4; ++r) { const int row = row0 + r; float* dst = isc ? CS + (size_t)row * 1024 : p.out + (size_t)(row - NCTX) * 1024;
#pragma unroll
                for (int j = 0; j < 4; ++j) *(f32x4*)(dst + 4 * lane + 256 * j) = xv[r][j]; }
        }
#pragma unroll
        for (int r = 0; r < 4; ++r) {
            float s = 0.f;
#pragma unroll
            for (int j = 0; j < 4; ++j) s += (xv[r][j][0] * xv[r][j][0] + xv[r][j][1] * xv[r][j][1]) + (xv[r][j][2] * xv[r][j][2] + xv[r][j][3] * xv[r][j][3]);
            const float rstd = rsqrtf(wave_sum(s) * (1.0f / 1024.0f) + EPS);
            bf16_t* hrow = H + (size_t)(row0 + r) * 1024;
#pragma unroll
            for (int j = 0; j < 4; ++j) { xv[r][j] = xv[r][j] * rstd * gm[j] + sh[j];
                u32x2 w; w.x = cvt_pk_bf16(xv[r][j][0], xv[r][j][1]); w.y = cvt_pk_bf16(xv[r][j][2], xv[r][j][3]);
                *(u32x2*)(hrow + 4 * lane + 256 * j) = w; }
        }
        if (GATES) {
            float v[64];
#pragma unroll
            for (int i = 0; i < 64; ++i) v[i] = 0.f;
#pragma unroll
            for (int gi = 0; gi < 16; ++gi) {
                if ((gi & 1) == 0) asm volatile("" ::: "memory");
#pragma unroll
                for (int j = 0; j < 4; ++j) { const f32x4 w4 = *(const LAS f32x4*)(wg + gi * 1024 + 4 * lane + 256 * j);
#pragma unroll
                    for (int r = 0; r < 4; ++r) v[r * 16 + gi] += (xv[r][j][0] * w4[0] + xv[r][j][1] * w4[1]) + (xv[r][j][2] * w4[2] + xv[r][j][3] * w4[3]); } }
#pragma unroll
            for (int i = 0; i < 32; ++i) { const bool hi = (lane & 32) != 0; const float keep = hi ? v[i + 32] : v[i]; const float send = hi ? v[i] : v[i + 32]; v[i] = keep + __shfl_xor(send, 32); }
#pragma unroll
            for (int i = 0; i < 16; ++i) { const bool hi = (lane & 16) != 0; const float keep = hi ? v[i + 16] : v[i]; const float send = hi ? v[i] : v[i + 16]; v[i] = keep + __shfl_xor(send, 16); }
#pragma unroll
            for (int i = 0; i < 8; ++i) { const bool hi = (lane & 8) != 0; const float keep = hi ? v[i + 8] : v[i]; const float send = hi ? v[i] : v[i + 8]; v[i] = keep + __shfl_xor(send, 8); }
#pragma unroll
            for (int i = 0; i < 4; ++i) { const bool hi = (lane & 4) != 0; const float keep = hi ? v[i + 4] : v[i]; const float send = hi ? v[i] : v[i + 4]; v[i] = keep + __shfl_xor(send, 4); }
#pragma unroll
            for (int i = 0; i < 2; ++i) { const bool hi = (lane & 2) != 0; const float keep = hi ? v[i + 2] : v[i]; const float send = hi ? v[i] : v[i + 2]; v[i] = keep + __shfl_xor(send, 2); }
            { const bool hi = (lane & 1) != 0; const float keep = hi ? v[1] : v[0]; const float send = hi ? v[0] : v[1]; v[0] = keep + __shfl_xor(send, 1); }
            const int gate = lane & 15;
            float val = v[0] + p.gate_b[l * 16 + gate];
            if (gate & 4) val = logsigf_(val);
            G[(size_t)row0 * 16 + lane] = val;
        }
    }
}

__device__ __forceinline__ void final_norm(const Params& p, int gw, int NGW, int lane) {
    f32x4 g4[4];
#pragma unroll
    for (int j = 0; j < 4; ++j) g4[j] = *(const f32x4*)(p.final_g + 4 * lane + 256 * j);
    for (int row = gw; row < T - NCTX; row += NGW) {
        float* rp = p.out + (size_t)row * 1024; f32x4 xv[4]; float s = 0.f;
#pragma unroll
        for (int j = 0; j < 4; ++j) { xv[j] = *(const f32x4*)(rp + 4 * lane + 256 * j); s += (xv[j][0] * xv[j][0] + xv[j][1] * xv[j][1]) + (xv[j][2] * xv[j][2] + xv[j][3] * xv[j][3]); }
        const float rstd = rsqrtf(wave_sum(s) * (1.0f / 1024.0f) + EPS);
#pragma unroll
        for (int j = 0; j < 4; ++j) { f32x4 o = xv[j] * rstd * g4[j];
#ifdef DBG_SANITIZE
#pragma unroll
            for (int e = 0; e < 4; ++e) if (!(fabsf(o[e]) < 1e30f)) o[e] = 10000.0f;
#endif
            *(f32x4*)(rp + 4 * lane + 256 * j) = o; }
    }
}

constexpr size_t OFF_FLAG = 300 * 1024;
#define FLAGBAD(cond, code) do { if (cond) atomicMin((unsigned*)(p.ws + OFF_FLAG), (unsigned)(code)); } while (0)
constexpr int LROW = 272;
__device__ __forceinline__ float wave_incl_sum(float v, int lane) {
#pragma unroll
    for (int o = 1; o < 64; o <<= 1) { const float t = __shfl_up(v, o); if (lane >= o) v += t; }
    return v;
}
__device__ __forceinline__ float wave_incl_max(float v, int lane) {
#pragma unroll
    for (int o = 1; o < 64; o <<= 1) { const float t = __shfl_up(v, o); if (lane >= o) v = fmaxf(v, t); }
    return v;
}

__device__ __forceinline__ void mixA_mlstm(const Params& p, int l, int c, int h, LAS unsigned char* lds, int tid, int wave, int lane) {
    const int fr = lane & 15, fq = lane >> 4;
    bf16_t* Z = (bf16_t*)(p.ws + OFF_Z); bf16_t* QK = (bf16_t*)(p.ws + OFF_QK); bf16_t* ST = (bf16_t*)(p.ws + OFF_ST);
    const float* G = (const float*)(p.ws + OFF_G); float* SC = (float*)(p.ws + OFF_SC); float* NS = (float*)(p.ws + OFF_NS);
    LAS unsigned char* KT = lds; LAS unsigned char* VT = lds + 128 * LROW;
    LAS float* wsrc = (LAS float*)(lds + 384 * LROW); LAS float* red = wsrc + 256;
    const int t0 = c * 128; const int seq_lo = (c < 2) ? 0 : NCTX, seq_hi = (c < 2) ? NCTX : T;
    const int gdir = wave & 1;
    const int gr0 = gdir ? 127 - 2 * lane : 2 * lane, gr1 = gdir ? gr0 - 1 : gr0 + 1;
    const float* gpp = G + (size_t)t0 * 16 + gdir * 8 + h;
    const float gi0 = gpp[gr0 * 16], gf0 = gpp[gr0 * 16 + 4], gi1 = gpp[gr1 * 16], gf1 = gpp[gr1 * 16 + 4];
    const float* cw = p.conv_w + (size_t)l * 5 * 1024; const float* cb_ = p.conv_b + (size_t)l * 1024;
#pragma unroll 1
    for (int qk = 0; qk < 2; ++qk) {
        const int tg = tid >> 4, cb = tid & 15;
        const int ch = qk * 512 + h * 128 + cb * 8;
        u32x4 rr[8];
#pragma unroll
        for (int i = 0; i < 8; ++i) { const int tt = t0 + tg * 4 - 2 + i; const int ttc = tt < seq_lo ? seq_lo : (tt >= seq_hi ? seq_hi - 1 : tt);
            rr[i] = *(const u32x4*)(Z + (size_t)ttc * 1024 + ch); }
        float wv[5][8], bv[8];
#pragma unroll
        for (int j = 0; j < 5; ++j) { const f32x4 a = *(const f32x4*)(cw + j * 1024 + ch), b = *(const f32x4*)(cw + j * 1024 + ch + 4);
            wv[j][0] = a[0]; wv[j][1] = a[1]; wv[j][2] = a[2]; wv[j][3] = a[3]; wv[j][4] = b[0]; wv[j][5] = b[1]; wv[j][6] = b[2]; wv[j][7] = b[3]; }
        { const f32x4 a = *(const f32x4*)(cb_ + ch), b = *(const f32x4*)(cb_ + ch + 4); bv[0] = a[0]; bv[1] = a[1]; bv[2] = a[2]; bv[3] = a[3]; bv[4] = b[0]; bv[5] = b[1]; bv[6] = b[2]; bv[7] = b[3]; }
        float xin[8][8];
#pragma unroll
        for (int i = 0; i < 8; ++i) { const int tt = t0 + tg * 4 - 2 + i; const bool ok = (tt >= seq_lo) && (tt < seq_hi);
            const unsigned w4[4] = {rr[i].x, rr[i].y, rr[i].z, rr[i].w};
#pragma unroll
            for (int e = 0; e < 4; ++e) { xin[i][2 * e] = ok ? bf_lo(w4[e]) : 0.f; xin[i][2 * e + 1] = ok ? bf_hi(w4[e]) : 0.f; } }
        const float scl = qk ? 1.0f : 0.08838834764831845f;
        unsigned outw[4][4];
#pragma unroll
        for (int o = 0; o < 4; ++o) { float a[8];
#pragma unroll
            for (int e = 0; e < 8; ++e) { float acc = bv[e];
#pragma unroll
                for (int j = 0; j < 5; ++j) acc += wv[j][e] * xin[o + j][e];
                a[e] = siluf_(acc) * scl; }
            outw[o][0] = cvt_pk_bf16(a[0], a[1]); outw[o][1] = cvt_pk_bf16(a[2], a[3]); outw[o][2] = cvt_pk_bf16(a[4], a[5]); outw[o][3] = cvt_pk_bf16(a[6], a[7]);
            u32x4 w; w.x = outw[o][0]; w.y = outw[o][1]; w.z = outw[o][2]; w.w = outw[o][3];
            *(u32x4*)(QK + (size_t)(t0 + tg * 4 + o) * 1024 + ch) = w; }
        if (qk) {
#pragma unroll
            for (int e = 0; e < 8; ++e) { const int sh = (e & 1) * 16; const int wi = e >> 1;
                const unsigned t0v = (outw[0][wi] >> sh) & 0xffffu, t1v = (outw[1][wi] >> sh) & 0xffffu, t2v = (outw[2][wi] >> sh) & 0xffffu, t3v = (outw[3][wi] >> sh) & 0xffffu;
                u32x2 pk; pk.x = t0v | (t1v << 16); pk.y = t2v | (t3v << 16);
                *(LAS u32x2*)(KT + (cb * 8 + e) * LROW + tg * 8) = pk; }
        }
    }
    bf16_t* Zv = Z + PLANE + (size_t)t0 * 1024 + h * 256;
#pragma unroll
    for (int ps = 0; ps < 8; ++ps) {
        const int tok = tid & 127; const int d0 = ((tid >> 7) + 4 * ps) * 8;
        const u32x4 r = *(const u32x4*)(Zv + (size_t)tok * 1024 + d0);
        const unsigned ww[4] = {r.x, r.y, r.z, r.w};
#pragma unroll
        for (int e = 0; e < 8; ++e) *(LAS bf16_t*)(VT + (d0 + e) * LROW + tok * 2) = (bf16_t)((e & 1) ? (ww[e >> 1] >> 16) : (ww[e >> 1] & 0xffffu));
    }
    if (wave < 2) {
        const int dir = wave;
        const int r0 = gr0, r1 = gr1;
        const float i0 = gi0, f0 = gf0, i1 = gi1, f1 = gf1;
        const float s = f0 + f1; const float incl = wave_incl_sum(s, lane); const float b0 = incl - s + f0, b1 = incl;
        const float B0 = i0 - b0, B1 = i1 - b1;
        const float cmB = wave_max(fmaxf(B0, B1)); const float bend = __shfl(b1, 63);
        wsrc[dir * 128 + r0] = __expf(B0 - cmB); wsrc[dir * 128 + r1] = __expf(B1 - cmB);
        if (lane == 0) { SC[((c * 2 + dir) * 4 + h) * 2] = bend; SC[((c * 2 + dir) * 4 + h) * 2 + 1] = bend + cmB; }
    }
    __syncthreads();
#pragma unroll
    for (int ps = 0; ps < 8; ++ps) {
        const int dv = (tid >> 4) + 32 * ps, chn = tid & 15;
        const u32x4 r = *(const LAS u32x4*)(VT + dv * LROW + chn * 16);
        *(u32x4*)(Zv + (size_t)(dv >> 1) * 1024 + (dv & 1) * 128 + chn * 8) = r;
    }
#pragma unroll 1
    for (int dir = 0; dir < 2; ++dir) {
        f32x4 acc[2][8];
#pragma unroll
        for (int m = 0; m < 2; ++m)
#pragma unroll
            for (int n = 0; n < 8; ++n) acc[m][n] = (f32x4){0.f, 0.f, 0.f, 0.f};
#pragma unroll
        for (int ks = 0; ks < 4; ++ks) {
            const LAS float* wp = wsrc + dir * 128 + 32 * ks + 8 * fq;
            const f32x4 w0 = *(const LAS f32x4*)wp, w1 = *(const LAS f32x4*)(wp + 4);
#ifdef DBG_CHECK
            if (l == 0) { bool b = false;
                for (int e = 0; e < 4; ++e) { if (!(w0[e] >= 0.f && w0[e] <= 1.0001f)) b = true; if (!(w1[e] >= 0.f && w1[e] <= 1.0001f)) b = true; }
                FLAGBAD(b, 71); }
#endif
            bf16x8 af[2];
#pragma unroll
            for (int m = 0; m < 2; ++m) { const u32x4 r = *(const LAS u32x4*)(VT + (32 * wave + 16 * m + fr) * LROW + 64 * ks + 16 * fq);
                u32x4 o; o.x = cvt_pk_bf16(bf_lo(r.x) * w0[0], bf_hi(r.x) * w0[1]); o.y = cvt_pk_bf16(bf_lo(r.y) * w0[2], bf_hi(r.y) * w0[3]);
                o.z = cvt_pk_bf16(bf_lo(r.z) * w1[0], bf_hi(r.z) * w1[1]); o.w = cvt_pk_bf16(bf_lo(r.w) * w1[2], bf_hi(r.w) * w1[3]);
                af[m] = __builtin_bit_cast(bf16x8, o);
#ifdef DBG_CHECK
                if (l == 0) { bool b = false; const unsigned rr[4] = {r.x, r.y, r.z, r.w};
                    for (int e = 0; e < 4; ++e) { if (!(fabsf(bf_lo(rr[e])) < 1e4f)) b = true; if (!(fabsf(bf_hi(rr[e])) < 1e4f)) b = true; }
                    FLAGBAD(b, 72); }
#endif
            }
#pragma unroll
            for (int n = 0; n < 8; ++n) { const bf16x8 bfv = *(const LAS bf16x8*)(KT + (16 * n + fr) * LROW + 64 * ks + 16 * fq);
#ifdef DBG_CHECK
                if (l == 0) { bool b = false; const u32x4 rk = __builtin_bit_cast(u32x4, bfv); const unsigned rr[4] = {rk.x, rk.y, rk.z, rk.w};
                    for (int e = 0; e < 4; ++e) { if (!(fabsf(bf_lo(rr[e])) < 1e4f)) b = true; if (!(fabsf(bf_hi(rr[e])) < 1e4f)) b = true; }
                    FLAGBAD(b, 73); }
#endif
#pragma unroll
                for (int m = 0; m < 2; ++m) acc[m][n] = __builtin_amdgcn_mfma_f32_16x16x32_bf16(bfv, af[m], acc[m][n], 0, 0, 0); }
        }
#ifdef DBG_CHECK
        if (l == 0) { bool b = false;
            for (int m = 0; m < 2; ++m) for (int n = 0; n < 8; ++n) for (int e = 0; e < 4; ++e) if (!(fabsf(acc[m][n][e]) < 1e6f)) b = true;
            FLAGBAD(b, 74); }
#endif
        bf16_t* st = ST + (size_t)((c * 2 + dir) * 4 + h) * 32768;
#pragma unroll
        for (int m = 0; m < 2; ++m)
#pragma unroll
            for (int n = 0; n < 8; ++n) { u32x2 w; w.x = cvt_pk_bf16(acc[m][n][0], acc[m][n][1]); w.y = cvt_pk_bf16(acc[m][n][2], acc[m][n][3]);
                *(u32x2*)(st + (32 * wave + 16 * m + fr) * 128 + 16 * n + 4 * fq) = w; }
        { const int dk = tid & 127, part = tid >> 7; float s = 0.f;
#pragma unroll 8
          for (int e = 0; e < 32; ++e) { const int sidx = part * 32 + e; s += wsrc[dir * 128 + sidx] * __uint_as_float(((unsigned)*(const LAS bf16_t*)(KT + dk * LROW + sidx * 2)) << 16); }
          red[(dir * 4 + part) * 128 + dk] = s; }
    }
    __syncthreads();
    if (tid < 256) { const int dir = tid >> 7, dk = tid & 127;
        NS[(size_t)((c * 2 + dir) * 4 + h) * 128 + dk] = (red[(dir * 4 + 0) * 128 + dk] + red[(dir * 4 + 1) * 128 + dk]) + (red[(dir * 4 + 2) * 128 + dk] + red[(dir * 4 + 3) * 128 + dk]); }
    __syncthreads();
}

__device__ __forceinline__ void mixA_spatial(const Params& p, int l, int c, int g, LAS unsigned char* lds, int tid, int wave, int lane) {
    const int fr = lane & 15, fq = lane >> 4;
    const bf16_t* Z = (const bf16_t*)(p.ws + OFF_Z); bf16_t* YB = (bf16_t*)(p.ws + OFF_H);
    LAS unsigned char* VBT = lds; LAS unsigned char* WS = lds + 256 * LROW;
    const int t0 = c * 128;
    const bf16_t* Zvb = Z + 4 * PLANE + (size_t)t0 * 1024;
    LAS float* rstdv = (LAS float*)(lds + 384 * LROW);
    if (tid < 128) { const float* sp = (const float*)(p.ws + OFF_SSQ) + (size_t)(t0 + tid) * 16;
        const f32x4 a = *(const f32x4*)sp, b = *(const f32x4*)(sp + 4), c4 = *(const f32x4*)(sp + 8), d = *(const f32x4*)(sp + 12);
        const float tot = ((a[0] + a[1]) + (a[2] + a[3])) + ((b[0] + b[1]) + (b[2] + b[3])) + ((c4[0] + c4[1]) + (c4[2] + c4[3])) + ((d[0] + d[1]) + (d[2] + d[3]));
        rstdv[tid] = rsqrtf(tot * (1.0f / 1024.0f) + EPS); }
    __syncthreads();
#pragma unroll
    for (int ps = 0; ps < 8; ++ps) {
        const int tok = tid & 127; const int d0 = ((tid >> 7) + 4 * ps) * 8;
        const u32x4 r = *(const u32x4*)(Zvb + (size_t)tok * 1024 + 256 * g + d0);
        const float* vn = p.vnorm_g + (size_t)l * 1024 + 256 * g + d0; const f32x4 ga = *(const f32x4*)vn, gb = *(const f32x4*)(vn + 4);
        const float rs = rstdv[tok];
        const unsigned rr[4] = {r.x, r.y, r.z, r.w}; const float gg[8] = {ga[0], ga[1], ga[2], ga[3], gb[0], gb[1], gb[2], gb[3]};
#pragma unroll
        for (int e = 0; e < 4; ++e) { const unsigned w = cvt_pk_bf16(bf_lo(rr[e]) * rs * gg[2 * e], bf_hi(rr[e]) * rs * gg[2 * e + 1]);
            *(LAS bf16_t*)(VBT + (d0 + 2 * e) * LROW + tok * 2) = (bf16_t)(w & 0xffffu); *(LAS bf16_t*)(VBT + (d0 + 2 * e + 1) * LROW + tok * 2) = (bf16_t)(w >> 16); }
    }
    { const float* wsp = p.w_sp + ((size_t)l * 4 + g) * 16384;
#pragma unroll
      for (int i = 0; i < 8; ++i) { const int idx = tid + 512 * i; const int t = idx >> 5, s4 = idx & 31; const f32x4 w4 = *(const f32x4*)(wsp + (size_t)idx * 4);
          u32x2 o; o.x = cvt_pk_bf16(w4[0], w4[1]); o.y = cvt_pk_bf16(w4[2], w4[3]); *(LAS u32x2*)(WS + t * LROW + s4 * 8) = o; } }
    __syncthreads();
    f32x4 acc[8][2];
#pragma unroll
    for (int m = 0; m < 8; ++m)
#pragma unroll
        for (int n = 0; n < 2; ++n) acc[m][n] = (f32x4){0.f, 0.f, 0.f, 0.f};
#pragma unroll
    for (int ks = 0; ks < 4; ++ks) {
        bf16x8 bfv[2];
#pragma unroll
        for (int n = 0; n < 2; ++n) bfv[n] = *(const LAS bf16x8*)(VBT + (32 * wave + 16 * n + fr) * LROW + 64 * ks + 16 * fq);
#pragma unroll
        for (int m = 0; m < 8; ++m) { const bf16x8 af = *(const LAS bf16x8*)(WS + (16 * m + fr) * LROW + 64 * ks + 16 * fq);
#pragma unroll
            for (int n = 0; n < 2; ++n) acc[m][n] = __builtin_amdgcn_mfma_f32_16x16x32_bf16(bfv[n], af, acc[m][n], 0, 0, 0); }
    }
    const bf16_t* Zu = Z + 3 * PLANE + (size_t)t0 * 1024 + 256 * g;
    const float* bsp = p.b_sp + ((size_t)l * 4 + g) * 128;
#pragma unroll
    for (int m = 0; m < 8; ++m) { const int t = 16 * m + fr; const float bb = bsp[t];
#pragma unroll
        for (int n = 0; n < 2; ++n) { const int d = 32 * wave + 16 * n + 4 * fq;
            const u32x2 ur = *(const u32x2*)(Zu + (size_t)t * 1024 + d);
            const float y0 = bf_lo(ur.x) * (acc[m][n][0] + bb), y1 = bf_hi(ur.x) * (acc[m][n][1] + bb), y2 = bf_lo(ur.y) * (acc[m][n][2] + bb), y3 = bf_hi(ur.y) * (acc[m][n][3] + bb);
            u32x2 o; o.x = cvt_pk_bf16(y0, y1); o.y = cvt_pk_bf16(y2, y3);
            *(u32x2*)(YB + (size_t)(t0 + t) * 1024 + 256 * g + d) = o; } }
    __syncthreads();
}

__device__ __forceinline__ int scan_chunk(int dir, int k) { return dir ? (k < 2 ? 1 - k : 131 - k) : k; }
__device__ __forceinline__ void scan_phase(const Params& p, int tid) {
    bf16_t* ST = (bf16_t*)(p.ws + OFF_ST); const float* SC = (const float*)(p.ws + OFF_SC); float* MP = (float*)(p.ws + OFF_MP); float* NS = (float*)(p.ws + OFF_NS);
    const int gid = blockIdx.x * NTHREADS + tid, gsz = gridDim.x * NTHREADS;
    for (int pr = gid; pr < 8 * 16384; pr += gsz) {
        const int dh = __builtin_amdgcn_readfirstlane(pr >> 14), e = pr & 16383, dir = dh >> 2, h = dh & 3;
        int lz; asm volatile("v_mov_b32 %0, 0" : "=v"(lz));
        float c0 = 0.f, c1 = 0.f, m = 0.f;
        const bool nth = (e < 64);
        float n0 = 0.f, n1 = 0.f;
#pragma unroll 1
        for (int k0 = 0; k0 < NCH; k0 += 26) {
            unsigned dv[26]; float be[26], ml[26]; f32x2 dn2[26];
#pragma unroll
            for (int j = 0; j < 26; ++j) { const int c = scan_chunk(dir, k0 + j); const int sl = (c * 2 + dir) * 4 + h;
                dv[j] = *(const unsigned*)(ST + (size_t)sl * 32768 + 2 * e); be[j] = SC[sl * 2 + lz]; ml[j] = SC[sl * 2 + 1 + lz];
                if (nth) dn2[j] = *(const f32x2*)(NS + (size_t)sl * 128 + 2 * e); }
#pragma unroll
            for (int j = 0; j < 26; ++j) { const int c = scan_chunk(dir, k0 + j); const int sl = (c * 2 + dir) * 4 + h;
                *(unsigned*)(ST + (size_t)sl * 32768 + 2 * e) = cvt_pk_bf16(c0, c1);
                if (e == 0) MP[sl] = m;
                const float mn = fmaxf(be[j] + m, ml[j]); const float wc = __expf(be[j] + m - mn), wl = __expf(ml[j] - mn);
                c0 = wc * c0 + wl * bf_lo(dv[j]); c1 = wc * c1 + wl * bf_hi(dv[j]); m = mn;
                if (nth) { *(f32x2*)(NS + (size_t)sl * 128 + 2 * e) = (f32x2){n0, n1}; n0 = wc * n0 + wl * dn2[j][0]; n1 = wc * n1 + wl * dn2[j][1]; } }
        }
    }
}

__device__ __forceinline__ void mixC_item(const Params& p, int l, int c, int h, LAS unsigned char* lds, int tid, int wave, int lane) {
    const int fr = lane & 15, fq = lane >> 4;
    const bf16_t* Z = (const bf16_t*)(p.ws + OFF_Z); const bf16_t* QK = (const bf16_t*)(p.ws + OFF_QK); const bf16_t* ST = (const bf16_t*)(p.ws + OFF_ST);
    bf16_t* YA = (bf16_t*)(p.ws + OFF_Z);
    const float* G = (const float*)(p.ws + OFF_G); const float* MP = (const float*)(p.ws + OFF_MP); const float* NS = (const float*)(p.ws + OFF_NS);
    LAS unsigned char* Qs = lds; LAS unsigned char* Ks = lds + 128 * LROW; LAS unsigned char* QBs = lds + 256 * LROW;
    LAS float* vec = (LAS float*)(lds + 384 * LROW);
    LAS float* Bv = vec;
    LAS float* Mx = vec + 256;
    LAS float* bt = vec + 512;
    LAS float* npv = vec + 768;
    LAS float* qnp = vec + 1024;
    LAS float* cfv = vec + 2048;
    LAS float* ssq = vec + 2304;
    LAS float* mpv = vec + 3328;
    const int t0 = c * 128;
#pragma unroll
    for (int ps = 0; ps < 4; ++ps) { const int tok = (tid >> 4) + 32 * ps, chn = tid & 15;
        const u32x4 q = *(const u32x4*)(QK + (size_t)(t0 + tok) * 1024 + h * 128 + chn * 8), k = *(const u32x4*)(QK + (size_t)(t0 + tok) * 1024 + 512 + h * 128 + chn * 8);
        *(LAS u32x4*)(Qs + tok * LROW + chn * 16) = q; *(LAS u32x4*)(Ks + tok * LROW + chn * 16) = k; }
    if (wave < 2) {
        const int dir = wave; const int sl = (c * 2 + dir) * 4 + h;
        const int r0 = dir ? 127 - 2 * lane : 2 * lane, r1 = dir ? r0 - 1 : r0 + 1;
        const float* gp = G + (size_t)t0 * 16 + dir * 8 + h;
        const float i0 = gp[r0 * 16], f0 = gp[r0 * 16 + 4], i1 = gp[r1 * 16], f1 = gp[r1 * 16 + 4];
        const float s = f0 + f1; const float incl = wave_incl_sum(s, lane); const float b0 = incl - s + f0, b1 = incl;
        const float B0 = i0 - b0, B1 = i1 - b1;
        const float pm = fmaxf(B0, B1); const float cmi = wave_incl_max(pm, lane);
        float cme = __shfl_up(cmi, 1); if (lane == 0) cme = -INFINITY;
        const float mprev = MP[sl];
        const float cm0 = fmaxf(cme, B0), cm1 = cmi;
        Bv[dir * 128 + r0] = B0; Bv[dir * 128 + r1] = B1;
        Mx[dir * 128 + r0] = fmaxf(mprev, cm0); Mx[dir * 128 + r1] = fmaxf(mprev, cm1);
        bt[dir * 128 + r0] = b0; bt[dir * 128 + r1] = b1;
        npv[dir * 128 + lane] = NS[(size_t)sl * 128 + lane]; npv[dir * 128 + 64 + lane] = NS[(size_t)sl * 128 + 64 + lane];
        if (lane == 0) mpv[dir] = mprev;
    }
    __syncthreads();
    f32x4 S[8];
#pragma unroll
    for (int n = 0; n < 8; ++n) S[n] = (f32x4){0.f, 0.f, 0.f, 0.f};
#pragma unroll
    for (int ks = 0; ks < 4; ++ks) { const bf16x8 af = *(const LAS bf16x8*)(Qs + (16 * wave + fr) * LROW + 64 * ks + 16 * fq);
#pragma unroll
        for (int n = 0; n < 8; ++n) { const bf16x8 bfv = *(const LAS bf16x8*)(Ks + (16 * n + fr) * LROW + 64 * ks + 16 * fq);
            S[n] = __builtin_amdgcn_mfma_f32_16x16x32_bf16(bfv, af, S[n], 0, 0, 0); } }
    { const int t = tid & 127, part = tid >> 7; float sf = 0.f, sb = 0.f;
#pragma unroll
      for (int e8 = 0; e8 < 4; ++e8) { const u32x4 r = *(const LAS u32x4*)(Qs + t * LROW + part * 64 + e8 * 16); const int d = part * 32 + e8 * 8;
          const float qv[8] = {bf_lo(r.x), bf_hi(r.x), bf_lo(r.y), bf_hi(r.y), bf_lo(r.z), bf_hi(r.z), bf_lo(r.w), bf_hi(r.w)};
#pragma unroll
          for (int e = 0; e < 8; ++e) { sf += qv[e] * npv[d + e]; sb += qv[e] * npv[128 + d + e]; } }
      qnp[(0 * 4 + part) * 128 + t] = sf; qnp[(1 * 4 + part) * 128 + t] = sb; }
    __syncthreads();
    {
        const int t = 16 * wave + fr;
        const float mxf = Mx[t], mxb = Mx[128 + t];
        float pf[8][4], pb[8][4]; float sumf = 0.f, sumb = 0.f;
#pragma unroll
        for (int n = 0; n < 8; ++n) { const f32x4 bf4 = *(const LAS f32x4*)(Bv + 16 * n + 4 * fq), bb4 = *(const LAS f32x4*)(Bv + 128 + 16 * n + 4 * fq);
#pragma unroll
            for (int j = 0; j < 4; ++j) { const int s = 16 * n + 4 * fq + j;
                const float ef = (s <= t) ? __expf(bf4[j] - mxf) : 0.f; const float eb = (s >= t) ? __expf(bb4[j] - mxb) : 0.f;
                pf[n][j] = S[n][j] * ef; pb[n][j] = S[n][j] * eb; sumf += pf[n][j]; sumb += pb[n][j]; } }
        sumf += __shfl_xor(sumf, 16); sumf += __shfl_xor(sumf, 32); sumb += __shfl_xor(sumb, 16); sumb += __shfl_xor(sumb, 32);
        const float qnf = (qnp[0 * 128 + t] + qnp[1 * 128 + t]) + (qnp[2 * 128 + t] + qnp[3 * 128 + t]);
        const float qnb = (qnp[4 * 128 + t] + qnp[5 * 128 + t]) + (qnp[6 * 128 + t] + qnp[7 * 128 + t]);
        const float wpf = __expf(mpv[0] - mxf), wpb = __expf(mpv[1] - mxb);
        const float denf = sumf + wpf * qnf, denb = sumb + wpb * qnb;
        const float rsf = 1.0f / fmaxf(fabsf(denf), __expf(-(bt[t] + mxf))), rsb = 1.0f / fmaxf(fabsf(denb), __expf(-(bt[128 + t] + mxb)));
        if (fq == 0) { cfv[t] = wpf * rsf; cfv[128 + t] = wpb * rsb; }
#pragma unroll
        for (int n = 0; n < 8; ++n) { u32x2 o; o.x = cvt_pk_bf16(pf[n][0] * rsf + pb[n][0] * rsb, pf[n][1] * rsf + pb[n][1] * rsb); o.y = cvt_pk_bf16(pf[n][2] * rsf + pb[n][2] * rsb, pf[n][3] * rsf + pb[n][3] * rsb);
            *(LAS u32x2*)(Ks + t * LROW + 32 * n + 8 * fq) = o; }
    }
    __syncthreads();
    f32x4 acc[8][2];
#pragma unroll
    for (int m = 0; m < 8; ++m)
#pragma unroll
        for (int n = 0; n < 2; ++n) acc[m][n] = (f32x4){0.f, 0.f, 0.f, 0.f};
    const bf16_t* Zv = Z + PLANE + (size_t)t0 * 1024 + h * 256;
    bf16x8 bA[2][4], bB[2][4];
#pragma unroll
    for (int n = 0; n < 2; ++n) { const int dv = 32 * wave + 16 * n + fr;
        const bf16_t* bp = Zv + (size_t)(dv >> 1) * 1024 + (dv & 1) * 128; const bf16_t* cp = ST + (size_t)((c * 2 + 0) * 4 + h) * 32768 + dv * 128;
#pragma unroll
        for (int ks = 0; ks < 4; ++ks) { bA[n][ks] = *(const bf16x8*)(bp + 32 * ks + 8 * fq); bB[n][ks] = *(const bf16x8*)(cp + 32 * ks + 8 * fq); } }
    asm volatile("" ::: "memory");
#pragma unroll
    for (int ks = 0; ks < 4; ++ks)
#pragma unroll
        for (int m = 0; m < 8; ++m) { const bf16x8 af = *(const LAS bf16x8*)(Ks + (16 * m + fr) * LROW + 64 * ks + 16 * fq);
#pragma unroll
            for (int n = 0; n < 2; ++n) acc[m][n] = __builtin_amdgcn_mfma_f32_16x16x32_bf16(bA[n][ks], af, acc[m][n], 0, 0, 0); }
    asm volatile("" ::: "memory");
#pragma unroll
    for (int n = 0; n < 2; ++n) { const int dv = 32 * wave + 16 * n + fr; const bf16_t* cp = ST + (size_t)((c * 2 + 1) * 4 + h) * 32768 + dv * 128;
#pragma unroll
        for (int ks = 0; ks < 4; ++ks) bA[n][ks] = *(const bf16x8*)(cp + 32 * ks + 8 * fq); }
    asm volatile("" ::: "memory");
#pragma unroll
    for (int sg = 0; sg < 2; ++sg) {
#pragma unroll
        for (int mh = 0; mh < 2; ++mh) {
            f32x4 tmp[4][2];
#pragma unroll
            for (int m = 0; m < 4; ++m)
#pragma unroll
                for (int n = 0; n < 2; ++n) tmp[m][n] = (f32x4){0.f, 0.f, 0.f, 0.f};
#pragma unroll
            for (int ks = 0; ks < 4; ++ks)
#pragma unroll
                for (int m = 0; m < 4; ++m) { const bf16x8 af = *(const LAS bf16x8*)(Qs + (16 * (4 * mh + m) + fr) * LROW + 64 * ks + 16 * fq);
#pragma unroll
                    for (int n = 0; n < 2; ++n) tmp[m][n] = __builtin_amdgcn_mfma_f32_16x16x32_bf16(sg == 0 ? bB[n][ks] : bA[n][ks], af, tmp[m][n], 0, 0, 0); }
#pragma unroll
            for (int m = 0; m < 4; ++m) { const float cs_ = cfv[sg * 128 + 16 * (4 * mh + m) + fr];
#pragma unroll
                for (int n = 0; n < 2; ++n) acc[4 * mh + m][n] += tmp[m][n] * cs_; }
        }
        asm volatile("" ::: "memory");
    }
#pragma unroll
    for (int m = 0; m < 8; ++m) { float s = 0.f;
#pragma unroll
        for (int n = 0; n < 2; ++n) s += (acc[m][n][0] * acc[m][n][0] + acc[m][n][1] * acc[m][n][1]) + (acc[m][n][2] * acc[m][n][2] + acc[m][n][3] * acc[m][n][3]);
        s += __shfl_xor(s, 16); s += __shfl_xor(s, 32);
        if (fq == 0) ssq[wave * 128 + 16 * m + fr] = s; }
    __syncthreads();
    const float* hg = p.head_g + ((size_t)l * 4 + h) * 256;
    const bf16_t* Zo = Z + 2 * PLANE + (size_t)t0 * 1024 + h * 256;
    f32x4 hg4[2];
#pragma unroll
    for (int n = 0; n < 2; ++n) hg4[n] = *(const f32x4*)(hg + 32 * wave + 16 * n + 4 * fq);
#pragma unroll
    for (int m = 0; m < 8; ++m) { const int t = 16 * m + fr; float tot = 0.f;
#pragma unroll
        for (int w8 = 0; w8 < 8; ++w8) tot += ssq[w8 * 128 + t];
        const float rstd = rsqrtf(tot * (1.0f / 256.0f) + EPS);
#pragma unroll
        for (int n = 0; n < 2; ++n) { const int dv = 32 * wave + 16 * n + 4 * fq;
            const u32x2 orw = *(const u32x2*)(Zo + (size_t)t * 1024 + dv);
            const float y0 = acc[m][n][0] * rstd * hg4[n][0] * sigmoidf_(bf_lo(orw.x)), y1 = acc[m][n][1] * rstd * hg4[n][1] * sigmoidf_(bf_hi(orw.x));
            const float y2 = acc[m][n][2] * rstd * hg4[n][2] * sigmoidf_(bf_lo(orw.y)), y3 = acc[m][n][3] * rstd * hg4[n][3] * sigmoidf_(bf_hi(orw.y));
            u32x2 o; o.x = cvt_pk_bf16(y0, y1); o.y = cvt_pk_bf16(y2, y3);
            *(u32x2*)(YA + (size_t)(t0 + t) * 1024 + h * 256 + dv) = o; } }
    __syncthreads();
}


template <int MODE>
__device__ __forceinline__ void ctx_gemm_tile(const bf16_t* A0, const bf16_t* A1, const bf16_t* Bt, const int K, const bf16_t* GA, const bf16_t* GB, bf16_t* O, float* cs, const float* gc,
                                              LAS unsigned char* lds, int tile, int tid, int wave, int lane) {
    const int fr = lane & 15, fq = lane >> 4;
    const int row0 = (tile >> 5) * 32, col0 = (tile & 31) * 32;
    const int seg = (MODE == 0) ? (wave >> 2) : 0;
    const int kw = (MODE == 0) ? K / 4 : K / 8;
    const int kb = ((MODE == 0) ? (wave & 3) : wave) * kw;
    const bf16_t* A = (seg ? A1 : A0) + (size_t)(row0 + fr) * K + kb + 8 * fq;
    const bf16_t* B = Bt + (size_t)(seg * 1024 + col0 + fr) * K + kb + 8 * fq;
    f32x4 acc[2][2];
#pragma unroll
    for (int m = 0; m < 2; ++m)
#pragma unroll
        for (int n = 0; n < 2; ++n) acc[m][n] = (f32x4){0.f, 0.f, 0.f, 0.f};
#pragma unroll 4
    for (int k = 0; k < kw; k += 32) {
        bf16x8 a[2], b[2];
#pragma unroll
        for (int m = 0; m < 2; ++m) a[m] = *(const bf16x8*)(A + (size_t)(16 * m) * K + k);
#pragma unroll
        for (int n = 0; n < 2; ++n) b[n] = *(const bf16x8*)(B + (size_t)(16 * n) * K + k);
#pragma unroll
        for (int m = 0; m < 2; ++m)
#pragma unroll
            for (int n = 0; n < 2; ++n) acc[m][n] = __builtin_amdgcn_mfma_f32_16x16x32_bf16(b[n], a[m], acc[m][n], 0, 0, 0);
    }
    LAS float* red = (LAS float*)lds;
#pragma unroll
    for (int m = 0; m < 2; ++m)
#pragma unroll
        for (int n = 0; n < 2; ++n) *(LAS f32x4*)(red + wave * 1024 + (16 * m + fr) * 32 + 16 * n + 4 * fq) = acc[m][n];
    __syncthreads();
    const int r = tid >> 4, c2 = (tid & 15) * 2;
    float pa0 = 0.f, pa1 = 0.f, pb0 = 0.f, pb1 = 0.f;
#pragma unroll
    for (int w = 0; w < 8; ++w) { const f32x2 v = *(const LAS f32x2*)(red + w * 1024 + r * 32 + c2);
        if (MODE == 0 && w >= 4) { pb0 += v[0]; pb1 += v[1]; } else { pa0 += v[0]; pa1 += v[1]; } }
    const size_t o = (size_t)(row0 + r) * 1024 + col0 + c2;
    if (MODE == 0) {
        const unsigned ga = *(const unsigned*)(GA + o), gb = *(const unsigned*)(GB + o);
        const float m0 = sigmoidf_(bf_lo(ga)) * pa0 + sigmoidf_(bf_lo(gb)) * pb0, m1 = sigmoidf_(bf_hi(ga)) * pa1 + sigmoidf_(bf_hi(gb)) * pb1;
        *(unsigned*)(O + o) = cvt_pk_bf16(m0, m1);
    } else {
        const f32x2 g2 = *(const f32x2*)(gc + col0 + c2); f32x2* pp = (f32x2*)(cs + o); f32x2 x = *pp; x[0] += g2[0] * pa0; x[1] += g2[1] * pa1; *pp = x;
    }
    __syncthreads();
}


constexpr size_t OFF_BAR = 280 * 1024;
#define XB_TMO      128
#define XB_XCNT(j)  (256  + 64 * (j))
#define XB_XSUB(j)  (1280 + 64 * (j))
#define XB_XGEN(j)  (2304 + 64 * (j))
#define XB_TOP      3328
#define XB_TOPGEN   3392
#define XCD_BAR_WORDS 3456
#define XB_SPIN_CAP (1u << 22)
__device__ __forceinline__ unsigned xb_ld(unsigned* p)              { return __hip_atomic_load(p, __ATOMIC_RELAXED, __HIP_MEMORY_SCOPE_AGENT); }
__device__ __forceinline__ unsigned xb_add(unsigned* p, unsigned v) { return __hip_atomic_fetch_add(p, v, __ATOMIC_RELAXED, __HIP_MEMORY_SCOPE_AGENT); }
__device__ __forceinline__ unsigned xb_xcc_id() { return (unsigned)__builtin_amdgcn_s_getreg((3 << 11) | 20) & 0xFu; }
#define XB_SPIN(cond, bar) do { unsigned _sp = 0; while (cond) { __builtin_amdgcn_s_sleep(1); \
    if ((++_sp & 255u) == 0u) { if (xb_ld(&(bar)[XB_TMO])) break; if (_sp > XB_SPIN_CAP) { atomicAdd(&(bar)[XB_TMO], 1u); break; } } } } while (0)
struct XcdBarrier { unsigned* bar; unsigned x; volatile LAS unsigned* st; };
__device__ __forceinline__ void xcd_barrier_complete(unsigned* bar, unsigned x, unsigned& nloc, unsigned& nx) {
    const unsigned G = gridDim.x * gridDim.y * gridDim.z;
    unsigned sum, cnt, mine, sp = 0u;
    for (;;) {
        sum = 0u; cnt = 0u; mine = 0u;
#pragma unroll
        for (unsigned j = 0; j < 16; ++j) { const unsigned c = xb_ld(&bar[XB_XCNT(j)]); sum += c; cnt += (c > 0u) ? 1u : 0u; mine = (j == x) ? c : mine; }
        if (sum == G) break;
        __builtin_amdgcn_s_sleep(1);
        if ((++sp & 255u) == 0u) { if (xb_ld(&bar[XB_TMO])) break; if (sp > XB_SPIN_CAP) { atomicAdd(&bar[XB_TMO], 1u); break; } }
    }
    nloc = mine > 0u ? mine : 1u; nx = cnt > 0u ? cnt : 1u;
}
__device__ __forceinline__ void xcd_barrier(const XcdBarrier& b) {
    asm volatile("s_waitcnt vmcnt(0)" ::: "memory");
    __syncthreads();
    if (threadIdx.x == 0) {
        unsigned* bar = b.bar;
        __builtin_amdgcn_s_waitcnt(0);
        unsigned nloc = b.st[0], nx = b.st[1];
        if (nloc == 0u) { xcd_barrier_complete(bar, b.x, nloc, nx); b.st[0] = nloc; b.st[1] = nx; }
        const unsigned old = xb_add(&bar[XB_XSUB(b.x)], 1u);
        const unsigned gen = old / nloc;
        if (old + 1u == (gen + 1u) * nloc) {
            __builtin_amdgcn_fence(__ATOMIC_RELEASE, "agent");
            asm volatile("s_waitcnt vmcnt(0)" ::: "memory");
            const unsigned og = xb_add(&bar[XB_TOP], 1u);
            const unsigned tg = og / nx;
            if (og + 1u == (tg + 1u) * nx) xb_add(&bar[XB_TOPGEN], 1u);
            else XB_SPIN(xb_ld(&bar[XB_TOPGEN]) == tg, bar);
            __builtin_amdgcn_fence(__ATOMIC_ACQUIRE, "agent");
            xb_add(&bar[XB_XGEN(b.x)], 1u);
            asm volatile("s_waitcnt vmcnt(0)" ::: "memory");
        } else {
            XB_SPIN(xb_ld(&bar[XB_XGEN(b.x)]) == gen, bar);
            __builtin_amdgcn_fence(__ATOMIC_ACQUIRE, "agent");
            asm volatile("s_waitcnt vmcnt(0)" ::: "memory");
        }
    }
    __syncthreads();
}
#define XB_ST ((volatile LAS unsigned*)(lds + 144384))

#define GRID_SYNC_CG() do { T_BEGIN(); asm volatile("s_waitcnt vmcnt(0) lgkmcnt(0)" ::: "memory"); grid.sync(); T_END(12); } while (0)
#ifdef DBG_TIME
#define TACC ((LAS unsigned long long*)(lds + 143360))
#define T_BEGIN() unsigned long long t0_ = __builtin_amdgcn_s_memrealtime()
#define T_END(k) do { if (blockIdx.x == 0 && threadIdx.x == 0) TACC[k] += __builtin_amdgcn_s_memrealtime() - t0_; } while (0)
#else
#define T_BEGIN() do {} while (0)
#define T_END(k) do {} while (0)
#endif
#define GRID_SYNC() do { T_BEGIN(); { const Params pb_ = LOADP(); XcdBarrier b_; b_.bar = (unsigned*)(pb_.ws + OFF_BAR); b_.x = xb_xcc_id(); b_.st = XB_ST; xcd_barrier(b_); } T_END(12); } while (0)
typedef const __attribute__((address_space(4))) Params* KP;
typedef const __attribute__((address_space(4))) unsigned long long* KP64;
#define GPTR(T, v) ((T*)(__attribute__((address_space(1))) T*)(v))
__device__ __forceinline__ Params load_params(KP q) {
    KP64 s = (KP64)q; Params p;
    p.x = GPTR(const float, s[0]); p.c = GPTR(const float, s[1]); p.ctx = GPTR(const float, s[2]); p.c_ctx = GPTR(const float, s[3]); p.w_ada = GPTR(const float, s[4]); p.b_ada = GPTR(const float, s[5]);
    p.norm1_g = GPTR(const float, s[6]); p.norm2_g = GPTR(const float, s[7]); p.w_in = GPTR(const float, s[8]); p.conv_w = GPTR(const float, s[9]); p.conv_b = GPTR(const float, s[10]); p.gate_b = GPTR(const float, s[11]);
    p.head_g = GPTR(const float, s[12]); p.vnorm_g = GPTR(const float, s[13]); p.w_sp = GPTR(const float, s[14]); p.b_sp = GPTR(const float, s[15]); p.w_pa = GPTR(const float, s[16]); p.w_pb = GPTR(const float, s[17]);
    p.w_out = GPTR(const float, s[18]); p.w_ff1 = GPTR(const float, s[19]); p.w_ff3 = GPTR(const float, s[20]); p.w_ff2 = GPTR(const float, s[21]); p.final_g = GPTR(const float, s[22]);
    p.out = GPTR(float, s[23]); p.ws = GPTR(unsigned char, s[24]);
    return p;
}
#define LOADP() ({ KP q_ = kp; asm volatile("" : "+s"(q_)); load_params(q_); })
#define TIDS() int t_ = threadIdx.x; asm volatile("" : "+v"(t_)); const int tid = t_, lane = tid & 63, wave = __builtin_amdgcn_readfirstlane(tid >> 6); const int gw = bx * NWAVES + wave; (void)lane; (void)gw;

#ifdef DBG_CHECK
__device__ __forceinline__ void chk_bf16(const Params& p, const bf16_t* b, size_t n, unsigned code, bool on, int tid) {
    if (!on) return; unsigned* flag = (unsigned*)(p.ws + OFF_FLAG); bool bad = false;
    for (size_t i = (size_t)blockIdx.x * NTHREADS + tid; i < n; i += (size_t)gridDim.x * NTHREADS) { const float v = __uint_as_float(((unsigned)b[i]) << 16); if (!(fabsf(v) < 1e6f)) bad = true; }
    if (bad) atomicMin(flag, code);
}
__device__ __forceinline__ void chk_f32(const Params& p, const float* b, size_t n, unsigned code, bool on, int tid) {
    if (!on) return; unsigned* flag = (unsigned*)(p.ws + OFF_FLAG); bool bad = false;
    for (size_t i = (size_t)blockIdx.x * NTHREADS + tid; i < n; i += (size_t)gridDim.x * NTHREADS) { const float v = b[i]; if (!(fabsf(v) < 1e6f)) bad = true; }
    if (bad) atomicMin(flag, code);
}
#define CHK(stmt) do { TIDS(); const Params p = LOADP(); stmt; } while (0)
#else
#define CHK(stmt) do {} while (0)
#endif
__global__ void __launch_bounds__(NTHREADS, 2) fwd_megakernel(Params pk) {
    extern __shared__ __attribute__((aligned(16))) unsigned char lds_raw[];
    LAS unsigned char* lds = (LAS unsigned char*)lds_raw;
    cg::grid_group grid = cg::this_grid();
    KP kp = (KP)__builtin_amdgcn_kernarg_segment_ptr();
    const int G = gridDim.x, bx = blockIdx.x;
    const int NGW = G * NWAVES;

    { const Params p = LOADP(); if (blockIdx.x == 0) for (int i = threadIdx.x; i < XCD_BAR_WORDS; i += NTHREADS) ((unsigned*)(p.ws + OFF_BAR))[i] = 0u;
      if (threadIdx.x == 0) { XB_ST[0] = 0u; XB_ST[1] = 0u; } }
#ifdef DBG_TIME
    if (threadIdx.x < 16) TACC[threadIdx.x] = 0ull;
    __syncthreads();
#endif
#ifdef DBG_CHECK
    { const Params p = LOADP(); if (blockIdx.x == 0 && threadIdx.x == 0) *(unsigned*)(p.ws + OFF_FLAG) = 9999u; }
#endif
    if (PH(0)) { T_BEGIN(); TIDS(); const Params p = LOADP(); mods_phase(p, lds, tid, wave, lane); T_END(0); }
    __syncthreads();
    if (PH(1)) { T_BEGIN(); TIDS(); const Params p = LOADP(); convert_weights(p, 0, lds, gw, NGW, wave, lane); T_END(0); }
    GRID_SYNC_CG();
    { const Params p = LOADP(); if (threadIdx.x == 0) (void)xb_add(&((unsigned*)(p.ws + OFF_BAR))[XB_XCNT(xb_xcc_id())], 1u); }
        CHK(chk_f32(p, (const float*)(p.ws + OFF_MOD), 4 * 2 * 6144, 1, true, tid); chk_bf16(p, (const bf16_t*)(p.ws + OFF_WB), WB_END / 2, 2, true, tid));

#pragma unroll 1
    for (int l = 0; l < DEPTH; ++l) {
        if (PH(1)) if (l > 0) { T_BEGIN(); TIDS(); const Params p = LOADP(); convert_weights(p, l, lds + 65536, gw, NGW, wave, lane); T_END(1); }
        if (PH(2)) { T_BEGIN(); TIDS(); const Params p = LOADP(); norm_phase<true>(p, l, lds, gw, NGW, tid, lane); T_END(1); }
        GRID_SYNC();
        CHK(chk_bf16(p, (const bf16_t*)(p.ws + OFF_H), PLANE, 3, l == 0, tid); chk_f32(p, (const float*)(p.ws + OFF_G), (size_t)T * 16, 4, l == 0, tid));
        if (PH(3)) { T_BEGIN(); TIDS(); const Params p = LOADP(); bf16_t* WB = (bf16_t*)(p.ws + OFF_WB); bf16_t* H = (bf16_t*)(p.ws + OFF_H); bf16_t* Z = (bf16_t*)(p.ws + OFF_Z);
          pg8::Gemm g{H, H, WB + WB_WIN / 2, 1024, 0}; pg8::Sched S; S.init(65, 28, G, bx, 1, 0); EpiZ E{Z, (float*)(p.ws + OFF_SSQ)};
          pg8::gemm_phase<EpiZ>(lds, g, S, E, tid); T_END(2); }
        GRID_SYNC();
        CHK(chk_bf16(p, (const bf16_t*)(p.ws + OFF_Z), 7 * PLANE, 5, l == 0, tid));
        for (int it = bx; it < NCH * 4; it += G) { if (PH(4)) { T_BEGIN(); TIDS(); const Params p = LOADP(); mixA_mlstm(p, l, it >> 2, it & 3, lds, tid, wave, lane); T_END(3); } }
        { const int nA = (G > 8) ? ((G - 8 < NCH * 4) ? G - 8 : NCH * 4) : 0;
          if (bx >= 8 && bx - 8 < nA) { if (PH(5)) { T_BEGIN(); TIDS(); const Params p = LOADP(); const int j = bx - 8; mixA_spatial(p, l, j >> 2, j & 3, lds, tid, wave, lane); T_END(3); } } }
        GRID_SYNC();
        if (PH(6)) { T_BEGIN(); TIDS(); const Params p = LOADP(); scan_phase(p, tid); T_END(4); }
        GRID_SYNC();
        CHK(chk_bf16(p, (const bf16_t*)(p.ws + OFF_ST), (size_t)NCH * 8 * 32768, 11, l == 0, tid); chk_f32(p, (const float*)(p.ws + OFF_NS), (size_t)NCH * 8 * 128, 12, l == 0, tid); chk_f32(p, (const float*)(p.ws + OFF_MP), (size_t)NCH * 8, 13, l == 0, tid));
        if (PH(7)) for (int it = bx + ((l == DEPTH - 1) ? 8 : 0); it < NCH * 4; it += G) { T_BEGIN(); TIDS(); const Params p = LOADP(); mixC_item(p, l, it >> 2, it & 3, lds, tid, wave, lane); T_END(5); }
        { const int nA = (G > 8) ? ((G - 8 < NCH * 4) ? G - 8 : NCH * 4) : 0;
          for (int j = nA + ((bx + G - 32) % G); j < NCH * 4; j += G) { if (PH(5)) { T_BEGIN(); TIDS(); const Params p = LOADP(); mixA_spatial(p, l, j >> 2, j & 3, lds, tid, wave, lane); T_END(5); } } }
        GRID_SYNC();
        CHK(chk_bf16(p, (const bf16_t*)(p.ws + OFF_Z), PLANE, 14, l == 0, tid));
        if (PH(8)) { T_BEGIN(); TIDS(); const Params p = LOADP(); bf16_t* WB = (bf16_t*)(p.ws + OFF_WB); bf16_t* H = (bf16_t*)(p.ws + OFF_H); bf16_t* Z = (bf16_t*)(p.ws + OFF_Z);
          if (l < DEPTH - 1) for (int tile = bx; tile < 256; tile += G) ctx_gemm_tile<0>(Z, H, WB + WB_WPAB / 2, 1024, Z + 5 * PLANE, Z + 6 * PLANE, Z + 3 * PLANE, nullptr, nullptr, lds, tile, tid, wave, lane);
          pg8::Gemm g{Z, H, WB + WB_WPAB / 2, 1024, 4}; pg8::Sched S; S.init(64, 4, G, bx, 2, 1); EpiMerge E{Z + 5 * PLANE, Z + 6 * PLANE, Z + 3 * PLANE};
          pg8::gemm_phase<EpiMerge>(lds, g, S, E, tid); T_END(6); }
        GRID_SYNC();
        CHK(chk_bf16(p, (const bf16_t*)(p.ws + OFF_Z) + 3 * PLANE, PLANE, 15, l == 0, tid));
        if (PH(9)) { T_BEGIN(); TIDS(); const Params p = LOADP(); bf16_t* WB = (bf16_t*)(p.ws + OFF_WB); bf16_t* Z = (bf16_t*)(p.ws + OFF_Z); const float* MOD = (const float*)(p.ws + OFF_MOD); float* CS = (float*)(p.ws + OFF_CS);
          if (l < DEPTH - 1) for (int tile = bx; tile < 256; tile += G) ctx_gemm_tile<1>(Z + 3 * PLANE, Z + 3 * PLANE, WB + WB_WOUT / 2, 1024, nullptr, nullptr, nullptr, CS, MOD + (size_t)(l * 2 + 1) * 6144 + 2048, lds, tile, tid, wave, lane);
          pg8::Gemm g{Z + 3 * PLANE, Z + 3 * PLANE, WB + WB_WOUT / 2, 1024, 0}; pg8::Sched S; S.init(64, 4, G, bx, 1, 1);
          EpiRes E{p.out, CS, MOD + (size_t)(l * 2 + 0) * 6144 + 2048, MOD + (size_t)(l * 2 + 1) * 6144 + 2048};
          pg8::gemm_phase<EpiRes>(lds, g, S, E, tid); T_END(7); }
        GRID_SYNC();
        CHK(chk_f32(p, p.out, (size_t)(T - NCTX) * 1024, 16, l == 0, tid); chk_f32(p, (const float*)(p.ws + OFF_CS), (size_t)NCTX * 1024, 16, l == 0, tid));
        if (PH(10)) { T_BEGIN(); TIDS(); const Params p = LOADP(); norm_phase<false>(p, l, lds, gw, NGW, tid, lane); T_END(8); }
        GRID_SYNC();
        CHK(chk_bf16(p, (const bf16_t*)(p.ws + OFF_H), PLANE, 17, l == 0, tid));
        if (PH(11)) { T_BEGIN(); TIDS(); const Params p = LOADP(); bf16_t* WB = (bf16_t*)(p.ws + OFF_WB); bf16_t* H = (bf16_t*)(p.ws + OFF_H); bf16_t* Z = (bf16_t*)(p.ws + OFF_Z);
          pg8::Gemm g{H, H, WB + WB_W13 / 2, 1024, 0}; pg8::Sched S; S.init(65, 22, G, bx, 1, 0); EpiSwiglu E{Z + PLANE};
          pg8::gemm_phase<EpiSwiglu>(lds, g, S, E, tid); T_END(9); }
        GRID_SYNC();
        CHK(chk_bf16(p, (const bf16_t*)(p.ws + OFF_Z) + PLANE, (size_t)T * DFF, 18, l == 0, tid));
        if (PH(12)) { T_BEGIN(); TIDS(); const Params p = LOADP(); bf16_t* WB = (bf16_t*)(p.ws + OFF_WB); bf16_t* Z = (bf16_t*)(p.ws + OFF_Z); const float* MOD = (const float*)(p.ws + OFF_MOD); float* CS = (float*)(p.ws + OFF_CS);
          if (l < DEPTH - 1) for (int tile = bx; tile < 256; tile += G) ctx_gemm_tile<1>(Z + PLANE, Z + PLANE, WB + WB_W2 / 2, DFF, nullptr, nullptr, nullptr, CS, MOD + (size_t)(l * 2 + 1) * 6144 + 5120, lds, tile, tid, wave, lane);
          pg8::Gemm g{Z + PLANE, Z + PLANE, WB + WB_W2 / 2, DFF, 0}; pg8::Sched S; S.init(64, 4, G, bx, 1, 1);
          EpiRes E{p.out, CS, MOD + (size_t)(l * 2 + 0) * 6144 + 5120, MOD + (size_t)(l * 2 + 1) * 6144 + 5120};
          pg8::gemm_phase<EpiRes>(lds, g, S, E, tid); T_END(10); }
        GRID_SYNC();
        CHK(chk_f32(p, p.out, (size_t)(T - NCTX) * 1024, 19 + l, true, tid));
    }
#ifdef DBG_CHECK
    GRID_SYNC();
    { const Params p = LOADP(); const unsigned f = *(volatile unsigned*)(p.ws + OFF_FLAG);
      if (f != 9999u) { for (size_t i = (size_t)blockIdx.x * NTHREADS + threadIdx.x; i < (size_t)(T - NCTX) * 1024; i += (size_t)gridDim.x * NTHREADS) p.out[i] = 100.0f * (float)f; return; } }
#endif
    if (PH(13)) { T_BEGIN(); TIDS(); const Params p = LOADP(); final_norm(p, gw, NGW, lane); T_END(11); }
#ifdef DBG_TIME
    { const Params p = LOADP(); float* tf = (float*)(p.ws + 300 * 1024);
      if (blockIdx.x == 0 && threadIdx.x == 0) { float x = 0.f, y = 0.f;
          for (int k = 0; k < 13; ++k) { const float us = (float)TACC[k] * 0.01f; if ((DBG_TX >> k) & 1) x += us; if ((DBG_TY >> k) & 1) y += us; }
          tf[0] = x; tf[1] = y; }
      GRID_SYNC();
      const float x = ((volatile float*)tf)[0], y = ((volatile float*)tf)[1];
      for (size_t i = (size_t)blockIdx.x * NTHREADS + threadIdx.x; i < (1u << 20) + 1; i += (size_t)gridDim.x * NTHREADS) p.out[i] += (i == 0) ? x : y; }
#endif
}

extern "C" void kernel_launch(void* const* d_in, const int* in_sizes, int n_in, void* d_out, int out_size, void* d_ws, size_t ws_size, hipStream_t stream) {
    static int grid = 0;
    if (grid == 0) {
        if (n_in != 23 || out_size != (T - NCTX) * D || ws_size < WS_END) { fprintf(stderr, "kernel_launch: unexpected shapes (n_in %d, out %d, ws %zu, need %zu)\n", n_in, out_size, ws_size, (size_t)WS_END); grid = -1; return; }
        int dev = 0, cus = 0, per_cu = 0;
        (void)hipGetDevice(&dev); (void)hipDeviceGetAttribute(&cus, hipDeviceAttributeMultiprocessorCount, dev);
        if (hipFuncSetAttribute((const void*)fwd_megakernel, hipFuncAttributeMaxDynamicSharedMemorySize, LDS_BYTES) != hipSuccess) { fprintf(stderr, "kernel_launch: hipFuncSetAttribute failed\n"); grid = -1; return; }
        if (hipOccupancyMaxActiveBlocksPerMultiprocessor(&per_cu, (const void*)fwd_megakernel, NTHREADS, LDS_BYTES) != hipSuccess || per_cu < 1) { fprintf(stderr, "kernel_launch: occupancy query says %d\n", per_cu); per_cu = 1; }
        (void)hipGetLastError();
        grid = cus;
    }
    if (grid < 0) return;
    Params p{};
    p.x = (const float*)d_in[0]; p.c = (const float*)d_in[1]; p.ctx = (const float*)d_in[2]; p.c_ctx = (const float*)d_in[3]; p.w_ada = (const float*)d_in[4]; p.b_ada = (const float*)d_in[5];
    p.norm1_g = (const float*)d_in[6]; p.norm2_g = (const float*)d_in[7]; p.w_in = (const float*)d_in[8]; p.conv_w = (const float*)d_in[9]; p.conv_b = (const float*)d_in[10]; p.gate_b = (const float*)d_in[11];
    p.head_g = (const float*)d_in[12]; p.vnorm_g = (const float*)d_in[13]; p.w_sp = (const float*)d_in[14]; p.b_sp = (const float*)d_in[15]; p.w_pa = (const float*)d_in[16]; p.w_pb = (const float*)d_in[17];
    p.w_out = (const float*)d_in[18]; p.w_ff1 = (const float*)d_in[19]; p.w_ff3 = (const float*)d_in[20]; p.w_ff2 = (const float*)d_in[21]; p.final_g = (const float*)d_in[22];
    p.out = (float*)d_out; p.ws = (unsigned char*)d_ws;
    void* args[] = {&p};
    hipError_t e = hipLaunchCooperativeKernel((const void*)fwd_megakernel, dim3(grid), dim3(NTHREADS), args, LDS_BYTES, stream);
    if (e != hipSuccess) fprintf(stderr, "kernel_launch: cooperative launch failed: %s (grid %d)\n", hipGetErrorString(e), grid);
}
```

```cpp
#include <hip/hip_runtime.h>
#include <hip/hip_cooperative_groups.h>
#include <cstdio>
namespace cg = cooperative_groups;

#define LAS __attribute__((address_space(3)))
typedef unsigned short bf16_t;
typedef short bf16x8 __attribute__((ext_vector_type(8)));
typedef float f32x4 __attribute__((ext_vector_type(4)));
typedef float f32x2 __attribute__((ext_vector_type(2)));
typedef unsigned u32x4 __attribute__((ext_vector_type(4)));
typedef unsigned u32x2 __attribute__((ext_vector_type(2)));

constexpr int T = 16640, NCTX = 256, D = 1024, NCH = 130, DFF = 2816, INW = 7184, ZW = 7168, DEPTH = 4;
constexpr size_t PLANE = (size_t)T * 1024;
constexpr float EPS = 1e-6f;
constexpr int NTHREADS = 512, NWAVES = 8;
constexpr int LDS_BYTES = 147456;
#ifndef PH_MASK
#define PH_MASK 0xFFFFF
#endif
#define PH(k) ((PH_MASK >> (k)) & 1)

constexpr size_t MiB = 1u << 20;
constexpr size_t OFF_MOD = 0;
constexpr size_t OFF_SC = 256 * 1024;
constexpr size_t OFF_MP = 256 * 1024 + 16 * 1024;
constexpr size_t OFF_NS = 320 * 1024;
constexpr size_t OFF_G = 1 * MiB;
constexpr size_t OFF_CS = 3 * MiB;
constexpr size_t OFF_WB = 4 * MiB;
constexpr size_t WB_WIN = 0, WB_WPAB = (size_t)ZW * 1024 * 2, WB_WOUT = WB_WPAB + (size_t)2048 * 1024 * 2, WB_W13 = WB_WOUT + (size_t)1024 * 1024 * 2,
                 WB_W2 = WB_W13 + (size_t)5632 * 1024 * 2, WB_END = WB_W2 + (size_t)1024 * 2816 * 2;
static_assert(WB_END <= 37 * MiB, "wb");
constexpr size_t OFF_H = 41 * MiB;
constexpr size_t OFF_QK = 74 * MiB;
constexpr size_t OFF_ST = 107 * MiB;
constexpr size_t OFF_Z = 172 * MiB;
constexpr size_t OFF_SSQ = 400 * MiB;
constexpr size_t WS_END = OFF_SSQ + 2 * MiB;
static_assert(OFF_Z + 7 * PLANE * 2 <= OFF_SSQ, "ws map 2");
static_assert(OFF_H + PLANE * 2 <= OFF_QK && OFF_QK + PLANE * 2 <= OFF_ST && OFF_ST + (size_t)NCH * 8 * 32768 * 2 <= OFF_Z, "ws map");

struct Params {
    const float *x, *c, *ctx, *c_ctx, *w_ada, *b_ada, *norm1_g, *norm2_g, *w_in, *conv_w, *conv_b, *gate_b, *head_g, *vnorm_g, *w_sp, *b_sp, *w_pa, *w_pb, *w_out, *w_ff1, *w_ff3, *w_ff2, *final_g;
    float* out; unsigned char* ws;
};

__device__ __forceinline__ float bf_lo(unsigned w) { return __uint_as_float(w << 16); }
__device__ __forceinline__ float bf_hi(unsigned w) { return __uint_as_float(w & 0xffff0000u); }
typedef __bf16 bf16v2_t __attribute__((ext_vector_type(2)));
__device__ __forceinline__ unsigned cvt_pk_bf16(float lo, float hi) { const f32x2 v = {lo, hi}; const bf16v2_t b = __builtin_convertvector(v, bf16v2_t); return __builtin_bit_cast(unsigned, b); }
__device__ __forceinline__ float wave_sum(float v) {
#pragma unroll
    for (int o = 1; o < 64; o <<= 1) v += __shfl_xor(v, o);
    return v;
}
__device__ __forceinline__ float wave_max(float v) {
#pragma unroll
    for (int o = 1; o < 64; o <<= 1) v = fmaxf(v, __shfl_xor(v, o));
    return v;
}
__device__ __forceinline__ float sigmoidf_(float x) { return __builtin_amdgcn_rcpf(1.0f + __expf(-x)); }
__device__ __forceinline__ float siluf_(float x) { return x * __builtin_amdgcn_rcpf(1.0f + __expf(-x)); }
__device__ __forceinline__ float geluf_(float x) {
    const float y2 = 1.5957691216057308f * (x + 0.044715f * x * x * x);
    return x * __builtin_amdgcn_rcpf(1.0f + __expf(-y2));
}
__device__ __forceinline__ float logsigf_(float x) { return fminf(x, 0.0f) - log1pf(__expf(-fabsf(x))); }
#define LDS_WAIT() asm volatile("s_waitcnt lgkmcnt(0)" ::: "memory")

namespace pg8 {
constexpr int BM = 256, BK = 64, HALF = 128, HTB = HALF * BK * 2, STAGE_BYTES = 8 * HTB, NXCD = 8, WGM = 8;
__host__ __device__ __forceinline__ int lds_byte(int r, int c) { const int st = (r >> 4) * 2 + (c >> 5), rr = r & 15, cc = c & 31, ob = rr * 64 + cc * 2; return st * 1024 + (ob ^ (((ob >> 9) & 1) << 5)); }
__host__ __device__ __forceinline__ void stage_rc(int b, int& R, int& C) { const int st = b / 1024, sb = b % 1024, swz = sb ^ (((sb >> 9) & 1) << 5); R = (st >> 1) * 16 + swz / 64; C = (st & 1) * 32 + (swz % 64) / 2; }
__host__ __device__ __forceinline__ int perm32(int rho) { const int n = rho >> 4, i = rho & 15; return 8 * (i >> 2) + 4 * n + (i & 3); }

struct Unit { int pm, pn, seg; };
struct Gemm { const bf16_t* A0; const bf16_t* A1; const bf16_t* Bt; int K; int seg_pn_off; };
struct Sched {
    int nM, nN, nwg, G, c, nseg, pm0;
    __device__ void init(int nM_, int nN_, int G_, int c_, int nseg_, int pm0_) { nM = nM_; nN = nN_; nwg = nM * nN; G = G_; c = c_; nseg = nseg_; pm0 = pm0_; }
    __device__ bool next(int i, Unit& u) const {
        const int ii = i / nseg; u.seg = i - ii * nseg;
        const long L = (long)ii * G + c; if (L >= nwg) return false;
        int wgid = (int)L; { const int q = nwg / NXCD, r = nwg % NXCD, xcd = wgid % NXCD, off = wgid / NXCD; wgid = (xcd < r ? xcd * (q + 1) : r * (q + 1) + (xcd - r) * q) + off; }
        const int nig = WGM * nN, gid = wgid / nig, fm = gid * WGM, gsz = (nM - fm) < WGM ? (nM - fm) : WGM;
        u.pm = pm0 + fm + ((wgid % nig) % gsz); u.pn = (wgid % nig) / gsz; return true;
    }
};

template <class Epi>
__device__ __forceinline__ void gemm_phase(LAS unsigned char* lds, const Gemm g, const Sched& S, const Epi& E, const int tid) {
    const int wid = __builtin_amdgcn_readfirstlane(tid >> 6), lane = tid & 63, wr = wid >> 2, wc = wid & 3, fr = lane & 15, fq = lane >> 4;
    const int K = g.K, nt = K / BK;
    unsigned voffA[2], voffB[2];
#pragma unroll
    for (int i = 0; i < 2; ++i) { int R, C; stage_rc(tid * 16 + i * 8192, R, C); const int Rb = Epi::PERM ? ((R & ~31) + perm32(R & 31)) : R;
        voffA[i] = (unsigned)(R * K + C) * 2u; voffB[i] = (unsigned)(Rb * K + C) * 2u; }
    const size_t kstep = (size_t)(BK * 2);
    const size_t hstep = (size_t)HALF * K * 2;
    const size_t tstep = 2 * hstep;
    const unsigned ldsw = (unsigned)wid * 1024u;
    const int aoff = lds_byte(wr * 64 + fr, fq * 8), boff = lds_byte(wc * 32 + fr, fq * 8);
#define PG8_SA(b, h) (((b) * 2 + (h)) * HTB)
#define PG8_SB(b, h) ((4 + (b) * 2 + (h)) * HTB)
#define PG8_STAGE(bufoff, gbase, voff) do { _Pragma("unroll") for (int _i = 0; _i < 2; ++_i) \
        __builtin_amdgcn_global_load_lds((const unsigned*)((const char*)(gbase) + (voff)[_i]), (LAS unsigned*)(lds + (bufoff) + ldsw + _i * 8192), 16, 0, 0); } while (0)
#define PG8_LDA(dst, b, h) do { _Pragma("unroll") for (int m = 0; m < 4; ++m) _Pragma("unroll") for (int k = 0; k < 2; ++k) dst[m][k] = *(const LAS bf16x8*)(lds + PG8_SA(b, h) + aoff + m * 2048 + k * 1024); } while (0)
#define PG8_LDB(dst, b, h) do { _Pragma("unroll") for (int n = 0; n < 2; ++n) _Pragma("unroll") for (int k = 0; k < 2; ++k) dst[n][k] = *(const LAS bf16x8*)(lds + PG8_SB(b, h) + boff + n * 2048 + k * 1024); } while (0)
#define PG8_MMA(ai, bj, At, Bt) do { __builtin_amdgcn_s_setprio(1); _Pragma("unroll") for (int m = 0; m < 4; ++m) _Pragma("unroll") for (int n = 0; n < 2; ++n) _Pragma("unroll") for (int k = 0; k < 2; ++k) \
        acc[ai][bj][m][n] = __builtin_amdgcn_mfma_f32_16x16x32_bf16(Bt[n][k], At[m][k], acc[ai][bj][m][n], 0, 0, 0); __builtin_amdgcn_s_setprio(0); } while (0)
#define PG8_WAIT_V(n) asm volatile("s_waitcnt vmcnt(" #n ")" ::: "memory")
#define PG8_WAIT_L(n) asm volatile("s_waitcnt lgkmcnt(" #n ")" ::: "memory")
#define PG8_BAR __builtin_amdgcn_s_barrier()
#define PG8_SCHED __builtin_amdgcn_sched_barrier(0)
    Unit cur, nxt; int ui = 0;
    if (!S.next(0, cur)) return;
    f32x4 acc[2][2][4][2];
#pragma unroll
    for (int a = 0; a < 2; ++a)
#pragma unroll
        for (int b = 0; b < 2; ++b)
#pragma unroll
            for (int m = 0; m < 4; ++m)
#pragma unroll
                for (int n = 0; n < 2; ++n) acc[a][b][m][n] = (f32x4){0.f, 0.f, 0.f, 0.f};
    bf16x8 At[4][2], B0[2][2], B1[2][2];
    const char* cA = (const char*)(cur.seg ? g.A1 : g.A0) + (size_t)cur.pm * tstep; const char* cB = (const char*)g.Bt + (size_t)(cur.pn + cur.seg * g.seg_pn_off) * tstep;
    PG8_STAGE(PG8_SB(0, 0), cB, voffB); PG8_STAGE(PG8_SA(0, 0), cA, voffA); PG8_STAGE(PG8_SB(0, 1), cB + hstep, voffB); PG8_STAGE(PG8_SA(0, 1), cA + hstep, voffA);
    if (wr == 1) PG8_BAR;
    PG8_WAIT_V(4); PG8_BAR;
    PG8_STAGE(PG8_SB(1, 0), cB + kstep, voffB); PG8_STAGE(PG8_SA(1, 0), cA + kstep, voffA); PG8_STAGE(PG8_SB(1, 1), cB + hstep + kstep, voffB);
    PG8_WAIT_V(6); PG8_BAR;
    for (;;) {
        const bool has_next = S.next(ui + 1, nxt);
        const char* nA = has_next ? (const char*)(nxt.seg ? g.A1 : g.A0) + (size_t)nxt.pm * tstep : cA;
        const char* nB = has_next ? (const char*)g.Bt + (size_t)(nxt.pn + nxt.seg * g.seg_pn_off) * tstep : cB;
        for (int t = 0; t < nt; t += 2) {
            const bool last = (t == nt - 2);
            const char* a1 = cA + (size_t)(t + 1) * kstep;
            const char* a2 = last ? nA : cA + (size_t)(t + 2) * kstep; const char* b2 = last ? nB : cB + (size_t)(t + 2) * kstep;
            const char* a3 = a2 + kstep; const char* b3 = b2 + kstep;
            PG8_LDB(B0, 0, 0); PG8_SCHED; PG8_LDA(At, 0, 0); PG8_STAGE(PG8_SA(1, 1), a1 + hstep, voffA);
            PG8_WAIT_L(8); PG8_BAR; PG8_WAIT_L(0); PG8_MMA(0, 0, At, B0); PG8_BAR; PG8_SCHED;
            PG8_LDB(B1, 0, 1); PG8_STAGE(PG8_SB(0, 0), b2, voffB);
            PG8_BAR; PG8_WAIT_L(0); PG8_MMA(0, 1, At, B1); PG8_BAR;
            PG8_LDA(At, 0, 1); PG8_STAGE(PG8_SA(0, 0), a2, voffA);
            PG8_BAR; PG8_WAIT_L(0); PG8_MMA(1, 0, At, B0); PG8_BAR; PG8_SCHED;
            PG8_STAGE(PG8_SB(0, 1), b2 + hstep, voffB);
            PG8_WAIT_V(6); PG8_BAR; PG8_MMA(1, 1, At, B1); PG8_BAR;
            PG8_LDB(B0, 1, 0); PG8_SCHED; PG8_LDA(At, 1, 0); PG8_STAGE(PG8_SA(0, 1), a2 + hstep, voffA);
            PG8_WAIT_L(8); PG8_BAR; PG8_WAIT_L(0); PG8_MMA(0, 0, At, B0); PG8_BAR; PG8_SCHED;
            PG8_LDB(B1, 1, 1); PG8_STAGE(PG8_SB(1, 0), b3, voffB);
            PG8_BAR; PG8_WAIT_L(0); PG8_MMA(0, 1, At, B1); PG8_BAR;
            PG8_LDA(At, 1, 1); PG8_STAGE(PG8_SA(1, 0), a3, voffA);
            PG8_BAR; PG8_WAIT_L(0); PG8_MMA(1, 0, At, B0); PG8_BAR; PG8_SCHED;
            PG8_STAGE(PG8_SB(1, 1), b3 + hstep, voffB);
            PG8_WAIT_V(6); PG8_BAR; PG8_MMA(1, 1, At, B1); PG8_BAR;
        }
        const bool zero = E(acc, cur, wr, wc, fr, fq);
        if (!has_next) break;
        if (zero) {
#pragma unroll
            for (int a = 0; a < 2; ++a)
#pragma unroll
                for (int b = 0; b < 2; ++b)
#pragma unroll
                    for (int m = 0; m < 4; ++m)
#pragma unroll
                        for (int n = 0; n < 2; ++n) acc[a][b][m][n] = (f32x4){0.f, 0.f, 0.f, 0.f};
        }
        cur = nxt; cA = nA; cB = nB; ++ui;
    }
    PG8_WAIT_V(0);
    if (wr == 0) PG8_BAR;
    PG8_BAR;
#undef PG8_SA
#undef PG8_SB
#undef PG8_STAGE
#undef PG8_LDA
#undef PG8_LDB
#undef PG8_MMA
#undef PG8_WAIT_V
#undef PG8_WAIT_L
#undef PG8_BAR
#undef PG8_SCHED
}
}

typedef f32x4 AccT[2][2][4][2];
struct EpiZ {
    static constexpr bool PERM = true;
    bf16_t* Z; float* SSQP;
    __device__ __forceinline__ bool operator()(AccT& acc, const pg8::Unit& u, int wr, int wc, int fr, int fq) const {
        const int row0 = u.pm * 256 + wr * 64 + fr; const int colt = u.pn * 256; const int plane = colt >> 10;
        bf16_t* base = Z + (size_t)plane * PLANE + (colt & 1023) + wc * 32 + 8 * fq;
        const bool act = (plane == 3) || (plane == 4);
#pragma unroll
        for (int ai = 0; ai < 2; ++ai)
#pragma unroll
            for (int m = 0; m < 4; ++m) { const int row = row0 + ai * 128 + m * 16; bf16_t* rowp = base + (size_t)row * 1024; float ss = 0.f;
#pragma unroll
                for (int bj = 0; bj < 2; ++bj) { f32x4 v0 = acc[ai][bj][m][0], v1 = acc[ai][bj][m][1];
                    if (act) {
#pragma unroll
                        for (int j = 0; j < 4; ++j) { v0[j] = geluf_(v0[j]); v1[j] = geluf_(v1[j]); ss += v0[j] * v0[j] + v1[j] * v1[j]; } }
                    u32x4 w; w.x = cvt_pk_bf16(v0[0], v0[1]); w.y = cvt_pk_bf16(v0[2], v0[3]); w.z = cvt_pk_bf16(v1[0], v1[1]); w.w = cvt_pk_bf16(v1[2], v1[3]);
                    *(u32x4*)(rowp + bj * 128) = w; }
                if (plane == 4) { ss += __shfl_xor(ss, 16); ss += __shfl_xor(ss, 32); if (fq == 0) SSQP[(size_t)row * 16 + (u.pn & 3) * 4 + wc] = ss; } }
        return true;
    }
};
struct EpiMerge {
    static constexpr bool PERM = true;
    const bf16_t* GA; const bf16_t* GB; bf16_t* O;
    __device__ __forceinline__ bool operator()(AccT& acc, const pg8::Unit& u, int wr, int wc, int fr, int fq) const {
        const int row0 = u.pm * 256 + wr * 64 + fr; const int col0 = u.pn * 256 + wc * 32 + 8 * fq;
#pragma unroll
        for (int ai = 0; ai < 2; ++ai)
#pragma unroll
            for (int m = 0; m < 4; ++m) { const size_t ro = (size_t)(row0 + ai * 128 + m * 16) * 1024 + col0;
#pragma unroll
                for (int bj = 0; bj < 2; ++bj) {
                    const u32x4 gb = *(const u32x4*)(GB + ro + bj * 128);
                    float b[8] = {bf_lo(gb.x), bf_hi(gb.x), bf_lo(gb.y), bf_hi(gb.y), bf_lo(gb.z), bf_hi(gb.z), bf_lo(gb.w), bf_hi(gb.w)};
                    if (u.seg == 0) {
                        const u32x4 ga = *(const u32x4*)(GA + ro + bj * 128);
                        float a[8] = {bf_lo(ga.x), bf_hi(ga.x), bf_lo(ga.y), bf_hi(ga.y), bf_lo(ga.z), bf_hi(ga.z), bf_lo(ga.w), bf_hi(ga.w)};
#pragma unroll
                        for (int j = 0; j < 8; ++j) { const float r = sigmoidf_(a[j]) * (1.0f + __expf(-b[j])); acc[ai][bj][m][j >> 2][j & 3] *= r; }
                    } else {
                        float v[8];
#pragma unroll
                        for (int j = 0; j < 8; ++j) v[j] = acc[ai][bj][m][j >> 2][j & 3] * sigmoidf_(b[j]);
                        u32x4 w; w.x = cvt_pk_bf16(v[0], v[1]); w.y = cvt_pk_bf16(v[2], v[3]); w.z = cvt_pk_bf16(v[4], v[5]); w.w = cvt_pk_bf16(v[6], v[7]);
                        *(u32x4*)(O + ro + bj * 128) = w;
                    }
                } }
        return u.seg != 0;
    }
};
struct EpiRes {
    static constexpr bool PERM = false;
    float* out; float* cs; const float* gx; const float* gc;
    __device__ __forceinline__ bool operator()(AccT& acc, const pg8::Unit& u, int wr, int wc, int fr, int fq) const {
        const bool isc = (u.pm == 0);
        float* base = isc ? cs : out - (size_t)NCTX * 1024; const float* gv = isc ? gc : gx;
        const int row0 = u.pm * 256 + wr * 64 + fr, col0 = u.pn * 256 + wc * 32 + 4 * fq;
        f32x4 g4[2][2];
#pragma unroll
        for (int bj = 0; bj < 2; ++bj)
#pragma unroll
            for (int n = 0; n < 2; ++n) g4[bj][n] = *(const f32x4*)(gv + col0 + bj * 128 + n * 16);
#pragma unroll
        for (int ai = 0; ai < 2; ++ai)
#pragma unroll
            for (int m = 0; m < 4; ++m) { float* rowp = base + (size_t)(row0 + ai * 128 + m * 16) * 1024 + col0;
#pragma unroll
                for (int bj = 0; bj < 2; ++bj)
#pragma unroll
                    for (int n = 0; n < 2; ++n) { f32x4* p = (f32x4*)(rowp + bj * 128 + n * 16); *p = *p + g4[bj][n] * acc[ai][bj][m][n]; } }
        return true;
    }
};
struct EpiSwiglu {
    static constexpr bool PERM = true;
    bf16_t* FM;
    __device__ __forceinline__ bool operator()(AccT& acc, const pg8::Unit& u, int wr, int wc, int fr, int fq) const {
        const int row0 = u.pm * 256 + wr * 64 + fr, col0 = u.pn * 128 + wc * 32 + 8 * fq;
#pragma unroll
        for (int ai = 0; ai < 2; ++ai)
#pragma unroll
            for (int m = 0; m < 4; ++m) {
                float v[8];
#pragma unroll
                for (int j = 0; j < 8; ++j) v[j] = siluf_(acc[ai][0][m][j >> 2][j & 3]) * acc[ai][1][m][j >> 2][j & 3];
                u32x4 w; w.x = cvt_pk_bf16(v[0], v[1]); w.y = cvt_pk_bf16(v[2], v[3]); w.z = cvt_pk_bf16(v[4], v[5]); w.w = cvt_pk_bf16(v[6], v[7]);
                *(u32x4*)(FM + (size_t)(row0 + ai * 128 + m * 16) * DFF + col0) = w; }
        return true;
    }
};

__device__ __forceinline__ void transpose_item(const float* W, int ldw, int src_col0, int k0, bf16_t* WT, int K, int dst_row0, LAS float* scr, int lane) {
    float tv[32];
#pragma unroll
    for (int i = 0; i < 32; ++i) { const int kk = 2 * i + (lane >> 5); tv[i] = W[(size_t)(k0 + kk) * ldw + src_col0 + (lane & 31)]; }
#pragma unroll
    for (int i = 0; i < 32; ++i) { const int kk = 2 * i + (lane >> 5); scr[kk * 33 + (lane & 31)] = tv[i]; }
    LDS_WAIT();
    const int c = lane & 7;
#pragma unroll
    for (int j = 0; j < 4; ++j) { const int n = (lane >> 3) + 8 * j; const LAS float* s = scr + (8 * c) * 33 + n;
        u32x4 o; o.x = cvt_pk_bf16(s[0 * 33], s[1 * 33]); o.y = cvt_pk_bf16(s[2 * 33], s[3 * 33]); o.z = cvt_pk_bf16(s[4 * 33], s[5 * 33]); o.w = cvt_pk_bf16(s[6 * 33], s[7 * 33]);
        *(u32x4*)(WT + (size_t)(dst_row0 + n) * K + k0 + 8 * c) = o; }
    LDS_WAIT();
}
__device__ __forceinline__ void convert_weights(const Params& p, int l, LAS unsigned char* lds_scr, int gw, int NGW, int wave, int lane) {
    LAS float* scr = (LAS float*)(lds_scr + wave * 8448);
    bf16_t* wb = (bf16_t*)(p.ws + OFF_WB);
    constexpr int I_IN = 16 * 224, I_SQ = 16 * 32, I_F = 16 * 88, I_2 = 44 * 32;
    constexpr int NIT = I_IN + 3 * I_SQ + 2 * I_F + I_2;
    for (int it = gw; it < NIT; it += NGW) {
        int r = it;
        if (r < I_IN) { const int kb = r / 224, nb = r % 224; const int dc = nb * 32; const int sc = dc + (dc >= 3072 ? 16 : 0);
            transpose_item(p.w_in + (size_t)l * 1024 * INW, INW, sc, kb * 64, wb + WB_WIN / 2, 1024, dc, scr, lane); continue; } r -= I_IN;
        if (r < I_SQ) { const int kb = r / 32, nb = r % 32; transpose_item(p.w_pa + (size_t)l * 1024 * 1024, 1024, nb * 32, kb * 64, wb + WB_WPAB / 2, 1024, nb * 32, scr, lane); continue; } r -= I_SQ;
        if (r < I_SQ) { const int kb = r / 32, nb = r % 32; transpose_item(p.w_pb + (size_t)l * 1024 * 1024, 1024, nb * 32, kb * 64, wb + WB_WPAB / 2, 1024, 1024 + nb * 32, scr, lane); continue; } r -= I_SQ;
        if (r < I_SQ) { const int kb = r / 32, nb = r % 32; transpose_item(p.w_out + (size_t)l * 1024 * 1024, 1024, nb * 32, kb * 64, wb + WB_WOUT / 2, 1024, nb * 32, scr, lane); continue; } r -= I_SQ;
        if (r < I_F) { const int kb = r / 88, nb = r % 88; const int j0 = nb * 32; transpose_item(p.w_ff1 + (size_t)l * 1024 * DFF, DFF, j0, kb * 64, wb + WB_W13 / 2, 1024, 256 * (j0 >> 7) + (j0 & 127), scr, lane); continue; } r -= I_F;
        if (r < I_F) { const int kb = r / 88, nb = r % 88; const int j0 = nb * 32; transpose_item(p.w_ff3 + (size_t)l * 1024 * DFF, DFF, j0, kb * 64, wb + WB_W13 / 2, 1024, 256 * (j0 >> 7) + 128 + (j0 & 127), scr, lane); continue; } r -= I_F;
        { const int kb = r / 32, nb = r % 32; transpose_item(p.w_ff2 + (size_t)l * DFF * 1024, 1024, nb * 32, kb * 64, wb + WB_W2 / 2, DFF, nb * 32, scr, lane); }
    }
}

__device__ __forceinline__ void mods_phase(const Params& p, LAS unsigned char* lds, int tid, int wave, int lane) {
    LAS float* sc = (LAS float*)lds; LAS float* scc = sc + 1024; LAS float* red = scc + 1024;
    float* MOD = (float*)(p.ws + OFF_MOD);
    for (int i = tid; i < 1024; i += NTHREADS) { sc[i] = siluf_(p.c[i]); scc[i] = siluf_(p.c_ctx[i]); }
    __syncthreads();
    for (int item = blockIdx.x; item < 4 * 96; item += gridDim.x) {
        const int l = item / 96, col = (item % 96) * 64 + lane;
        const float* w = p.w_ada + (size_t)l * 1024 * 6144 + col;
        float ax = 0.f, ac = 0.f;
#pragma unroll 8
        for (int d = wave * 128; d < wave * 128 + 128; ++d) { const float wv = w[(size_t)d * 6144]; ax += sc[d] * wv; ac += scc[d] * wv; }
        red[(wave * 64 + lane) * 2] = ax; red[(wave * 64 + lane) * 2 + 1] = ac;
        __syncthreads();
        if (wave == 0) { float sx = 0.f, s2 = 0.f;
#pragma unroll
            for (int w8 = 0; w8 < 8; ++w8) { sx += red[(w8 * 64 + lane) * 2]; s2 += red[(w8 * 64 + lane) * 2 + 1]; }
            const float b = p.b_ada[l * 6144 + col];
            MOD[(size_t)(l * 2 + 0) * 6144 + col] = sx + b; MOD[(size_t)(l * 2 + 1) * 6144 + col] = s2 + b; }
        __syncthreads();
    }
}

template <bool GATES>
__device__ __forceinline__ void norm_phase(const Params& p, int l, LAS unsigned char* lds, int gw, int NGW, int tid, int lane) {
    const float* MOD = (const float*)(p.ws + OFF_MOD);
    float* CS = (float*)(p.ws + OFF_CS); bf16_t* H = (bf16_t*)(p.ws + OFF_H); float* G = (float*)(p.ws + OFF_G);
    const float* ng = (GATES ? p.norm1_g : p.norm2_g) + l * 1024;
    LAS float* wg = (LAS float*)lds;
    if (GATES) {
        const float* wsrc = p.w_in + (size_t)l * 1024 * INW + 3072;
        for (int i = tid; i < 16384; i += NTHREADS) { const int k = i >> 4, j = i & 15; wg[j * 1024 + k] = wsrc[(size_t)k * INW + j]; }
        __syncthreads();
    }
    const bool first = GATES && (l == 0);
    const bool spread = (NGW >= 64 * 32);
    const int n_lat = (T / 4 - 64 - gw + NGW - 1) / NGW;
    const int has_ctx = spread ? (((gw & 31) == 0 && (gw >> 5) < 64) ? 1 : 0) : 0;
    const int n_it = spread ? n_lat + has_ctx : (T / 4 - gw + NGW - 1) / NGW;
    for (int it = 0; it < n_it; ++it) {
        const int grp = spread ? ((it < n_lat) ? 64 + gw + it * NGW : (gw >> 5)) : gw + it * NGW;
        const int row0 = grp * 4; const bool isc = row0 < NCTX;
        const float* modp = MOD + (size_t)(l * 2 + (isc ? 1 : 0)) * 6144 + (GATES ? 0 : 3072);
        f32x4 gm[4], sh[4];
#pragma unroll
        for (int j = 0; j < 4; ++j) { const int col = 4 * lane + 256 * j; const f32x4 g4 = *(const f32x4*)(ng + col); const f32x4 s4 = *(const f32x4*)(modp + 1024 + col);
            sh[j] = *(const f32x4*)(modp + col); gm[j] = g4 * (s4 + 1.0f); }
        f32x4 xv[4][4];
#pragma unroll
        for (int r = 0; r < 4; ++r) {
            const int row = row0 + r;
            const float* src = first ? (isc ? p.ctx + (size_t)row * 1024 : p.x + (size_t)(row - NCTX) * 1024) : (isc ? CS + (size_t)row * 1024 : p.out + (size_t)(row - NCTX) * 1024);
#pragma unroll
            for (int j = 0; j < 4; ++j) xv[r][j] = *(const f32x4*)(src + 4 * lane + 256 * j);
        }
        if (first) {
#pragma unroll
            for (int r = 0; r < 4; ++r) { const int row = row0 + r; float* dst = isc ? CS + (size_t)row * 1024 : p.out + (size_t)(row - NCTX) * 1024;
#pragma unroll
                for (int j = 0; j < 4; ++j) *(f32x4*)(dst + 4 * lane + 256 * j) = xv[r][j]; }
        }
#pragma unroll
        for (int r = 0; r < 4; ++r) {
            float s = 0.f;
#pragma unroll
            for (int j = 0; j < 4; ++j) s += (xv[r][j][0] * xv[r][j][0] + xv[r][j][1] * xv[r][j][1]) + (xv[r][j][2] * xv[r][j][2] + xv[r][j][3] * xv[r][j][3]);
            const float rstd = rsqrtf(wave_sum(s) * (1.0f / 1024.0f) + EPS);
            bf16_t* hrow = H + (size_t)(row0 + r) * 1024;
#pragma unroll
            for (int j = 0; j < 4; ++j) { xv[r][j] = xv[r][j] * rstd * gm[j] + sh[j];
                u32x2 w; w.x = cvt_pk_bf16(xv[r][j][0], xv[r][j][1]); w.y = cvt_pk_bf16(xv[r][j][2], xv[r][j][3]);
                *(u32x2*)(hrow + 4 * lane + 256 * j) = w; }
        }
        if (GATES) {
            float v[64];
#pragma unroll
            for (int i = 0; i < 64; ++i) v[i] = 0.f;
#pragma unroll
            for (int gi = 0; gi < 16; ++gi) {
                if ((gi & 1) == 0) asm volatile("" ::: "memory");
#pragma unroll
                for (int j = 0; j < 4; ++j) { const f32x4 w4 = *(const LAS f32x4*)(wg + gi * 1024 + 4 * lane + 256 * j);
#pragma unroll
                    for (int r = 0; r < 4; ++r) v[r * 16 + gi] += (xv[r][j][0] * w4[0] + xv[r][j][1] * w4[1]) + (xv[r][j][2] * w4[2] + xv[r][j][3] * w4[3]); } }
#pragma unroll
            for (int i = 0; i < 32; ++i) { const bool hi = (lane & 32) != 0; const float keep = hi ? v[i + 32] : v[i]; const float send = hi ? v[i] : v[i + 32]; v[i] = keep + __shfl_xor(send, 32); }
#pragma unroll
            for (int i = 0; i < 16; ++i) { const bool hi = (lane & 16) != 0; const float keep = hi ? v[i + 16] : v[i]; const float send = hi ? v[i] : v[i + 16]; v[i] = keep + __shfl_xor(send, 16); }
#pragma unroll
            for (int i = 0; i < 8; ++i) { const bool hi = (lane & 8) != 0; const float keep = hi ? v[i + 8] : v[i]; const float send = hi ? v[i] : v[i + 8]; v[i] = keep + __shfl_xor(send, 8); }
#pragma unroll
            for (int i = 0; i < 4; ++i) { const bool hi = (lane & 4) != 0; const float keep = hi ? v[i + 4] : v[i]; const float send = hi ? v[i] : v[i + 4]; v[i] = keep + __shfl_xor(send, 4); }
#pragma unroll
            for (int i = 0; i < 2; ++i) { const bool hi = (lane & 2) != 0; const float keep = hi ? v[i + 2] : v[i]; const float send = hi ? v[i] : v[i + 2]; v[i] = keep + __shfl_xor(send, 2); }
            { const bool hi = (lane & 1) != 0; const float keep = hi ? v[1] : v[0]; const float send = hi ? v[0] : v[1]; v[0] = keep + __shfl_xor(send, 1); }
            const int gate = lane & 15;
            float val = v[0] + p.gate_b[l * 16 + gate];
            if (gate & 4) val = logsigf_(val);
            G[(size_t)row0 * 16 + lane] = val;
        }
    }
}

__device__ __forceinline__ void final_norm(const Params& p, int gw, int NGW, int lane) {
    f32x4 g4[4];
#pragma unroll
    for (int j = 0; j < 4; ++j) g4[j] = *(const f32x4*)(p.final_g + 4 * lane + 256 * j);
    for (int row = gw; row < T - NCTX; row += NGW) {
        float* rp = p.out + (size_t)row * 1024; f32x4 xv[4]; float s = 0.f;
#pragma unroll
        for (int j = 0; j < 4; ++j) { xv[j] = *(const f32x4*)(rp + 4 * lane + 256 * j); s += (xv[j][0] * xv[j][0] + xv[j][1] * xv[j][1]) + (xv[j][2] * xv[j][2] + xv[j][3] * xv[j][3]); }
        const float rstd = rsqrtf(wave_sum(s) * (1.0f / 1024.0f) + EPS);
#pragma unroll
        for (int j = 0; j < 4; ++j) { f32x4 o = xv[j] * rstd * g4[j];
#ifdef DBG_SANITIZE
#pragma unroll
            for (int e = 0; e < 4; ++e) if (!(fabsf(o[e]) < 1e30f)) o[e] = 10000.0f;
#endif
            *(f32x4*)(rp + 4 * lane + 256 * j) = o; }
    }
}

constexpr size_t OFF_FLAG = 300 * 1024;
#define FLAGBAD(cond, code) do { if (cond) atomicMin((unsigned*)(p.ws + OFF_FLAG), (unsigned)(code)); } while (0)
constexpr int LROW = 272;
__device__ __forceinline__ float wave_incl_sum(float v, int lane) {
#pragma unroll
    for (int o = 1; o < 64; o <<= 1) { const float t = __shfl_up(v, o); if (lane >= o) v += t; }
    return v;
}
__device__ __forceinline__ float wave_incl_max(float v, int lane) {
#pragma unroll
    for (int o = 1; o < 64; o <<= 1) { const float t = __shfl_up(v, o); if (lane >= o) v = fmaxf(v, t); }
    return v;
}

__device__ __forceinline__ void mixA_mlstm(const Params& p, int l, int c, int h, LAS unsigned char* lds, int tid, int wave, int lane) {
    const int fr = lane & 15, fq = lane >> 4;
    bf16_t* Z = (bf16_t*)(p.ws + OFF_Z); bf16_t* QK = (bf16_t*)(p.ws + OFF_QK); bf16_t* ST = (bf16_t*)(p.ws + OFF_ST);
    const float* G = (const float*)(p.ws + OFF_G); float* SC = (float*)(p.ws + OFF_SC); float* NS = (float*)(p.ws + OFF_NS);
    LAS unsigned char* KT = lds; LAS unsigned char* VT = lds + 128 * LROW;
    LAS float* wsrc = (LAS float*)(lds + 384 * LROW); LAS float* red = wsrc + 256;
    const int t0 = c * 128; const int seq_lo = (c < 2) ? 0 : NCTX, seq_hi = (c < 2) ? NCTX : T;
    const int gdir = wave & 1;
    const int gr0 = gdir ? 127 - 2 * lane : 2 * lane, gr1 = gdir ? gr0 - 1 : gr0 + 1;
    const float* gpp = G + (size_t)t0 * 16 + gdir * 8 + h;
    const float gi0 = gpp[gr0 * 16], gf0 = gpp[gr0 * 16 + 4], gi1 = gpp[gr1 * 16], gf1 = gpp[gr1 * 16 + 4];
    const float* cw = p.conv_w + (size_t)l * 5 * 1024; const float* cb_ = p.conv_b + (size_t)l * 1024;
#pragma unroll 1
    for (int qk = 0; qk < 2; ++qk) {
        const int tg = tid >> 4, cb = tid & 15;
        const int ch = qk * 512 + h * 128 + cb * 8;
        u32x4 rr[8];
#pragma unroll
        for (int i = 0; i < 8; ++i) { const int tt = t0 + tg * 4 - 2 + i; const int ttc = tt < seq_lo ? seq_lo : (tt >= seq_hi ? seq_hi - 1 : tt);
            rr[i] = *(const u32x4*)(Z + (size_t)ttc * 1024 + ch); }
        float wv[5][8], bv[8];
#pragma unroll
        for (int j = 0; j < 5; ++j) { const f32x4 a = *(const f32x4*)(cw + j * 1024 + ch), b = *(const f32x4*)(cw + j * 1024 + ch + 4);
            wv[j][0] = a[0]; wv[j][1] = a[1]; wv[j][2] = a[2]; wv[j][3] = a[3]; wv[j][4] = b[0]; wv[j][5] = b[1]; wv[j][6] = b[2]; wv[j][7] = b[3]; }
        { const f32x4 a = *(const f32x4*)(cb_ + ch), b = *(const f32x4*)(cb_ + ch + 4); bv[0] = a[0]; bv[1] = a[1]; bv[2] = a[2]; bv[3] = a[3]; bv[4] = b[0]; bv[5] = b[1]; bv[6] = b[2]; bv[7] = b[3]; }
        float xin[8][8];
#pragma unroll
        for (int i = 0; i < 8; ++i) { const int tt = t0 + tg * 4 - 2 + i; const bool ok = (tt >= seq_lo) && (tt < seq_hi);
            const unsigned w4[4] = {rr[i].x, rr[i].y, rr[i].z, rr[i].w};
#pragma unroll
            for (int e = 0; e < 4; ++e) { xin[i][2 * e] = ok ? bf_lo(w4[e]) : 0.f; xin[i][2 * e + 1] = ok ? bf_hi(w4[e]) : 0.f; } }
        const float scl = qk ? 1.0f : 0.08838834764831845f;
        unsigned outw[4][4];
#pragma unroll
        for (int o = 0; o < 4; ++o) { float a[8];
#pragma unroll
            for (int e = 0; e < 8; ++e) { float acc = bv[e];
#pragma unroll
                for (int j = 0; j < 5; ++j) acc += wv[j][e] * xin[o + j][e];
                a[e] = siluf_(acc) * scl; }
            outw[o][0] = cvt_pk_bf16(a[0], a[1]); outw[o][1] = cvt_pk_bf16(a[2], a[3]); outw[o][2] = cvt_pk_bf16(a[4], a[5]); outw[o][3] = cvt_pk_bf16(a[6], a[7]);
            u32x4 w; w.x = outw[o][0]; w.y = outw[o][1]; w.z = outw[o][2]; w.w = outw[o][3];
            *(u32x4*)(QK + (size_t)(t0 + tg * 4 + o) * 1024 + ch) = w; }
        if (qk) {
#pragma unroll
            for (int e = 0; e < 8; ++e) { const int sh = (e & 1) * 16; const int wi = e >> 1;
                const unsigned t0v = (outw[0][wi] >> sh) & 0xffffu, t1v = (outw[1][wi] >> sh) & 0xffffu, t2v = (outw[2][wi] >> sh) & 0xffffu, t3v = (outw[3][wi] >> sh) & 0xffffu;
                u32x2 pk; pk.x = t0v | (t1v << 16); pk.y = t2v | (t3v << 16);
                *(LAS u32x2*)(KT + (cb * 8 + e) * LROW + tg * 8) = pk; }
        }
    }
    bf16_t* Zv = Z + PLANE + (size_t)t0 * 1024 + h * 256;
#pragma unroll
    for (int ps = 0; ps < 8; ++ps) {
        const int tok = tid & 127; const int d0 = ((tid >> 7) + 4 * ps) * 8;
        const u32x4 r = *(const u32x4*)(Zv + (size_t)tok * 1024 + d0);
        const unsigned ww[4] = {r.x, r.y, r.z, r.w};
#pragma unroll
        for (int e = 0; e < 8; ++e) *(LAS bf16_t*)(VT + (d0 + e) * LROW + tok * 2) = (bf16_t)((e & 1) ? (ww[e >> 1] >> 16) : (ww[e >> 1] & 0xffffu));
    }
    if (wave < 2) {
        const int dir = wave;
        const int r0 = gr0, r1 = gr1;
        const float i0 = gi0, f0 = gf0, i1 = gi1, f1 = gf1;
        const float s = f0 + f1; const float incl = wave_incl_sum(s, lane); const float b0 = incl - s + f0, b1 = incl;
        const float B0 = i0 - b0, B1 = i1 - b1;
        const float cmB = wave_max(fmaxf(B0, B1)); const float bend = __shfl(b1, 63);
        wsrc[dir * 128 + r0] = __expf(B0 - cmB); wsrc[dir * 128 + r1] = __expf(B1 - cmB);
        if (lane == 0) { SC[((c * 2 + dir) * 4 + h) * 2] = bend; SC[((c * 2 + dir) * 4 + h) * 2 + 1] = bend + cmB; }
    }
    __syncthreads();
#pragma unroll
    for (int ps = 0; ps < 8; ++ps) {
        const int dv = (tid >> 4) + 32 * ps, chn = tid & 15;
        const u32x4 r = *(const LAS u32x4*)(VT + dv * LROW + chn * 16);
        *(u32x4*)(Zv + (size_t)(dv >> 1) * 1024 + (dv & 1) * 128 + chn * 8) = r;
    }
#pragma unroll 1
    for (int dir = 0; dir < 2; ++dir) {
        f32x4 acc[2][8];
#pragma unroll
        for (int m = 0; m < 2; ++m)
#pragma unroll
            for (int n = 0; n < 8; ++n) acc[m][n] = (f32x4){0.f, 0.f, 0.f, 0.f};
#pragma unroll
        for (int ks = 0; ks < 4; ++ks) {
            const LAS float* wp = wsrc + dir * 128 + 32 * ks + 8 * fq;
            const f32x4 w0 = *(const LAS f32x4*)wp, w1 = *(const LAS f32x4*)(wp + 4);
#ifdef DBG_CHECK
            if (l == 0) { bool b = false;
                for (int e = 0; e < 4; ++e) { if (!(w0[e] >= 0.f && w0[e] <= 1.0001f)) b = true; if (!(w1[e] >= 0.f && w1[e] <= 1.0001f)) b = true; }
                FLAGBAD(b, 71); }
#endif
            bf16x8 af[2];
#pragma unroll
            for (int m = 0; m < 2; ++m) { const u32x4 r = *(const LAS u32x4*)(VT + (32 * wave + 16 * m + fr) * LROW + 64 * ks + 16 * fq);
                u32x4 o; o.x = cvt_pk_bf16(bf_lo(r.x) * w0[0], bf_hi(r.x) * w0[1]); o.y = cvt_pk_bf16(bf_lo(r.y) * w0[2], bf_hi(r.y) * w0[3]);
                o.z = cvt_pk_bf16(bf_lo(r.z) * w1[0], bf_hi(r.z) * w1[1]); o.w = cvt_pk_bf16(bf_lo(r.w) * w1[2], bf_hi(r.w) * w1[3]);
                af[m] = __builtin_bit_cast(bf16x8, o);
#ifdef DBG_CHECK
                if (l == 0) { bool b = false; const unsigned rr[4] = {r.x, r.y, r.z, r.w};
                    for (int e = 0; e < 4; ++e) { if (!(fabsf(bf_lo(rr[e])) < 1e4f)) b = true; if (!(fabsf(bf_hi(rr[e])) < 1e4f)) b = true; }
                    FLAGBAD(b, 72); }
#endif
            }
#pragma unroll
            for (int n = 0; n < 8; ++n) { const bf16x8 bfv = *(const LAS bf16x8*)(KT + (16 * n + fr) * LROW + 64 * ks + 16 * fq);
#ifdef DBG_CHECK
                if (l == 0) { bool b = false; const u32x4 rk = __builtin_bit_cast(u32x4, bfv); const unsigned rr[4] = {rk.x, rk.y, rk.z, rk.w};
                    for (int e = 0; e < 4; ++e) { if (!(fabsf(bf_lo(rr[e])) < 1e4f)) b = true; if (!(fabsf(bf_hi(rr[e])) < 1e4f)) b = true; }
                    FLAGBAD(b, 73); }
#endif
#pragma unroll
                for (int m = 0; m < 2; ++m) acc[m][n] = __builtin_amdgcn_mfma_f32_16x16x32_bf16(bfv, af[m], acc[m][n], 0, 0, 0); }
        }
#ifdef DBG_CHECK
        if (l == 0) { bool b = false;
            for (int m = 0; m < 2; ++m) for (int n = 0; n < 8; ++n) for (int e = 0; e < 4; ++e) if (!(fabsf(acc[m][n][e]) < 1e6f)) b = true;
            FLAGBAD(b, 74); }
#endif
        bf16_t* st = ST + (size_t)((c * 2 + dir) * 4 + h) * 32768;
#pragma unroll
        for (int m = 0; m < 2; ++m)
#pragma unroll
            for (int n = 0; n < 8; ++n) { u32x2 w; w.x = cvt_pk_bf16(acc[m][n][0], acc[m][n][1]); w.y = cvt_pk_bf16(acc[m][n][2], acc[m][n][3]);
                *(u32x2*)(st + (32 * wave + 16 * m + fr) * 128 + 16 * n + 4 * fq) = w; }
        { const int dk = tid & 127, part = tid >> 7; float s = 0.f;
#pragma unroll 8
          for (int e = 0; e < 32; ++e) { const int sidx = part * 32 + e; s += wsrc[dir * 128 + sidx] * __uint_as_float(((unsigned)*(const LAS bf16_t*)(KT + dk * LROW + sidx * 2)) << 16); }
          red[(dir * 4 + part) * 128 + dk] = s; }
    }
    __syncthreads();
    if (tid < 256) { const int dir = tid >> 7, dk = tid & 127;
        NS[(size_t)((c * 2 + dir) * 4 + h) * 128 + dk] = (red[(dir * 4 + 0) * 128 + dk] + red[(dir * 4 + 1) * 128 + dk]) + (red[(dir * 4 + 2) * 128 + dk] + red[(dir * 4 + 3) * 128 + dk]); }
    __syncthreads();
}

__device__ __forceinline__ void mixA_spatial(const Params& p, int l, int c, int g, LAS unsigned char* lds, int tid, int wave, int lane) {
    const int fr = lane & 15, fq = lane >> 4;
    const bf16_t* Z = (const bf16_t*)(p.ws + OFF_Z); bf16_t* YB = (bf16_t*)(p.ws + OFF_H);
    LAS unsigned char* VBT = lds; LAS unsigned char* WS = lds + 256 * LROW;
    const int t0 = c * 128;
    const bf16_t* Zvb = Z + 4 * PLANE + (size_t)t0 * 1024;
    LAS float* rstdv = (LAS float*)(lds + 384 * LROW);
    if (tid < 128) { const float* sp = (const float*)(p.ws + OFF_SSQ) + (size_t)(t0 + tid) * 16;
        const f32x4 a = *(const f32x4*)sp, b = *(const f32x4*)(sp + 4), c4 = *(const f32x4*)(sp + 8), d = *(const f32x4*)(sp + 12);
        const float tot = ((a[0] + a[1]) + (a[2] + a[3])) + ((b[0] + b[1]) + (b[2] + b[3])) + ((c4[0] + c4[1]) + (c4[2] + c4[3])) + ((d[0] + d[1]) + (d[2] + d[3]));
        rstdv[tid] = rsqrtf(tot * (1.0f / 1024.0f) + EPS); }
    __syncthreads();
#pragma unroll
    for (int ps = 0; ps < 8; ++ps) {
        const int tok = tid & 127; const int d0 = ((tid >> 7) + 4 * ps) * 8;
        const u32x4 r = *(const u32x4*)(Zvb + (size_t)tok * 1024 + 256 * g + d0);
        const float* vn = p.vnorm_g + (size_t)l * 1024 + 256 * g + d0; const f32x4 ga = *(const f32x4*)vn, gb = *(const f32x4*)(vn + 4);
        const float rs = rstdv[tok];
        const unsigned rr[4] = {r.x, r.y, r.z, r.w}; const float gg[8] = {ga[0], ga[1], ga[2], ga[3], gb[0], gb[1], gb[2], gb[3]};
#pragma unroll
        for (int e = 0; e < 4; ++e) { const unsigned w = cvt_pk_bf16(bf_lo(rr[e]) * rs * gg[2 * e], bf_hi(rr[e]) * rs * gg[2 * e + 1]);
            *(LAS bf16_t*)(VBT + (d0 + 2 * e) * LROW + tok * 2) = (bf16_t)(w & 0xffffu); *(LAS bf16_t*)(VBT + (d0 + 2 * e + 1) * LROW + tok * 2) = (bf16_t)(w >> 16); }
    }
    { const float* wsp = p.w_sp + ((size_t)l * 4 + g) * 16384;
#pragma unroll
      for (int i = 0; i < 8; ++i) { const int idx = tid + 512 * i; const int t = idx >> 5, s4 = idx & 31; const f32x4 w4 = *(const f32x4*)(wsp + (size_t)idx * 4);
          u32x2 o; o.x = cvt_pk_bf16(w4[0], w4[1]); o.y = cvt_pk_bf16(w4[2], w4[3]); *(LAS u32x2*)(WS + t * LROW + s4 * 8) = o; } }
    __syncthreads();
    f32x4 acc[8][2];
#pragma unroll
    for (int m = 0; m < 8; ++m)
#pragma unroll
        for (int n = 0; n < 2; ++n) acc[m][n] = (f32x4){0.f, 0.f, 0.f, 0.f};
#pragma unroll
    for (int ks = 0; ks < 4; ++ks) {
        bf16x8 bfv[2];
#pragma unroll
        for (int n = 0; n < 2; ++n) bfv[n] = *(const LAS bf16x8*)(VBT + (32 * wave + 16 * n + fr) * LROW + 64 * ks + 16 * fq);
#pragma unroll
        for (int m = 0; m < 8; ++m) { const bf16x8 af = *(const LAS bf16x8*)(WS + (16 * m + fr) * LROW + 64 * ks + 16 * fq);
#pragma unroll
            for (int n = 0; n < 2; ++n) acc[m][n] = __builtin_amdgcn_mfma_f32_16x16x32_bf16(bfv[n], af, acc[m][n], 0, 0, 0); }
    }
    const bf16_t* Zu = Z + 3 * PLANE + (size_t)t0 * 1024 + 256 * g;
    const float* bsp = p.b_sp + ((size_t)l * 4 + g) * 128;
#pragma unroll
    for (int m = 0; m < 8; ++m) { const int t = 16 * m + fr; const float bb = bsp[t];
#pragma unroll
        for (int n = 0; n < 2; ++n) { const int d = 32 * wave + 16 * n + 4 * fq;
            const u32x2 ur = *(const u32x2*)(Zu + (size_t)t * 1024 + d);
            const float y0 = bf_lo(ur.x) * (acc[m][n][0] + bb), y1 = bf_hi(ur.x) * (acc[m][n][1] + bb), y2 = bf_lo(ur.y) * (acc[m][n][2] + bb), y3 = bf_hi(ur.y) * (acc[m][n][3] + bb);
            u32x2 o; o.x = cvt_pk_bf16(y0, y1); o.y = cvt_pk_bf16(y2, y3);
            *(u32x2*)(YB + (size_t)(t0 + t) * 1024 + 256 * g + d) = o; } }
    __syncthreads();
}

__device__ __forceinline__ int scan_chunk(int dir, int k) { return dir ? (k < 2 ? 1 - k : 131 - k) : k; }
__device__ __forceinline__ void scan_phase(const Params& p, int tid) {
    bf16_t* ST = (bf16_t*)(p.ws + OFF_ST); const float* SC = (const float*)(p.ws + OFF_SC); float* MP = (float*)(p.ws + OFF_MP); float* NS = (float*)(p.ws + OFF_NS);
    const int gid = blockIdx.x * NTHREADS + tid, gsz = gridDim.x * NTHREADS;
    for (int pr = gid; pr < 8 * 16384; pr += gsz) {
        const int dh = __builtin_amdgcn_readfirstlane(pr >> 14), e = pr & 16383, dir = dh >> 2, h = dh & 3;
        int lz; asm volatile("v_mov_b32 %0, 0" : "=v"(lz));
        float c0 = 0.f, c1 = 0.f, m = 0.f;
        const bool nth = (e < 64);
        float n0 = 0.f, n1 = 0.f;
#pragma unroll 1
        for (int k0 = 0; k0 < NCH; k0 += 26) {
            unsigned dv[26]; float be[26], ml[26]; f32x2 dn2[26];
#pragma unroll
            for (int j = 0; j < 26; ++j) { const int c = scan_chunk(dir, k0 + j); const int sl = (c * 2 + dir) * 4 + h;
                dv[j] = *(const unsigned*)(ST + (size_t)sl * 32768 + 2 * e); be[j] = SC[sl * 2 + lz]; ml[j] = SC[sl * 2 + 1 + lz];
                if (nth) dn2[j] = *(const f32x2*)(NS + (size_t)sl * 128 + 2 * e); }
#pragma unroll
            for (int j = 0; j < 26; ++j) { const int c = scan_chunk(dir, k0 + j); const int sl = (c * 2 + dir) * 4 + h;
                *(unsigned*)(ST + (size_t)sl * 32768 + 2 * e) = cvt_pk_bf16(c0, c1);
                if (e == 0) MP[sl] = m;
                const float mn = fmaxf(be[j] + m, ml[j]); const float wc = __expf(be[j] + m - mn), wl = __expf(ml[j] - mn);
                c0 = wc * c0 + wl * bf_lo(dv[j]); c1 = wc * c1 + wl * bf_hi(dv[j]); m = mn;
                if (nth) { *(f32x2*)(NS + (size_t)sl * 128 + 2 * e) = (f32x2){n0, n1}; n0 = wc * n0 + wl * dn2[j][0]; n1 = wc * n1 + wl * dn2[j][1]; } }
        }
    }
}

__device__ __forceinline__ void mixC_item(const Params& p, int l, int c, int h, LAS unsigned char* lds, int tid, int wave, int lane) {
    const int fr = lane & 15, fq = lane >> 4;
    const bf16_t* Z = (const bf16_t*)(p.ws + OFF_Z); const bf16_t* QK = (const bf16_t*)(p.ws + OFF_QK); const bf16_t* ST = (const bf16_t*)(p.ws + OFF_ST);
    bf16_t* YA = (bf16_t*)(p.ws + OFF_Z);
    const float* G = (const float*)(p.ws + OFF_G); const float* MP = (const float*)(p.ws + OFF_MP); const float* NS = (const float*)(p.ws + OFF_NS);
    LAS unsigned char* Qs = lds; LAS unsigned char* Ks = lds + 128 * LROW; LAS unsigned char* QBs = lds + 256 * LROW;
    LAS float* vec = (LAS float*)(lds + 384 * LROW);
    LAS float* Bv = vec;
    LAS float* Mx = vec + 256;
    LAS float* bt = vec + 512;
    LAS float* npv = vec + 768;
    LAS float* qnp = vec + 1024;
    LAS float* cfv = vec + 2048;
    LAS float* ssq = vec + 2304;
    LAS float* mpv = vec + 3328;
    const int t0 = c * 128;
#pragma unroll
    for (int ps = 0; ps < 4; ++ps) { const int tok = (tid >> 4) + 32 * ps, chn = tid & 15;
        const u32x4 q = *(const u32x4*)(QK + (size_t)(t0 + tok) * 1024 + h * 128 + chn * 8), k = *(const u32x4*)(QK + (size_t)(t0 + tok) * 1024 + 512 + h * 128 + chn * 8);
        *(LAS u32x4*)(Qs + tok * LROW + chn * 16) = q; *(LAS u32x4*)(Ks + tok * LROW + chn * 16) = k; }
    if (wave < 2) {
        const int dir = wave; const int sl = (c * 2 + dir) * 4 + h;
        const int r0 = dir ? 127 - 2 * lane : 2 * lane, r1 = dir ? r0 - 1 : r0 + 1;
        const float* gp = G + (size_t)t0 * 16 + dir * 8 + h;
        const float i0 = gp[r0 * 16], f0 = gp[r0 * 16 + 4], i1 = gp[r1 * 16], f1 = gp[r1 * 16 + 4];
        const float s = f0 + f1; const float incl = wave_incl_sum(s, lane); const float b0 = incl - s + f0, b1 = incl;
        const float B0 = i0 - b0, B1 = i1 - b1;
        const float pm = fmaxf(B0, B1); const float cmi = wave_incl_max(pm, lane);
        float cme = __shfl_up(cmi, 1); if (lane == 0) cme = -INFINITY;
        const float mprev = MP[sl];
        const float cm0 = fmaxf(cme, B0), cm1 = cmi;
        Bv[dir * 128 + r0] = B0; Bv[dir * 128 + r1] = B1;
        Mx[dir * 128 + r0] = fmaxf(mprev, cm0); Mx[dir * 128 + r1] = fmaxf(mprev, cm1);
        bt[dir * 128 + r0] = b0; bt[dir * 128 + r1] = b1;
        npv[dir * 128 + lane] = NS[(size_t)sl * 128 + lane]; npv[dir * 128 + 64 + lane] = NS[(size_t)sl * 128 + 64 + lane];
        if (lane == 0) mpv[dir] = mprev;
    }
    __syncthreads();
    f32x4 S[8];
#pragma unroll
    for (int n = 0; n < 8; ++n) S[n] = (f32x4){0.f, 0.f, 0.f, 0.f};
#pragma unroll
    for (int ks = 0; ks < 4; ++ks) { const bf16x8 af = *(const LAS bf16x8*)(Qs + (16 * wave + fr) * LROW + 64 * ks + 16 * fq);
#pragma unroll
        for (int n = 0; n < 8; ++n) { const bf16x8 bfv = *(const LAS bf16x8*)(Ks + (16 * n + fr) * LROW + 64 * ks + 16 * fq);
            S[n] = __builtin_amdgcn_mfma_f32_16x16x32_bf16(bfv, af, S[n], 0, 0, 0); } }
    { const int t = tid & 127, part = tid >> 7; float sf = 0.f, sb = 0.f;
#pragma unroll
      for (int e8 = 0; e8 < 4; ++e8) { const u32x4 r = *(const LAS u32x4*)(Qs + t * LROW + part * 64 + e8 * 16); const int d = part * 32 + e8 * 8;
          const float qv[8] = {bf_lo(r.x), bf_hi(r.x), bf_lo(r.y), bf_hi(r.y), bf_lo(r.z), bf_hi(r.z), bf_lo(r.w), bf_hi(r.w)};
#pragma unroll
          for (int e = 0; e < 8; ++e) { sf += qv[e] * npv[d + e]; sb += qv[e] * npv[128 + d + e]; } }
      qnp[(0 * 4 + part) * 128 + t] = sf; qnp[(1 * 4 + part) * 128 + t] = sb; }
    __syncthreads();
    {
        const int t = 16 * wave + fr;
        const float mxf = Mx[t], mxb = Mx[128 + t];
        float pf[8][4], pb[8][4]; float sumf = 0.f, sumb = 0.f;
#pragma unroll
        for (int n = 0; n < 8; ++n) { const f32x4 bf4 = *(const LAS f32x4*)(Bv + 16 * n + 4 * fq), bb4 = *(const LAS f32x4*)(Bv + 128 + 16 * n + 4 * fq);
#pragma unroll
            for (int j = 0; j < 4; ++j) { const int s = 16 * n + 4 * fq + j;
                const float ef = (s <= t) ? __expf(bf4[j] - mxf) : 0.f; const float eb = (s >= t) ? __expf(bb4[j] - mxb) : 0.f;
                pf[n][j] = S[n][j] * ef; pb[n][j] = S[n][j] * eb; sumf += pf[n][j]; sumb += pb[n][j]; } }
        sumf += __shfl_xor(sumf, 16); sumf += __shfl_xor(sumf, 32); sumb += __shfl_xor(sumb, 16); sumb += __shfl_xor(sumb, 32);
        const float qnf = (qnp[0 * 128 + t] + qnp[1 * 128 + t]) + (qnp[2 * 128 + t] + qnp[3 * 128 + t]);
        const float qnb = (qnp[4 * 128 + t] + qnp[5 * 128 + t]) + (qnp[6 * 128 + t] + qnp[7 * 128 + t]);
        const float wpf = __expf(mpv[0] - mxf), wpb = __expf(mpv[1] - mxb);
        const float denf = sumf + wpf * qnf, denb = sumb + wpb * qnb;
        const float rsf = 1.0f / fmaxf(fabsf(denf), __expf(-(bt[t] + mxf))), rsb = 1.0f / fmaxf(fabsf(denb), __expf(-(bt[128 + t] + mxb)));
        if (fq == 0) { cfv[t] = wpf * rsf; cfv[128 + t] = wpb * rsb; }
#pragma unroll
        for (int n = 0; n < 8; ++n) { u32x2 o; o.x = cvt_pk_bf16(pf[n][0] * rsf + pb[n][0] * rsb, pf[n][1] * rsf + pb[n][1] * rsb); o.y = cvt_pk_bf16(pf[n][2] * rsf + pb[n][2] * rsb, pf[n][3] * rsf + pb[n][3] * rsb);
            *(LAS u32x2*)(Ks + t * LROW + 32 * n + 8 * fq) = o; }
    }
    __syncthreads();
    f32x4 acc[8][2];
#pragma unroll
    for (int m = 0; m < 8; ++m)
#pragma unroll
        for (int n = 0; n < 2; ++n) acc[m][n] = (f32x4){0.f, 0.f, 0.f, 0.f};
    const bf16_t* Zv = Z + PLANE + (size_t)t0 * 1024 + h * 256;
    bf16x8 bA[2][4], bB[2][4];
#pragma unroll
    for (int n = 0; n < 2; ++n) { const int dv = 32 * wave + 16 * n + fr;
        const bf16_t* bp = Zv + (size_t)(dv >> 1) * 1024 + (dv & 1) * 128; const bf16_t* cp = ST + (size_t)((c * 2 + 0) * 4 + h) * 32768 + dv * 128;
#pragma unroll
        for (int ks = 0; ks < 4; ++ks) { bA[n][ks] = *(const bf16x8*)(bp + 32 * ks + 8 * fq); bB[n][ks] = *(const bf16x8*)(cp + 32 * ks + 8 * fq); } }
    asm volatile("" ::: "memory");
#pragma unroll
    for (int ks = 0; ks < 4; ++ks)
#pragma unroll
        for (int m = 0; m < 8; ++m) { const bf16x8 af = *(const LAS bf16x8*)(Ks + (16 * m + fr) * LROW + 64 * ks + 16 * fq);
#pragma unroll
            for (int n = 0; n < 2; ++n) acc[m][n] = __builtin_amdgcn_mfma_f32_16x16x32_bf16(bA[n][ks], af, acc[m][n], 0, 0, 0); }
    asm volatile("" ::: "memory");
#pragma unroll
    for (int n = 0; n < 2; ++n) { const int dv = 32 * wave + 16 * n + fr; const bf16_t* cp = ST + (size_t)((c * 2 + 1) * 4 + h) * 32768 + dv * 128;
#pragma unroll
        for (int ks = 0; ks < 4; ++ks) bA[n][ks] = *(const bf16x8*)(cp + 32 * ks + 8 * fq); }
    asm volatile("" ::: "memory");
#pragma unroll
    for (int sg = 0; sg < 2; ++sg) {
#pragma unroll
        for (int mh = 0; mh < 2; ++mh) {
            f32x4 tmp[4][2];
#pragma unroll
            for (int m = 0; m < 4; ++m)
#pragma unroll
                for (int n = 0; n < 2; ++n) tmp[m][n] = (f32x4){0.f, 0.f, 0.f, 0.f};
#pragma unroll
            for (int ks = 0; ks < 4; ++ks)
#pragma unroll
                for (int m = 0; m < 4; ++m) { const bf16x8 af = *(const LAS bf16x8*)(Qs + (16 * (4 * mh + m) + fr) * LROW + 64 * ks + 16 * fq);
#pragma unroll
                    for (int n = 0; n < 2; ++n) tmp[m][n] = __builtin_amdgcn_mfma_f32_16x16x32_bf16(sg == 0 ? bB[n][ks] : bA[n][ks], af, tmp[m][n], 0, 0, 0); }
#pragma unroll
            for (int m = 0; m < 4; ++m) { const float cs_ = cfv[sg * 128 + 16 * (4 * mh + m) + fr];
#pragma unroll
                for (int n = 0; n < 2; ++n) acc[4 * mh + m][n] += tmp[m][n] * cs_; }
        }
        asm volatile("" ::: "memory");
    }
#pragma unroll
    for (int m = 0; m < 8; ++m) { float s = 0.f;
#pragma unroll
        for (int n = 0; n < 2; ++n) s += (acc[m][n][0] * acc[m][n][0] + acc[m][n][1] * acc[m][n][1]) + (acc[m][n][2] * acc[m][n][2] + acc[m][n][3] * acc[m][n][3]);
        s += __shfl_xor(s, 16); s += __shfl_xor(s, 32);
        if (fq == 0) ssq[wave * 128 + 16 * m + fr] = s; }
    __syncthreads();
    const float* hg = p.head_g + ((size_t)l * 4 + h) * 256;
    const bf16_t* Zo = Z + 2 * PLANE + (size_t)t0 * 1024 + h * 256;
    f32x4 hg4[2];
#pragma unroll
    for (int n = 0; n < 2; ++n) hg4[n] = *(const f32x4*)(hg + 32 * wave + 16 * n + 4 * fq);
#pragma unroll
    for (int m = 0; m < 8; ++m) { const int t = 16 * m + fr; float tot = 0.f;
#pragma unroll
        for (int w8 = 0; w8 < 8; ++w8) tot += ssq[w8 * 128 + t];
        const float rstd = rsqrtf(tot * (1.0f / 256.0f) + EPS);
#pragma unroll
        for (int n = 0; n < 2; ++n) { const int dv = 32 * wave + 16 * n + 4 * fq;
            const u32x2 orw = *(const u32x2*)(Zo + (size_t)t * 1024 + dv);
            const float y0 = acc[m][n][0] * rstd * hg4[n][0] * sigmoidf_(bf_lo(orw.x)), y1 = acc[m][n][1] * rstd * hg4[n][1] * sigmoidf_(bf_hi(orw.x));
            const float y2 = acc[m][n][2] * rstd * hg4[n][2] * sigmoidf_(bf_lo(orw.y)), y3 = acc[m][n][3] * rstd * hg4[n][3] * sigmoidf_(bf_hi(orw.y));
            u32x2 o; o.x = cvt_pk_bf16(y0, y1); o.y = cvt_pk_bf16(y2, y3);
            *(u32x2*)(YA + (size_t)(t0 + t) * 1024 + h * 256 + dv) = o; } }
    __syncthreads();
}


template <int MODE>
__device__ __forceinline__ void ctx_gemm_tile(const bf16_t* A0, const bf16_t* A1, const bf16_t* Bt, const int K, const bf16_t* GA, const bf16_t* GB, bf16_t* O, float* cs, const float* gc,
                                              LAS unsigned char* lds, int tile, int tid, int wave, int lane) {
    const int fr = lane & 15, fq = lane >> 4;
    const int row0 = (tile >> 5) * 32, col0 = (tile & 31) * 32;
    const int seg = (MODE == 0) ? (wave >> 2) : 0;
    const int kw = (MODE == 0) ? K / 4 : K / 8;
    const int kb = ((MODE == 0) ? (wave & 3) : wave) * kw;
    const bf16_t* A = (seg ? A1 : A0) + (size_t)(row0 + fr) * K + kb + 8 * fq;
    const bf16_t* B = Bt + (size_t)(seg * 1024 + col0 + fr) * K + kb + 8 * fq;
    f32x4 acc[2][2];
#pragma unroll
    for (int m = 0; m < 2; ++m)
#pragma unroll
        for (int n = 0; n < 2; ++n) acc[m][n] = (f32x4){0.f, 0.f, 0.f, 0.f};
#pragma unroll 4
    for (int k = 0; k < kw; k += 32) {
        bf16x8 a[2], b[2];
#pragma unroll
        for (int m = 0; m < 2; ++m) a[m] = *(const bf16x8*)(A + (size_t)(16 * m) * K + k);
#pragma unroll
        for (int n = 0; n < 2; ++n) b[n] = *(const bf16x8*)(B + (size_t)(16 * n) * K + k);
#pragma unroll
        for (int m = 0; m < 2; ++m)
#pragma unroll
            for (int n = 0; n < 2; ++n) acc[m][n] = __builtin_amdgcn_mfma_f32_16x16x32_bf16(b[n], a[m], acc[m][n], 0, 0, 0);
    }
    LAS float* red = (LAS float*)lds;
#pragma unroll
    for (int m = 0; m < 2; ++m)
#pragma unroll
        for (int n = 0; n < 2; ++n) *(LAS f32x4*)(red + wave * 1024 + (16 * m + fr) * 32 + 16 * n + 4 * fq) = acc[m][n];
    __syncthreads();
    const int r = tid >> 4, c2 = (tid & 15) * 2;
    float pa0 = 0.f, pa1 = 0.f, pb0 = 0.f, pb1 = 0.f;
#pragma unroll
    for (int w = 0; w < 8; ++w) { const f32x2 v = *(const LAS f32x2*)(red + w * 1024 + r * 32 + c2);
        if (MODE == 0 && w >= 4) { pb0 += v[0]; pb1 += v[1]; } else { pa0 += v[0]; pa1 += v[1]; } }
    const size_t o = (size_t)(row0 + r) * 1024 + col0 + c2;
    if (MODE == 0) {
        const unsigned ga = *(const unsigned*)(GA + o), gb = *(const unsigned*)(GB + o);
        const float m0 = sigmoidf_(bf_lo(ga)) * pa0 + sigmoidf_(bf_lo(gb)) * pb0, m1 = sigmoidf_(bf_hi(ga)) * pa1 + sigmoidf_(bf_hi(gb)) * pb1;
        *(unsigned*)(O + o) = cvt_pk_bf16(m0, m1);
    } else {
        const f32x2 g2 = *(const f32x2*)(gc + col0 + c2); f32x2* pp = (f32x2*)(cs + o); f32x2 x = *pp; x[0] += g2[0] * pa0; x[1] += g2[1] * pa1; *pp = x;
    }
    __syncthreads();
}


constexpr size_t OFF_BAR = 280 * 1024;
#define XB_TMO      128
#define XB_XCNT(j)  (256  + 64 * (j))
#define XB_XSUB(j)  (1280 + 64 * (j))
#define XB_XGEN(j)  (2304 + 64 * (j))
#define XB_TOP      3328
#define XB_TOPGEN   3392
#define XCD_BAR_WORDS 3456
#define XB_SPIN_CAP (1u << 22)
__device__ __forceinline__ unsigned xb_ld(unsigned* p)              { return __hip_atomic_load(p, __ATOMIC_RELAXED, __HIP_MEMORY_SCOPE_AGENT); }
__device__ __forceinline__ unsigned xb_add(unsigned* p, unsigned v) { return __hip_atomic_fetch_add(p, v, __ATOMIC_RELAXED, __HIP_MEMORY_SCOPE_AGENT); }
__device__ __forceinline__ unsigned xb_xcc_id() { return (unsigned)__builtin_amdgcn_s_getreg((3 << 11) | 20) & 0xFu; }
#define XB_SPIN(cond, bar) do { unsigned _sp = 0; while (cond) { __builtin_amdgcn_s_sleep(1); \
    if ((++_sp & 255u) == 0u) { if (xb_ld(&(bar)[XB_TMO])) break; if (_sp > XB_SPIN_CAP) { atomicAdd(&(bar)[XB_TMO], 1u); break; } } } } while (0)
struct XcdBarrier { unsigned* bar; unsigned x; volatile LAS unsigned* st; };
__device__ __forceinline__ void xcd_barrier_complete(unsigned* bar, unsigned x, unsigned& nloc, unsigned& nx) {
    const unsigned G = gridDim.x * gridDim.y * gridDim.z;
    unsigned sum, cnt, mine, sp = 0u;
    for (;;) {
        sum = 0u; cnt = 0u; mine = 0u;
#pragma unroll
        for (unsigned j = 0; j < 16; ++j) { const unsigned c = xb_ld(&bar[XB_XCNT(j)]); sum += c; cnt += (c > 0u) ? 1u : 0u; mine = (j == x) ? c : mine; }
        if (sum == G) break;
        __builtin_amdgcn_s_sleep(1);
        if ((++sp & 255u) == 0u) { if (xb_ld(&bar[XB_TMO])) break; if (sp > XB_SPIN_CAP) { atomicAdd(&bar[XB_TMO], 1u); break; } }
    }
    nloc = mine > 0u ? mine : 1u; nx = cnt > 0u ? cnt : 1u;
}
__device__ __forceinline__ void xcd_barrier(const XcdBarrier& b) {
    asm volatile("s_waitcnt vmcnt(0)" ::: "memory");
    __syncthreads();
    if (threadIdx.x == 0) {
        unsigned* bar = b.bar;
        __builtin_amdgcn_s_waitcnt(0);
        unsigned nloc = b.st[0], nx = b.st[1];
        if (nloc == 0u) { xcd_barrier_complete(bar, b.x, nloc, nx); b.st[0] = nloc; b.st[1] = nx; }
        const unsigned old = xb_add(&bar[XB_XSUB(b.x)], 1u);
        const unsigned gen = old / nloc;
        if (old + 1u == (gen + 1u) * nloc) {
            __builtin_amdgcn_fence(__ATOMIC_RELEASE, "agent");
            asm volatile("s_waitcnt vmcnt(0)" ::: "memory");
            const unsigned og = xb_add(&bar[XB_TOP], 1u);
            const unsigned tg = og / nx;
            if (og + 1u == (tg + 1u) * nx) xb_add(&bar[XB_TOPGEN], 1u);
            else XB_SPIN(xb_ld(&bar[XB_TOPGEN]) == tg, bar);
            __builtin_amdgcn_fence(__ATOMIC_ACQUIRE, "agent");
            xb_add(&bar[XB_XGEN(b.x)], 1u);
            asm volatile("s_waitcnt vmcnt(0)" ::: "memory");
        } else {
            XB_SPIN(xb_ld(&bar[XB_XGEN(b.x)]) == gen, bar);
            __builtin_amdgcn_fence(__ATOMIC_ACQUIRE, "agent");
            asm volatile("s_waitcnt vmcnt(0)" ::: "memory");
        }
    }
    __syncthreads();
}
#define XB_ST ((volatile LAS unsigned*)(lds + 144384))

#define GRID_SYNC_CG() do { T_BEGIN(); asm volatile("s_waitcnt vmcnt(0) lgkmcnt(0)" ::: "memory"); grid.sync(); T_END(12); } while (0)
#ifdef DBG_TIME
#define TACC ((LAS unsigned long long*)(lds + 143360))
#define T_BEGIN() unsigned long long t0_ = __builtin_amdgcn_s_memrealtime()
#define T_END(k) do { if (blockIdx.x == 0 && threadIdx.x == 0) TACC[k] += __builtin_amdgcn_s_memrealtime() - t0_; } while (0)
#else
#define T_BEGIN() do {} while (0)
#define T_END(k) do {} while (0)
#endif
#define GRID_SYNC() do { T_BEGIN(); { const Params pb_ = LOADP(); XcdBarrier b_; b_.bar = (unsigned*)(pb_.ws + OFF_BAR); b_.x = xb_xcc_id(); b_.st = XB_ST; xcd_barrier(b_); } T_END(12); } while (0)
typedef const __attribute__((address_space(4))) Params* KP;
typedef const __attribute__((address_space(4))) unsigned long long* KP64;
#define GPTR(T, v) ((T*)(__attribute__((address_space(1))) T*)(v))
__device__ __forceinline__ Params load_params(KP q) {
    KP64 s = (KP64)q; Params p;
    p.x = GPTR(const float, s[0]); p.c = GPTR(const float, s[1]); p.ctx = GPTR(const float, s[2]); p.c_ctx = GPTR(const float, s[3]); p.w_ada = GPTR(const float, s[4]); p.b_ada = GPTR(const float, s[5]);
    p.norm1_g = GPTR(const float, s[6]); p.norm2_g = GPTR(const float, s[7]); p.w_in = GPTR(const float, s[8]); p.conv_w = GPTR(const float, s[9]); p.conv_b = GPTR(const float, s[10]); p.gate_b = GPTR(const float, s[11]);
    p.head_g = GPTR(const float, s[12]); p.vnorm_g = GPTR(const float, s[13]); p.w_sp = GPTR(const float, s[14]); p.b_sp = GPTR(const float, s[15]); p.w_pa = GPTR(const float, s[16]); p.w_pb = GPTR(const float, s[17]);
    p.w_out = GPTR(const float, s[18]); p.w_ff1 = GPTR(const float, s[19]); p.w_ff3 = GPTR(const float, s[20]); p.w_ff2 = GPTR(const float, s[21]); p.final_g = GPTR(const float, s[22]);
    p.out = GPTR(float, s[23]); p.ws = GPTR(unsigned char, s[24]);
    return p;
}
#define LOADP() ({ KP q_ = kp; asm volatile("" : "+s"(q_)); load_params(q_); })
#define TIDS() int t_ = threadIdx.x; asm volatile("" : "+v"(t_)); const int tid = t_, lane = tid & 63, wave = __builtin_amdgcn_readfirstlane(tid >> 6); const int gw = bx * NWAVES + wave; (void)lane; (void)gw;

#ifdef DBG_CHECK
__device__ __forceinline__ void chk_bf16(const Params& p, const bf16_t* b, size_t n, unsigned code, bool on, int tid) {
    if (!on) return; unsigned* flag = (unsigned*)(p.ws + OFF_FLAG); bool bad = false;
    for (size_t i = (size_t)blockIdx.x * NTHREADS + tid; i < n; i += (size_t)gridDim.x * NTHREADS) { const float v = __uint_as_float(((unsigned)b[i]) << 16); if (!(fabsf(v) < 1e6f)) bad = true; }
    if (bad) atomicMin(flag, code);
}
__device__ __forceinline__ void chk_f32(const Params& p, const float* b, size_t n, unsigned code, bool on, int tid) {
    if (!on) return; unsigned* flag = (unsigned*)(p.ws + OFF_FLAG); bool bad = false;
    for (size_t i = (size_t)blockIdx.x * NTHREADS + tid; i < n; i += (size_t)gridDim.x * NTHREADS) { const float v = b[i]; if (!(fabsf(v) < 1e6f)) bad = true; }
    if (bad) atomicMin(flag, code);
}
#define CHK(stmt) do { TIDS(); const Params p = LOADP(); stmt; } while (0)
#else
#define CHK(stmt) do {} while (0)
#endif
__global__ void __launch_bounds__(NTHREADS, 2) fwd_megakernel(Params pk) {
    extern __shared__ __attribute__((aligned(16))) unsigned char lds_raw[];
    LAS unsigned char* lds = (LAS unsigned char*)lds_raw;
    cg::grid_group grid = cg::this_grid();
    KP kp = (KP)__builtin_amdgcn_kernarg_segment_ptr();
    const int G = gridDim.x, bx = blockIdx.x;
    const int NGW = G * NWAVES;

    { const Params p = LOADP(); if (blockIdx.x == 0) for (int i = threadIdx.x; i < XCD_BAR_WORDS; i += NTHREADS) ((unsigned*)(p.ws + OFF_BAR))[i] = 0u;
      if (threadIdx.x == 0) { XB_ST[0] = 0u; XB_ST[1] = 0u; } }
#ifdef DBG_TIME
    if (threadIdx.x < 16) TACC[threadIdx.x] = 0ull;
    __syncthreads();
#endif
#ifdef DBG_CHECK
    { const Params p = LOADP(); if (blockIdx.x == 0 && threadIdx.x == 0) *(unsigned*)(p.ws + OFF_FLAG) = 9999u; }
#endif
    if (PH(0)) { T_BEGIN(); TIDS(); const Params p = LOADP(); mods_phase(p, lds, tid, wave, lane); T_END(0); }
    __syncthreads();
    if (PH(1)) { T_BEGIN(); TIDS(); const Params p = LOADP(); convert_weights(p, 0, lds, gw, NGW, wave, lane); T_END(0); }
    GRID_SYNC_CG();
    { const Params p = LOADP(); if (threadIdx.x == 0) (void)xb_add(&((unsigned*)(p.ws + OFF_BAR))[XB_XCNT(xb_xcc_id())], 1u); }
        CHK(chk_f32(p, (const float*)(p.ws + OFF_MOD), 4 * 2 * 6144, 1, true, tid); chk_bf16(p, (const bf16_t*)(p.ws + OFF_WB), WB_END / 2, 2, true, tid));

#pragma unroll 1
    for (int l = 0; l < DEPTH; ++l) {
        if (PH(1)) if (l > 0) { T_BEGIN(); TIDS(); const Params p = LOADP(); convert_weights(p, l, lds + 65536, gw, NGW, wave, lane); T_END(1); }
        if (PH(2)) { T_BEGIN(); TIDS(); const Params p = LOADP(); norm_phase<true>(p, l, lds, gw, NGW, tid, lane); T_END(1); }
        GRID_SYNC();
        CHK(chk_bf16(p, (const bf16_t*)(p.ws + OFF_H), PLANE, 3, l == 0, tid); chk_f32(p, (const float*)(p.ws + OFF_G), (size_t)T * 16, 4, l == 0, tid));
        if (PH(3)) { T_BEGIN(); TIDS(); const Params p = LOADP(); bf16_t* WB = (bf16_t*)(p.ws + OFF_WB); bf16_t* H = (bf16_t*)(p.ws + OFF_H); bf16_t* Z = (bf16_t*)(p.ws + OFF_Z);
          pg8::Gemm g{H, H, WB + WB_WIN / 2, 1024, 0}; pg8::Sched S; S.init(65, 28, G, bx, 1, 0); EpiZ E{Z, (float*)(p.ws + OFF_SSQ)};
          pg8::gemm_phase<EpiZ>(lds, g, S, E, tid); T_END(2); }
        GRID_SYNC();
        CHK(chk_bf16(p, (const bf16_t*)(p.ws + OFF_Z), 7 * PLANE, 5, l == 0, tid));
        for (int it = bx; it < NCH * 4; it += G) { if (PH(4)) { T_BEGIN(); TIDS(); const Params p = LOADP(); mixA_mlstm(p, l, it >> 2, it & 3, lds, tid, wave, lane); T_END(3); } }
        { const int nA = (G > 8) ? ((G - 8 < NCH * 4) ? G - 8 : NCH * 4) : 0;
          if (bx >= 8 && bx - 8 < nA) { if (PH(5)) { T_BEGIN(); TIDS(); const Params p = LOADP(); const int j = bx - 8; mixA_spatial(p, l, j >> 2, j & 3, lds, tid, wave, lane); T_END(3); } } }
        GRID_SYNC();
        if (PH(6)) { T_BEGIN(); TIDS(); const Params p = LOADP(); scan_phase(p, tid); T_END(4); }
        GRID_SYNC();
        CHK(chk_bf16(p, (const bf16_t*)(p.ws + OFF_ST), (size_t)NCH * 8 * 32768, 11, l == 0, tid); chk_f32(p, (const float*)(p.ws + OFF_NS), (size_t)NCH * 8 * 128, 12, l == 0, tid); chk_f32(p, (const float*)(p.ws + OFF_MP), (size_t)NCH * 8, 13, l == 0, tid));
        if (PH(7)) for (int it = bx + ((l == DEPTH - 1) ? 8 : 0); it < NCH * 4; it += G) { T_BEGIN(); TIDS(); const Params p = LOADP(); mixC_item(p, l, it >> 2, it & 3, lds, tid, wave, lane); T_END(5); }
        { const int nA = (G > 8) ? ((G - 8 < NCH * 4) ? G - 8 : NCH * 4) : 0;
          const int jst = (G > 8) ? G - 8 : G;
          for (int j = nA + ((G > 8) ? bx - 8 : bx); (G <= 8 || bx >= 8) && j < NCH * 4; j += jst) { if (PH(5)) { T_BEGIN(); TIDS(); const Params p = LOADP(); mixA_spatial(p, l, j >> 2, j & 3, lds, tid, wave, lane); T_END(5); } } }
        GRID_SYNC();
        CHK(chk_bf16(p, (const bf16_t*)(p.ws + OFF_Z), PLANE, 14, l == 0, tid));
        if (PH(8)) { T_BEGIN(); TIDS(); const Params p = LOADP(); bf16_t* WB = (bf16_t*)(p.ws + OFF_WB); bf16_t* H = (bf16_t*)(p.ws + OFF_H); bf16_t* Z = (bf16_t*)(p.ws + OFF_Z);
          if (l < DEPTH - 1) for (int tile = bx; tile < 256; tile += G) ctx_gemm_tile<0>(Z, H, WB + WB_WPAB / 2, 1024, Z + 5 * PLANE, Z + 6 * PLANE, Z + 3 * PLANE, nullptr, nullptr, lds, tile, tid, wave, lane);
          pg8::Gemm g{Z, H, WB + WB_WPAB / 2, 1024, 4}; pg8::Sched S; S.init(64, 4, G, bx, 2, 1); EpiMerge E{Z + 5 * PLANE, Z + 6 * PLANE, Z + 3 * PLANE};
          pg8::gemm_phase<EpiMerge>(lds, g, S, E, tid); T_END(6); }
        GRID_SYNC();
        CHK(chk_bf16(p, (const bf16_t*)(p.ws + OFF_Z) + 3 * PLANE, PLANE, 15, l == 0, tid));
        if (PH(9)) { T_BEGIN(); TIDS(); const Params p = LOADP(); bf16_t* WB = (bf16_t*)(p.ws + OFF_WB); bf16_t* Z = (bf16_t*)(p.ws + OFF_Z); const float* MOD = (const float*)(p.ws + OFF_MOD); float* CS = (float*)(p.ws + OFF_CS);
          if (l < DEPTH - 1) for (int tile = bx; tile < 256; tile += G) ctx_gemm_tile<1>(Z + 3 * PLANE, Z + 3 * PLANE, WB + WB_WOUT / 2, 1024, nullptr, nullptr, nullptr, CS, MOD + (size_t)(l * 2 + 1) * 6144 + 2048, lds, tile, tid, wave, lane);
          pg8::Gemm g{Z + 3 * PLANE, Z + 3 * PLANE, WB + WB_WOUT / 2, 1024, 0}; pg8::Sched S; S.init(64, 4, G, bx, 1, 1);
          EpiRes E{p.out, CS, MOD + (size_t)(l * 2 + 0) * 6144 + 2048, MOD + (size_t)(l * 2 + 1) * 6144 + 2048};
          pg8::gemm_phase<EpiRes>(lds, g, S, E, tid); T_END(7); }
        GRID_SYNC();
        CHK(chk_f32(p, p.out, (size_t)(T - NCTX) * 1024, 16, l == 0, tid); chk_f32(p, (const float*)(p.ws + OFF_CS), (size_t)NCTX * 1024, 16, l == 0, tid));
        if (PH(10)) { T_BEGIN(); TIDS(); const Params p = LOADP(); norm_phase<false>(p, l, lds, gw, NGW, tid, lane); T_END(8); }
        GRID_SYNC();
        CHK(chk_bf16(p, (const bf16_t*)(p.ws + OFF_H), PLANE, 17, l == 0, tid));
        if (PH(11)) { T_BEGIN(); TIDS(); const Params p = LOADP(); bf16_t* WB = (bf16_t*)(p.ws + OFF_WB); bf16_t* H = (bf16_t*)(p.ws + OFF_H); bf16_t* Z = (bf16_t*)(p.ws + OFF_Z);
          pg8::Gemm g{H, H, WB + WB_W13 / 2, 1024, 0}; pg8::Sched S; S.init(65, 22, G, bx, 1, 0); EpiSwiglu E{Z + PLANE};
          pg8::gemm_phase<EpiSwiglu>(lds, g, S, E, tid); T_END(9); }
        GRID_SYNC();
        CHK(chk_bf16(p, (const bf16_t*)(p.ws + OFF_Z) + PLANE, (size_t)T * DFF, 18, l == 0, tid));
        if (PH(12)) { T_BEGIN(); TIDS(); const Params p = LOADP(); bf16_t* WB = (bf16_t*)(p.ws + OFF_WB); bf16_t* Z = (bf16_t*)(p.ws + OFF_Z); const float* MOD = (const float*)(p.ws + OFF_MOD); float* CS = (float*)(p.ws + OFF_CS);
          if (l < DEPTH - 1) for (int tile = bx; tile < 256; tile += G) ctx_gemm_tile<1>(Z + PLANE, Z + PLANE, WB + WB_W2 / 2, DFF, nullptr, nullptr, nullptr, CS, MOD + (size_t)(l * 2 + 1) * 6144 + 5120, lds, tile, tid, wave, lane);
          pg8::Gemm g{Z + PLANE, Z + PLANE, WB + WB_W2 / 2, DFF, 0}; pg8::Sched S; S.init(64, 4, G, bx, 1, 1);
          EpiRes E{p.out, CS, MOD + (size_t)(l * 2 + 0) * 6144 + 5120, MOD + (size_t)(l * 2 + 1) * 6144 + 5120};
          pg8::gemm_phase<EpiRes>(lds, g, S, E, tid); T_END(10); }
        GRID_SYNC();
        CHK(chk_f32(p, p.out, (size_t)(T - NCTX) * 1024, 19 + l, true, tid));
    }
#ifdef DBG_CHECK
    GRID_SYNC();
    { const Params p = LOADP(); const unsigned f = *(volatile unsigned*)(p.ws + OFF_FLAG);
      if (f != 9999u) { for (size_t i = (size_t)blockIdx.x * NTHREADS + threadIdx.x; i < (size_t)(T - NCTX) * 1024; i += (size_t)gridDim.x * NTHREADS) p.out[i] = 100.0f * (float)f; return; } }
#endif
    if (PH(13)) { T_BEGIN(); TIDS(); const Params p = LOADP(); final_norm(p, gw, NGW, lane); T_END(11); }
#ifdef DBG_TIME
    { const Params p = LOADP(); float* tf = (float*)(p.ws + 300 * 1024);
      if (blockIdx.x == 0 && threadIdx.x == 0) { float x = 0.f, y = 0.f;
          for (int k = 0; k < 13; ++k) { const float us = (float)TACC[k] * 0.01f; if ((DBG_TX >> k) & 1) x += us; if ((DBG_TY >> k) & 1) y += us; }
          tf[0] = x; tf[1] = y; }
      GRID_SYNC();
      const float x = ((volatile float*)tf)[0], y = ((volatile float*)tf)[1];
      for (size_t i = (size_t)blockIdx.x * NTHREADS + threadIdx.x; i < (1u << 20) + 1; i += (size_t)gridDim.x * NTHREADS) p.out[i] += (i == 0) ? x : y; }
#endif
}

extern "C" void kernel_launch(void* const* d_in, const int* in_sizes, int n_in, void* d_out, int out_size, void* d_ws, size_t ws_size, hipStream_t stream) {
    static int grid = 0;
    if (grid == 0) {
        if (n_in != 23 || out_size != (T - NCTX) * D || ws_size < WS_END) { fprintf(stderr, "kernel_launch: unexpected shapes (n_in %d, out %d, ws %zu, need %zu)\n", n_in, out_size, ws_size, (size_t)WS_END); grid = -1; return; }
        int dev = 0, cus = 0, per_cu = 0;
        (void)hipGetDevice(&dev); (void)hipDeviceGetAttribute(&cus, hipDeviceAttributeMultiprocessorCount, dev);
        if (hipFuncSetAttribute((const void*)fwd_megakernel, hipFuncAttributeMaxDynamicSharedMemorySize, LDS_BYTES) != hipSuccess) { fprintf(stderr, "kernel_launch: hipFuncSetAttribute failed\n"); grid = -1; return; }
        if (hipOccupancyMaxActiveBlocksPerMultiprocessor(&per_cu, (const void*)fwd_megakernel, NTHREADS, LDS_BYTES) != hipSuccess || per_cu < 1) { fprintf(stderr, "kernel_launch: occupancy query says %d\n", per_cu); per_cu = 1; }
        (void)hipGetLastError();
        grid = cus;
    }
    if (grid < 0) return;
    Params p{};
    p.x = (const float*)d_in[0]; p.c = (const float*)d_in[1]; p.ctx = (const float*)d_in[2]; p.c_ctx = (const float*)d_in[3]; p.w_ada = (const float*)d_in[4]; p.b_ada = (const float*)d_in[5];
    p.norm1_g = (const float*)d_in[6]; p.norm2_g = (const float*)d_in[7]; p.w_in = (const float*)d_in[8]; p.conv_w = (const float*)d_in[9]; p.conv_b = (const float*)d_in[10]; p.gate_b = (const float*)d_in[11];
    p.head_g = (const float*)d_in[12]; p.vnorm_g = (const float*)d_in[13]; p.w_sp = (const float*)d_in[14]; p.b_sp = (const float*)d_in[15]; p.w_pa = (const float*)d_in[16]; p.w_pb = (const float*)d_in[17];
    p.w_out = (const float*)d_in[18]; p.w_ff1 = (const float*)d_in[19]; p.w_ff3 = (const float*)d_in[20]; p.w_ff2 = (const float*)d_in[21]; p.final_g = (const float*)d_in[22];
    p.out = (float*)d_out; p.ws = (unsigned char*)d_ws;
    void* args[] = {&p};
    hipError_t e = hipLaunchCooperativeKernel((const void*)fwd_megakernel, dim3(grid), dim3(NTHREADS), args, LDS_BYTES, stream);
    if (e != hipSuccess) fprintf(stderr, "kernel_launch: cooperative launch failed: %s (grid %d)\n", hipGetErrorString(e), grid);
}
```
